# Optimizing an MI355X kernel written in HIP

```python
import math
import jax, jax.numpy as jnp
from jax import lax
import numpy as np

D_MODEL = 1024
BATCH = 32
SEQ = 256
DEPTH = 2
DEC_BATCH = 8
DEC_SEQ = 4096
PAST_LEN = 256

GRID_W = 64
EPS = 1e-6
ROPE_THETA = 10000.0
N_MOD = 9

ATTN_HEADS = 8
ATTN_KV_HEADS = 2
HEAD_DIM = 64
ATTN_GROUP = ATTN_HEADS // ATTN_KV_HEADS
Q_BLOCK = 128

RET_HEADS = 8
RET_DK = 64
RET_DV = 64
RET_CHUNK = 128
RET_DECAY_EXP_FWD = 5.0
RET_DECAY_EXP_BWD = 5.5

DN_HEADS = 4
DN_DK = 128
DN_DV = 128
DN_CHUNK = 64
CONV_K = 3

D_FF = 2816
N_BRANCH = 3

ATTN_Q_W = ATTN_HEADS * HEAD_DIM
ATTN_KV_W = ATTN_KV_HEADS * HEAD_DIM
RET_K_W = RET_HEADS * RET_DK
RET_V_W = RET_HEADS * RET_DV
DN_K_W = DN_HEADS * DN_DK
DN_V_W = DN_HEADS * DN_DV
IN_SPLITS = (ATTN_Q_W, ATTN_KV_W, ATTN_KV_W,
             RET_K_W, RET_K_W, RET_V_W, RET_V_W,
             DN_K_W, DN_K_W, DN_V_W, 2 * DN_HEADS, 2 * DN_HEADS, DN_V_W,
             N_BRANCH * D_MODEL)
N_IN = sum(IN_SPLITS)

kernel_name = 'hybrid_diffusion_prefix_trunk_step'


def rmsnorm(x, w):
    xf = x.astype(jnp.float32)
    y = xf * lax.rsqrt(jnp.mean(xf * xf, axis=-1, keepdims=True) + EPS)
    return (y * w.astype(jnp.float32)).astype(x.dtype)


def l2norm(x):
    return x * lax.rsqrt(jnp.sum(x * x, axis=-1, keepdims=True) + EPS)


def modulate(x, shift, scale):
    return x * (1 + scale) + shift


def swiglu(x, w_in, w_out):
    gate, up = jnp.split(x @ w_in, 2, axis=-1)
    return (jax.nn.silu(gate) * up) @ w_out


def flip(a):
    return a[:, ::-1]


def axial_rope(rows, dim):
    n_freq = dim // 4
    inv = ROPE_THETA ** (-jnp.arange(n_freq, dtype=jnp.float32) / n_freq)
    row = jnp.repeat(jnp.arange(rows, dtype=jnp.float32), GRID_W)
    col = jnp.tile(jnp.arange(GRID_W, dtype=jnp.float32), rows)
    ang = jnp.concatenate([row[:, None] * inv, col[:, None] * inv], axis=-1)
    return jnp.cos(ang), jnp.sin(ang)


def apply_rope(x, cos, sin):
    half = x.shape[-1] // 2
    xf = x.astype(jnp.float32)
    x1, x2 = xf[..., :half], xf[..., half:]
    c, s = cos[None, :, None, :], sin[None, :, None, :]
    return jnp.concatenate([x1 * c - x2 * s, x2 * c + x1 * s], axis=-1).astype(x.dtype)


def block_attention(q, k, v):
    B, T = q.shape[0], q.shape[1]
    nb = T // Q_BLOCK
    qb = q.reshape(B, nb, Q_BLOCK, ATTN_KV_HEADS, ATTN_GROUP, HEAD_DIM).transpose(1, 0, 2, 3, 4, 5)
    kf = k.astype(jnp.float32)
    vf = v.astype(jnp.float32)
    scale = HEAD_DIM ** -0.5

    def one_block(qblk):
        s = jnp.einsum('bqkgd,bskd->bkgqs', qblk.astype(jnp.float32), kf) * scale
        p = jax.nn.softmax(s, axis=-1)
        return jnp.einsum('bkgqs,bskd->bqkgd', p, vf)

    o = lax.map(one_block, qb)
    return o.transpose(1, 0, 2, 3, 4, 5).reshape(B, T, ATTN_Q_W).astype(q.dtype)


def retention_log_decays():
    h = jnp.arange(RET_HEADS, dtype=jnp.float32)
    fwd = jnp.log1p(-jnp.exp2(-RET_DECAY_EXP_FWD - h))
    bwd = jnp.log1p(-jnp.exp2(-RET_DECAY_EXP_BWD - h))
    return fwd, bwd


def retention_scan(q, k, v, log_gamma, s0):
    B, T, H = q.shape[0], q.shape[1], q.shape[2]
    C = RET_CHUNK
    n = T // C

    def chunks(a):
        return a.reshape(B, n, C, H, a.shape[-1]).transpose(1, 0, 3, 2, 4)

    pos = jnp.arange(C, dtype=jnp.float32)
    diff = pos[:, None] - pos[None, :]
    inner = jnp.where(diff >= 0, jnp.exp(log_gamma[:, None, None] * jnp.maximum(diff, 0.0)), 0.0)
    q_decay = jnp.exp(log_gamma[:, None] * (pos + 1.0))
    k_decay = jnp.exp(log_gamma[:, None] * (C - 1.0 - pos))
    chunk_decay = jnp.exp(log_gamma * C)

    def step(S, inp):
        qc, kc, vc = inp
        att = jnp.einsum('bhqd,bhkd->bhqk', qc, kc) * inner
        o = (jnp.einsum('bhqk,bhkv->bhqv', att, vc)
             + jnp.einsum('bhqd,bhdv->bhqv', qc * q_decay[None, :, :, None], S))
        S = (S * chunk_decay[None, :, None, None]
             + jnp.einsum('bhkd,bhkv->bhdv', kc * k_decay[None, :, :, None], vc))
        return S, o

    S, o = lax.scan(step, s0, (chunks(q), chunks(k), chunks(v)))
    return o.transpose(1, 0, 3, 2, 4).reshape(B, T, H, -1), S


def gated_delta_scan(q, k, v, g, beta, s0):
    B, T, H = q.shape[0], q.shape[1], q.shape[2]
    C = DN_CHUNK
    n = T // C

    def chunks(a):
        return a.reshape((B, n, C, H) + a.shape[3:]).transpose((1, 0, 3, 2) + tuple(range(4, a.ndim + 1)))

    qc, kc, vc, gc, bc = chunks(q), chunks(k), chunks(v), chunks(g), chunks(beta)
    G = jnp.cumsum(gc, axis=-1)
    pos = jnp.arange(C)
    incl = pos[:, None] >= pos[None, :]
    strict = pos[:, None] > pos[None, :]
    L = jnp.exp(jnp.where(incl, G[..., :, None] - G[..., None, :], -jnp.inf))
    kb = kc * bc[..., None]
    A = jnp.where(strict, jnp.einsum('nbhid,nbhjd->nbhij', kb, kc) * L, 0.0)
    IA = A + jnp.eye(C, dtype=A.dtype)
    u = lax.linalg.triangular_solve(IA, vc * bc[..., None], left_side=True, lower=True, unit_diagonal=True)
    w = lax.linalg.triangular_solve(IA, kb * jnp.exp(G)[..., None], left_side=True, lower=True, unit_diagonal=True)

    def step(S, inp):
        qi, ki, ui, wi, Gi, Li = inp
        v_new = ui - jnp.einsum('bhcd,bhdv->bhcv', wi, S)
        att = jnp.einsum('bhid,bhjd->bhij', qi, ki) * Li
        o = (jnp.einsum('bhcd,bhdv->bhcv', qi * jnp.exp(Gi)[..., None], S)
             + jnp.einsum('bhij,bhjv->bhiv', att, v_new))
        g_last = Gi[..., -1:]
        S = (S * jnp.exp(g_last)[..., None]
             + jnp.einsum('bhcd,bhcv->bhdv', ki * jnp.exp(g_last - Gi)[..., None], v_new))
        return S, o

    S, o = lax.scan(step, s0, (qc, kc, u, w, G, L))
    return o.transpose(1, 0, 3, 2, 4).reshape(B, T, H, -1), S


def centred_depthwise_conv(x, w):
    K, C = w.shape
    return lax.conv_general_dilated(x, w[:, None, :].astype(x.dtype), window_strides=(1,),
                                    padding=[(K // 2, K - 1 - K // 2)],
                                    dimension_numbers=('NWC', 'WIO', 'NWC'),
                                    feature_group_count=C)


def token_mixing(h, p, rows, ctx_k, ctx_v, ret_s0, dn_s0):
    f32 = jnp.float32
    B, T = h.shape[0], h.shape[1]
    points = np.cumsum(IN_SPLITS)[:-1].tolist()
    (aq, ak, av, rq, rk, rv, rg, dq, dk, dv, da, db, dg, mg) = jnp.split(h @ p['w_in'], points, axis=-1)

    aq = rmsnorm(aq.reshape(B, T, ATTN_HEADS, HEAD_DIM), p['attn_q_norm'])
    ak = rmsnorm(ak.reshape(B, T, ATTN_KV_HEADS, HEAD_DIM), p['attn_k_norm'])
    av = av.reshape(B, T, ATTN_KV_HEADS, HEAD_DIM)
    if rows is None:
        attn_out = block_attention(aq, ak, av)
    else:
        cos, sin = axial_rope(rows, HEAD_DIM)
        keys = jnp.concatenate([apply_rope(ak, cos, sin), ctx_k.astype(ak.dtype)], axis=1)
        vals = jnp.concatenate([av, ctx_v.astype(av.dtype)], axis=1)
        attn_out = block_attention(apply_rope(aq, cos, sin), keys, vals)

    rq = rq.reshape(B, T, RET_HEADS, RET_DK)
    rk = rk.reshape(B, T, RET_HEADS, RET_DK)
    if rows is not None:
        rcos, rsin = axial_rope(rows, RET_DK)
        rq, rk = apply_rope(rq, rcos, rsin), apply_rope(rk, rcos, rsin)
    rq = rq.astype(f32) * RET_DK ** -0.5
    rk = rk.astype(f32)
    rv = rv.reshape(B, T, RET_HEADS, RET_DV).astype(f32)
    lg_f, lg_b = retention_log_decays()
    r_f, rs_f = retention_scan(rq, rk, rv, lg_f, ret_s0[:, 0].astype(f32))
    r_b, rs_b = retention_scan(flip(rq), flip(rk), flip(rv), lg_b, ret_s0[:, 1].astype(f32))
    ret = r_f + flip(r_b)
    mu = jnp.mean(ret, axis=-1, keepdims=True)
    var = jnp.mean(jnp.square(ret - mu), axis=-1, keepdims=True)
    ret = ((ret - mu) * lax.rsqrt(var + EPS)).reshape(B, T, RET_V_W) * p['ret_norm'].astype(f32)
    ret_out = (jax.nn.silu(rg.astype(f32)) * ret).astype(h.dtype)
    ret_state = jnp.stack([rs_f, rs_b], axis=1)

    qkv = jax.nn.silu(centred_depthwise_conv(jnp.concatenate([dq, dk, dv], axis=-1), p['dn_conv']))
    dq, dk, dv = jnp.split(qkv, [DN_K_W, 2 * DN_K_W], axis=-1)
    dq = l2norm(dq.reshape(B, T, DN_HEADS, DN_DK).astype(f32)) * DN_DK ** -0.5
    dk = l2norm(dk.reshape(B, T, DN_HEADS, DN_DK).astype(f32))
    dv = dv.reshape(B, T, DN_HEADS, DN_DV).astype(f32)
    da = da.reshape(B, T, 2, DN_HEADS).astype(f32)
    db = db.reshape(B, T, 2, DN_HEADS).astype(f32)
    g = -jnp.exp(p['dn_a_log'].astype(f32)) * jax.nn.softplus(da + p['dn_dt_bias'].astype(f32))
    beta = jax.nn.sigmoid(db)
    d_f, ds_f = gated_delta_scan(dq, dk, dv, g[:, :, 0], beta[:, :, 0], dn_s0[:, 0].astype(f32))
    d_b, ds_b = gated_delta_scan(flip(dq), flip(dk), flip(dv), flip(g[:, :, 1]), flip(beta[:, :, 1]),
                                 dn_s0[:, 1].astype(f32))
    dn = rmsnorm(d_f + flip(d_b), p['dn_norm']) * jax.nn.silu(dg.reshape(B, T, DN_HEADS, DN_DV).astype(f32))
    dn_out = dn.reshape(B, T, DN_V_W).astype(h.dtype)
    dn_state = jnp.stack([ds_f, ds_b], axis=1)

    mg = jax.nn.sigmoid(mg.astype(f32)).reshape(B, T, N_BRANCH, D_MODEL)
    merged = (mg[:, :, 0] * (attn_out @ p['w_br_attn']).astype(f32)
              + mg[:, :, 1] * (ret_out @ p['w_br_ret']).astype(f32)
              + mg[:, :, 2] * (dn_out @ p['w_br_dn']).astype(f32))
    out = merged.astype(h.dtype) @ p['w_out']
    return out, ak, av, ret_state, dn_state


def trunk_layer(x, cond, p, rows, ctx_k, ctx_v, ret_s0, dn_s0):
    mod = (jax.nn.silu(cond) @ p['w_mod'] + p['b_mod'])[:, None, :]
    sh1, sc1, g1, sh2, sc2, g2, sh3, sc3, g3 = jnp.split(mod, N_MOD, axis=-1)
    x = x + 0.5 * g1 * swiglu(modulate(rmsnorm(x, p['norm_ffn1']), sh1, sc1), p['ffn1_w_in'], p['ffn1_w_out'])
    mix, k, v, rs, ds = token_mixing(modulate(rmsnorm(x, p['norm_mix']), sh2, sc2), p, rows,
                                     ctx_k, ctx_v, ret_s0, dn_s0)
    x = x + g2 * mix
    x = x + 0.5 * g3 * swiglu(modulate(rmsnorm(x, p['norm_ffn2']), sh3, sc3), p['ffn2_w_in'], p['ffn2_w_out'])
    return x, k, v, rs, ds


def setup_inputs(seed: int = 0) -> dict:
    key = jax.random.key(seed)
    ks = jax.random.split(key, 40)
    f32 = jnp.float32
    D = D_MODEL

    def nrm(k, shape, s):
        return jax.random.normal(k, shape, f32) * s

    def gain(k, shape):
        return 1.0 + 0.02 * jax.random.normal(k, shape, f32)

    dt = jnp.exp(jax.random.uniform(ks[20], (DEPTH, 2, DN_HEADS), f32, math.log(1e-3), math.log(1e-1)))
    return {
        'x_prompt': nrm(ks[0], (BATCH, SEQ, D), 1.0),
        'x_sample': nrm(ks[1], (DEC_BATCH, DEC_SEQ, D), 1.0),
        'cache_k': nrm(ks[2], (DEC_BATCH, DEPTH, PAST_LEN, ATTN_KV_HEADS, HEAD_DIM), 1.0),
        'cache_v': nrm(ks[3], (DEC_BATCH, DEPTH, PAST_LEN, ATTN_KV_HEADS, HEAD_DIM), 1.0),
        'state_ret': nrm(ks[4], (DEC_BATCH, DEPTH, 2, RET_HEADS, RET_DK, RET_DV), 0.1),
        'state_delta': nrm(ks[5], (DEC_BATCH, DEPTH, 2, DN_HEADS, DN_DK, DN_DV), 0.1),
        'c': nrm(ks[6], (DEC_BATCH, D), 1.0),
        'c_ctx': nrm(ks[7], (D,), 1.0),
        'w_mod': nrm(ks[8], (DEPTH, D, N_MOD * D), 0.5 * D ** -0.5),
        'b_mod': nrm(ks[9], (DEPTH, N_MOD * D), 0.01),
        'norm_ffn1': gain(ks[10], (DEPTH, D)),
        'ffn1_w_in': nrm(ks[11], (DEPTH, D, 2 * D_FF), D ** -0.5),
        'ffn1_w_out': nrm(ks[12], (DEPTH, D_FF, D), D_FF ** -0.5),
        'norm_mix': gain(ks[13], (DEPTH, D)),
        'w_in': nrm(ks[14], (DEPTH, D, N_IN), D ** -0.5),
        'attn_q_norm': gain(ks[15], (DEPTH, HEAD_DIM)),
        'attn_k_norm': gain(ks[16], (DEPTH, HEAD_DIM)),
        'ret_norm': gain(ks[17], (DEPTH, RET_V_W)),
        'dn_conv': nrm(ks[18], (DEPTH, CONV_K, 2 * DN_K_W + DN_V_W), CONV_K ** -0.5),
        'dn_a_log': jnp.log(jax.random.uniform(ks[19], (DEPTH, 2, DN_HEADS), f32, 1.0, 16.0)),
        'dn_dt_bias': dt + jnp.log(-jnp.expm1(-dt)),
        'dn_norm': gain(ks[21], (DEPTH, DN_DV)),
        'w_br_attn': nrm(ks[22], (DEPTH, ATTN_Q_W, D), ATTN_Q_W ** -0.5),
        'w_br_ret': nrm(ks[23], (DEPTH, RET_V_W, D), RET_V_W ** -0.5),
        'w_br_dn': nrm(ks[24], (DEPTH, DN_V_W, D), DN_V_W ** -0.5),
        'w_out': nrm(ks[25], (DEPTH, D, D), D ** -0.5),
        'norm_ffn2': gain(ks[26], (DEPTH, D)),
        'ffn2_w_in': nrm(ks[27], (DEPTH, D, 2 * D_FF), D ** -0.5),
        'ffn2_w_out': nrm(ks[28], (DEPTH, D_FF, D), D_FF ** -0.5),
        'norm_final': gain(ks[29], (D,)),
    }


def reference(x_prompt, x_sample, cache_k, cache_v, state_ret, state_delta, c, c_ctx,
              w_mod, b_mod, norm_ffn1, ffn1_w_in, ffn1_w_out, norm_mix, w_in,
              attn_q_norm, attn_k_norm, ret_norm, dn_conv, dn_a_log, dn_dt_bias, dn_norm,
              w_br_attn, w_br_ret, w_br_dn, w_out, norm_ffn2, ffn2_w_in, ffn2_w_out, norm_final):
    def layer_params(l):
        return {
            'w_mod': w_mod[l], 'b_mod': b_mod[l],
            'norm_ffn1': norm_ffn1[l], 'ffn1_w_in': ffn1_w_in[l], 'ffn1_w_out': ffn1_w_out[l],
            'norm_mix': norm_mix[l], 'w_in': w_in[l],
            'attn_q_norm': attn_q_norm[l], 'attn_k_norm': attn_k_norm[l], 'ret_norm': ret_norm[l],
            'dn_conv': dn_conv[l], 'dn_a_log': dn_a_log[l], 'dn_dt_bias': dn_dt_bias[l], 'dn_norm': dn_norm[l],
            'w_br_attn': w_br_attn[l], 'w_br_ret': w_br_ret[l], 'w_br_dn': w_br_dn[l], 'w_out': w_out[l],
            'norm_ffn2': norm_ffn2[l], 'ffn2_w_in': ffn2_w_in[l], 'ffn2_w_out': ffn2_w_out[l],
        }

    bp = x_prompt.shape[0]
    cond_ctx = c_ctx[None, :]
    ret_zero = jnp.zeros((bp, 2, RET_HEADS, RET_DK, RET_DV), jnp.float32)
    dn_zero = jnp.zeros((bp, 2, DN_HEADS, DN_DK, DN_DV), jnp.float32)
    h = x_prompt
    ks, vs, rss, dss = [], [], [], []
    for l in range(DEPTH):
        h, k_l, v_l, rs_l, ds_l = trunk_layer(h, cond_ctx, layer_params(l), None, None, None, ret_zero, dn_zero)
        ks.append(k_l)
        vs.append(v_l)
        rss.append(rs_l)
        dss.append(ds_l)
    y_prompt = rmsnorm(h, norm_final)
    new_cache_k = jnp.stack(ks, axis=1)
    new_cache_v = jnp.stack(vs, axis=1)
    new_state_ret = jnp.stack(rss, axis=1)
    new_state_delta = jnp.stack(dss, axis=1)

    rows = x_sample.shape[1] // GRID_W
    hs = x_sample
    for l in range(DEPTH):
        hs, _, _, _, _ = trunk_layer(hs, c, layer_params(l), rows, cache_k[:, l], cache_v[:, l],
                                     state_ret[:, l], state_delta[:, l])
    y_sample = rmsnorm(hs, norm_final)
    return (y_prompt, y_sample, new_cache_k, new_cache_v, new_state_ret, new_state_delta)
```

```cpp
#include <hip/hip_runtime.h>
#include <hip/hip_cooperative_groups.h>
#include <cstdio>
namespace cg = cooperative_groups;

typedef unsigned short u16;
using bf16x8 = __attribute__((ext_vector_type(8))) short;
using f32x4 = __attribute__((ext_vector_type(4))) float;
#define DI __device__ __forceinline__

constexpr int TT = 40960;
constexpr int TI = 8192;
constexpr int DM = 1024;
constexpr int DFF = 2816;
constexpr float EPSF = 1e-6f;
constexpr int NTHREADS = 512;
#ifndef PHMASK
#define PHMASK 0xffffffffu
#endif
#define PH(i) ((PHMASK >> (i)) & 1u)

constexpr size_t OCK = 41943040, OCV = 44040192, OSR = 46137344, OSD = 50331648;

constexpr size_t W1IN = 0, W1OUT = 5767168, WIN = 8650752, WBR = 16908288, WOUT = 18481152, W2IN = 19529728, W2OUT = 25296896, WTOTAL = 28180480;
constexpr size_t WS_W = 0;
constexpr size_t WS_H = WTOTAL * 2;
constexpr size_t SLABB = (size_t)TT * 512 * 2;
constexpr size_t WS_SLAB = WS_H + (size_t)TT * 1024 * 2;
constexpr size_t WS_MODS = WS_SLAB + 9 * SLABB;
constexpr size_t WS_DAB = WS_MODS + 2 * 9 * 9216 * 4;
constexpr size_t WS_GBG = WS_DAB + (size_t)TT * 16 * 4;
constexpr size_t WS_GBB = WS_GBG + (size_t)TT * 8 * 4;
constexpr size_t WS_HALO = WS_GBB + (size_t)TT * 8 * 4;
constexpr size_t WS_CTR = WS_HALO + (size_t)640 * 2 * 1536 * 2;
constexpr size_t WS_END = WS_CTR + 256;
constexpr size_t KC_VT_OFF = 5505024;

struct KParams {
  const float* in[30];
  float* out;
  unsigned char* ws;
};
struct Params {
  const KParams& k;
  float* out;
  unsigned char* ws;
};

typedef __bf16 bf16v2_t __attribute__((ext_vector_type(2)));
typedef float f32v2_t __attribute__((ext_vector_type(2)));
DI unsigned cvtpk(float lo, float hi) { f32v2_t v = {lo, hi}; bf16v2_t b = __builtin_convertvector(v, bf16v2_t); return __builtin_bit_cast(unsigned, b); }
DI u16 f2bf(float x) { return (u16)(cvtpk(x, 0.f) & 0xffffu); }
DI float bf2f(u16 h) { return __uint_as_float(((unsigned)h) << 16); }
DI float bflo(unsigned u) { return __uint_as_float(u << 16); }
DI float bfhi(unsigned u) { return __uint_as_float(u & 0xffff0000u); }
DI f32x4 mfma16(bf16x8 a, bf16x8 b, f32x4 c) { return __builtin_amdgcn_mfma_f32_16x16x32_bf16(a, b, c, 0, 0, 0); }
DI float silu_f(float x) { return x / (1.f + __expf(-x)); }
DI float sigmoid_f(float x) { return 1.f / (1.f + __expf(-x)); }
DI float wave_sum(float x) {
#pragma unroll
  for (int o = 32; o >= 1; o >>= 1) x += __shfl_xor(x, o);
  return x;
}
DI float sum16(float x) {
  x += __shfl_xor(x, 1); x += __shfl_xor(x, 2); x += __shfl_xor(x, 4); x += __shfl_xor(x, 8);
  return x;
}
DI float max16(float x) {
  x = fmaxf(x, __shfl_xor(x, 1)); x = fmaxf(x, __shfl_xor(x, 2)); x = fmaxf(x, __shfl_xor(x, 4)); x = fmaxf(x, __shfl_xor(x, 8));
  return x;
}
DI int seq_base(int s) { return s < 32 ? s * 256 : TI + (s - 32) * 4096; }
DI int seq_len(int s) { return s < 32 ? 256 : 4096; }
DI int modrow_of(int t) { return t < TI ? 0 : 1 + ((t - TI) >> 12); }
DI const float* xin_row(const Params& p, int t) { return t < TI ? p.k.in[0] + (size_t)t * DM : p.k.in[1] + (size_t)(t - TI) * DM; }
DI size_t kv_base(int s, int kvh) { return s < 32 ? (size_t)(s * 2 + kvh) * (256 * 64) : (size_t)1048576 + (size_t)((s - 32) * 2 + kvh) * (4352 * 64); }

DI u16* ws_w(const Params& p) { return (u16*)(p.ws + WS_W); }
DI u16* ws_h(const Params& p) { return (u16*)(p.ws + WS_H); }
DI u16* ws_slab(const Params& p, int i) { return (u16*)(p.ws + WS_SLAB + (size_t)i * SLABB); }
DI float* ws_mods(const Params& p) { return (float*)(p.ws + WS_MODS); }

template <int NT, int KS>
DI void wave_mma(const u16* A, int lda, int arow0, const u16* B, int ldb, int brow0, f32x4 (&acc)[NT], int lane) {
  const int r = lane & 15, q = lane >> 4;
#pragma unroll
  for (int ks = 0; ks < KS; ++ks) {
    bf16x8 a = *(const bf16x8*)(A + (arow0 + r) * lda + ks * 32 + q * 8);
#pragma unroll
    for (int n = 0; n < NT; ++n) {
      bf16x8 b = *(const bf16x8*)(B + (brow0 + n * 16 + r) * ldb + ks * 32 + q * 8);
      acc[n] = mfma16(a, b, acc[n]);
    }
  }
}

template <int MT>
DI void gemm_main(const u16* __restrict__ A, int lda, const u16* __restrict__ Bt, int ldb, int K, int m0, int n0,
                  f32x4 (&acc)[MT][4], u16* smem, int tid) {
  constexpr int BM = MT * 64;
  constexpr int LDT = 72;
  constexpr int ACH = BM * 8 / NTHREADS;
  constexpr int BUF = (BM + 128) * LDT;
  const int lane = tid & 63, w = tid >> 6, wr = w >> 1, wc = w & 1, r = lane & 15, q = lane >> 4;
  uint4 ra[ACH], rb[2];
  const int lrow = tid >> 3, lseg = tid & 7;
  const u16* Ap = A + (size_t)(m0 + lrow) * lda + lseg * 8;
  const u16* Bp = Bt + (size_t)(n0 + lrow) * ldb + lseg * 8;
  const int nk = K >> 6;
#pragma unroll
  for (int i = 0; i < ACH; ++i) ra[i] = *(const uint4*)(Ap + (size_t)(64 * i) * lda);
#pragma unroll
  for (int i = 0; i < 2; ++i) rb[i] = *(const uint4*)(Bp + (size_t)(64 * i) * ldb);
  {
    u16* sA = smem; u16* sB = smem + BM * LDT;
#pragma unroll
    for (int i = 0; i < ACH; ++i) *(uint4*)(sA + (lrow + 64 * i) * LDT + lseg * 8) = ra[i];
#pragma unroll
    for (int i = 0; i < 2; ++i) *(uint4*)(sB + (lrow + 64 * i) * LDT + lseg * 8) = rb[i];
  }
  __syncthreads();
  for (int kt = 0; kt < nk; ++kt) {
    const bool more = (kt + 1 < nk);
    if (more) {
#pragma unroll
      for (int i = 0; i < ACH; ++i) ra[i] = *(const uint4*)(Ap + (size_t)(64 * i) * lda + (kt + 1) * 64);
#pragma unroll
      for (int i = 0; i < 2; ++i) rb[i] = *(const uint4*)(Bp + (size_t)(64 * i) * ldb + (kt + 1) * 64);
    }
    const u16* sA = smem + (kt & 1) * BUF;
    const u16* sB = sA + BM * LDT;
#pragma unroll
    for (int ks = 0; ks < 2; ++ks) {
      bf16x8 af[MT], bfr[4];
#pragma unroll
      for (int m = 0; m < MT; ++m) af[m] = *(const bf16x8*)(sA + (wr * MT * 16 + m * 16 + r) * LDT + ks * 32 + q * 8);
#pragma unroll
      for (int n = 0; n < 4; ++n) bfr[n] = *(const bf16x8*)(sB + (wc * 64 + n * 16 + r) * LDT + ks * 32 + q * 8);
#pragma unroll
      for (int m = 0; m < MT; ++m)
#pragma unroll
        for (int n = 0; n < 4; ++n) acc[m][n] = mfma16(af[m], bfr[n], acc[m][n]);
    }
    if (more) {
      u16* dA = smem + ((kt + 1) & 1) * BUF; u16* dB = dA + BM * LDT;
#pragma unroll
      for (int i = 0; i < ACH; ++i) *(uint4*)(dA + (lrow + 64 * i) * LDT + lseg * 8) = ra[i];
#pragma unroll
      for (int i = 0; i < 2; ++i) *(uint4*)(dB + (lrow + 64 * i) * LDT + lseg * 8) = rb[i];
    }
    __syncthreads();
  }
}

template <int MT>
DI void zero_acc(f32x4 (&acc)[MT][4]) {
#pragma unroll
  for (int m = 0; m < MT; ++m)
#pragma unroll
    for (int n = 0; n < 4; ++n) acc[m][n] = f32x4{0.f, 0.f, 0.f, 0.f};
}

DI int map_row(int type, int col) {
  if (type == 0) return col;
  if (type == 1) { if (col < DFF) return 32 * (col >> 4) + (col & 15); int c = col - DFF; return 32 * (c >> 4) + 16 + (c & 15); }
  if (col < 2816) return col;
  if (col < 4352) return col;
  if (col < 4368) return 2816 + 2048 + (col - 4352);
  if (col < 4880) return 2816 + 1536 + (col - 4368);
  return 2816 + 2176 + (col - 4880);
}

DI void conv_tile(const float* __restrict__ src, int ld, int ncols, int k0, int c0, u16* __restrict__ dst, int K, int type, u16* sm, int tid) {
  {
    const int n = tid & 63, kk = tid >> 6;
    const bool ok = (c0 + n) < ncols;
#pragma unroll
    for (int i = 0; i < 8; ++i) {
      int k = kk + 8 * i;
      float v = ok ? src[(size_t)(k0 + k) * ld + c0 + n] : 0.f;
      sm[n * 72 + k] = f2bf(v);
    }
  }
  __syncthreads();
  {
    const int n2 = tid >> 3, seg = tid & 7;
    const int col = c0 + n2;
    if (col < ncols) {
      int row = map_row(type, col);
      *(uint4*)(dst + (size_t)row * K + k0 + seg * 8) = *(const uint4*)(sm + n2 * 72 + seg * 8);
    }
  }
  __syncthreads();
}

DI void phase_convert(const Params& p, int l, u16* smem, int tid, int bid, int nblk) {
  u16* W = ws_w(p);
  const int NJ = 9;
  const int cum[NJ + 1] = {0, 1408, 2112, 4112, 4240, 4368, 4496, 4752, 6160, 6864};
  const int nconv = 6864;
  const int nmod = (l == 0) ? 288 : 0;
  const int total = nconv + 1 + nmod;
  if (l == 0 && bid == 0 && tid < 64) ((int*)(p.ws + WS_CTR))[tid] = 0;
  for (int it = bid; it < total; it += nblk) {
    if (it < nconv) {
      int j = 0;
#pragma unroll
      for (int jj = 1; jj < NJ; ++jj) if (it >= cum[jj]) j = jj;
      int t = it - cum[j];
      const float* src; int ld, ncols, K, type = 0, nct; u16* dst;
      switch (j) {
        case 0: src = p.k.in[11] + (size_t)l * 1024 * 5632; ld = 5632; ncols = 5632; K = 1024; type = 1; nct = 88; dst = W + W1IN; break;
        case 1: src = p.k.in[12] + (size_t)l * 2816 * 1024; ld = 1024; ncols = 1024; K = 2816; nct = 16; dst = W + W1OUT; break;
        case 2: src = p.k.in[14] + (size_t)l * 1024 * 7952; ld = 7952; ncols = 7952; K = 1024; type = 2; nct = 125; dst = W + WIN; break;
        case 3: src = p.k.in[22] + (size_t)l * 512 * 1024; ld = 1024; ncols = 1024; K = 512; nct = 16; dst = W + WBR; break;
        case 4: src = p.k.in[23] + (size_t)l * 512 * 1024; ld = 1024; ncols = 1024; K = 512; nct = 16; dst = W + WBR + 524288; break;
        case 5: src = p.k.in[24] + (size_t)l * 512 * 1024; ld = 1024; ncols = 1024; K = 512; nct = 16; dst = W + WBR + 2 * 524288; break;
        case 6: src = p.k.in[25] + (size_t)l * 1024 * 1024; ld = 1024; ncols = 1024; K = 1024; nct = 16; dst = W + WOUT; break;
        case 7: src = p.k.in[27] + (size_t)l * 1024 * 5632; ld = 5632; ncols = 5632; K = 1024; type = 1; nct = 88; dst = W + W2IN; break;
        default: src = p.k.in[28] + (size_t)l * 2816 * 1024; ld = 1024; ncols = 1024; K = 2816; nct = 16; dst = W + W2OUT; break;
      }
      int kt = t / nct, ct = t % nct;
      conv_tile(src, ld, ncols, kt * 64, ct * 64, dst, K, type, smem, tid);
    } else if (it == nconv) {
      u16* z = W + WIN + (size_t)(2816 + 2064) * 1024;
      for (int i = tid; i < 112 * 1024 / 8; i += NTHREADS) *(uint4*)(z + i * 8) = uint4{0, 0, 0, 0};
    } else {
      int mi = it - nconv - 1;
      int ml = mi / 144, cb = mi % 144;
      float* sc = (float*)smem;
      float* red = sc + 9 * 1024;
      for (int i = tid; i < 9 * 1024; i += NTHREADS) {
        int r = i >> 10, k = i & 1023;
        float c = (r == 0) ? p.k.in[7][k] : p.k.in[6][(r - 1) * 1024 + k];
        sc[i] = silu_f(c);
      }
      __syncthreads();
      const int n = tid & 63, kg = tid >> 6;
      const float* Wm = p.k.in[8] + (size_t)ml * 1024 * 9216 + cb * 64 + n;
      float a[9];
#pragma unroll
      for (int r = 0; r < 9; ++r) a[r] = 0.f;
#pragma unroll 8
      for (int k = kg * 128; k < kg * 128 + 128; ++k) {
        float wv = Wm[(size_t)k * 9216];
#pragma unroll
        for (int r = 0; r < 9; ++r) a[r] += sc[r * 1024 + k] * wv;
      }
#pragma unroll
      for (int r = 0; r < 9; ++r) red[(kg * 9 + r) * 64 + n] = a[r];
      __syncthreads();
      for (int i = tid; i < 576; i += NTHREADS) {
        int r = i >> 6, nn = i & 63;
        float s = p.k.in[9][(size_t)ml * 9216 + cb * 64 + nn];
#pragma unroll
        for (int g = 0; g < 8; ++g) s += red[(g * 9 + r) * 64 + nn];
        ws_mods(p)[(size_t)(ml * 9 + r) * 9216 + cb * 64 + nn] = s;
      }
      __syncthreads();
    }
  }
}

DI void phase_norm(const Params& p, int l, int which, bool first, int tid, int bid, int nblk) {
  const int lane = tid & 63;
  const int gw = bid * 8 + (tid >> 6), nw = nblk * 8;
  const float* nwp = p.k.in[which == 0 ? 10 : (which == 1 ? 13 : 26)] + l * 1024;
  u16* H = ws_h(p);
  for (int t = gw; t < TT; t += nw) {
    const float* xr = first ? xin_row(p, t) : p.out + (size_t)t * DM;
    float4 v[4];
#pragma unroll
    for (int i = 0; i < 4; ++i) v[i] = *(const float4*)(xr + i * 256 + lane * 4);
    float ss = 0.f;
#pragma unroll
    for (int i = 0; i < 4; ++i) ss += v[i].x * v[i].x + v[i].y * v[i].y + v[i].z * v[i].z + v[i].w * v[i].w;
    ss = wave_sum(ss);
    const float rstd = rsqrtf(ss * (1.f / 1024.f) + EPSF);
    const float* mod = ws_mods(p) + (size_t)(l * 9 + modrow_of(t)) * 9216;
    const float* sh = mod + (3 * which) * 1024;
    const float* sc = mod + (3 * which + 1) * 1024;
#pragma unroll
    for (int i = 0; i < 4; ++i) {
      int c = i * 256 + lane * 4;
      float4 wv = *(const float4*)(nwp + c), s4 = *(const float4*)(sc + c), h4 = *(const float4*)(sh + c);
      float y0 = v[i].x * rstd * wv.x * (1.f + s4.x) + h4.x;
      float y1 = v[i].y * rstd * wv.y * (1.f + s4.y) + h4.y;
      float y2 = v[i].z * rstd * wv.z * (1.f + s4.z) + h4.z;
      float y3 = v[i].w * rstd * wv.w * (1.f + s4.w) + h4.w;
      *(uint2*)(H + (size_t)t * 1024 + c) = uint2{cvtpk(y0, y1), cvtpk(y2, y3)};
    }
  }
}

DI void phase_final_norm(const Params& p, int tid, int bid, int nblk) {
  const int lane = tid & 63;
  const int gw = bid * 8 + (tid >> 6), nw = nblk * 8;
  const float* nwp = p.k.in[29];
  for (int t = gw; t < TT; t += nw) {
    float* xr = p.out + (size_t)t * DM;
    float4 v[4];
#pragma unroll
    for (int i = 0; i < 4; ++i) v[i] = *(const float4*)(xr + i * 256 + lane * 4);
    float ss = 0.f;
#pragma unroll
    for (int i = 0; i < 4; ++i) ss += v[i].x * v[i].x + v[i].y * v[i].y + v[i].z * v[i].z + v[i].w * v[i].w;
    ss = wave_sum(ss);
    const float rstd = rsqrtf(ss * (1.f / 1024.f) + EPSF);
#pragma unroll
    for (int i = 0; i < 4; ++i) {
      int c = i * 256 + lane * 4;
      float4 wv = *(const float4*)(nwp + c);
      *(float4*)(xr + c) = float4{v[i].x * rstd * wv.x, v[i].y * rstd * wv.y, v[i].z * rstd * wv.z, v[i].w * rstd * wv.w};
    }
  }
}

DI void phase_g1(const Params& p, int which, u16* smem, int tid, int bid, int nblk) {
  const u16* A = ws_h(p);
  const u16* Bt = ws_w(p) + (which ? W2IN : W1IN);
  u16* hid = ws_slab(p, 0);
  const int lane = tid & 63, w = tid >> 6, wr = w >> 1, wc = w & 1, r = lane & 15, q = lane >> 4;
  for (int tile = bid; tile < 160 * 44; tile += nblk) {
    const int mt = tile / 44, nt = tile % 44;
    f32x4 acc[4][4];
    zero_acc<4>(acc);
    gemm_main<4>(A, 1024, Bt, 1024, 1024, mt * 256, nt * 128, acc, smem, tid);
#pragma unroll
    for (int m = 0; m < 4; ++m)
#pragma unroll
      for (int np = 0; np < 2; ++np)
#pragma unroll
        for (int j = 0; j < 4; ++j) {
          int row = mt * 256 + wr * 64 + m * 16 + q * 4 + j;
          int hc = nt * 64 + wc * 32 + np * 16 + r;
          float g = acc[m][2 * np][j], u = acc[m][2 * np + 1][j];
          hid[(size_t)row * DFF + hc] = f2bf(silu_f(g) * u);
        }
  }
}

DI void phase_g2(const Params& p, int l, int which, bool first, u16* smem, int tid, int bid, int nblk) {
  const u16* A = ws_slab(p, 0);
  const u16* Bt = ws_w(p) + (which ? W2OUT : W1OUT);
  const int lane = tid & 63, w = tid >> 6, wr = w >> 1, wc = w & 1, r = lane & 15, q = lane >> 4;
  for (int tile = bid; tile < 160 * 8; tile += nblk) {
    const int mt = tile / 8, nt = tile % 8;
    f32x4 acc[4][4];
    zero_acc<4>(acc);
    gemm_main<4>(A, DFF, Bt, DFF, DFF, mt * 256, nt * 128, acc, smem, tid);
    const float* gm = ws_mods(p) + (size_t)(l * 9 + modrow_of(mt * 256)) * 9216 + (which ? 8 : 2) * 1024;
#pragma unroll
    for (int m = 0; m < 4; ++m)
#pragma unroll
      for (int n = 0; n < 4; ++n)
#pragma unroll
        for (int j = 0; j < 4; ++j) {
          int row = mt * 256 + wr * 64 + m * 16 + q * 4 + j;
          int col = nt * 128 + wc * 64 + n * 16 + r;
          const float* xr = first ? xin_row(p, row) : p.out + (size_t)row * DM;
          p.out[(size_t)row * DM + col] = xr[col] + 0.5f * gm[col] * acc[m][n][j];
        }
  }
}

DI void phase_g3a(const Params& p, u16* smem, int tid, int bid, int nblk) {
  const u16* A = ws_h(p);
  const u16* Bt = ws_w(p) + WIN;
  const int lane = tid & 63, w = tid >> 6, wr = w >> 1, wc = w & 1, r = lane & 15, q = lane >> 4;
  for (int tile = bid; tile < 160 * 22; tile += nblk) {
    const int mt = tile / 22, nt = tile % 22;
    f32x4 acc[4][4];
    zero_acc<4>(acc);
    gemm_main<4>(A, 1024, Bt, 1024, 1024, mt * 256, nt * 128, acc, smem, tid);
    const int n0 = nt * 128;
    u16* dst; int ldd, c0;
    if (n0 < 512) { dst = ws_slab(p, 0); ldd = 512; c0 = n0; }
    else if (n0 < 768) { dst = ws_slab(p, 6); ldd = 256; c0 = n0 - 512; }
    else { dst = ws_slab(p, 2 + ((n0 - 768) >> 9)); ldd = 512; c0 = (n0 - 768) & 511; }
#pragma unroll
    for (int m = 0; m < 4; ++m)
#pragma unroll
      for (int n = 0; n < 4; ++n)
#pragma unroll
        for (int j = 0; j < 4; ++j) {
          int row = mt * 256 + wr * 64 + m * 16 + q * 4 + j;
          int col = c0 + wc * 64 + n * 16 + r;
          dst[(size_t)row * ldd + col] = f2bf(acc[m][n][j]);
        }
  }
}

DI void phase_g3b(const Params& p, u16* smem, int tid, int bid, int nblk) {
  const u16* A = ws_h(p);
  const u16* Bt = ws_w(p) + WIN + (size_t)2816 * 1024;
  float* DAB = (float*)(p.ws + WS_DAB);
  u16* HALO = (u16*)(p.ws + WS_HALO);
  const int lane = tid & 63, w = tid >> 6, wr = w >> 1, wc = w & 1, r = lane & 15, q = lane >> 4;
  for (int tile = bid; tile < 160 * 17; tile += nblk) {
    const int mt = tile / 17, nt = tile % 17;
    f32x4 acc[4][4];
    zero_acc<4>(acc);
    gemm_main<4>(A, 1024, Bt, 1024, 1024, mt * 256, nt * 128, acc, smem, tid);
    const int n0 = nt * 128;
    if (n0 < 2048) {
      u16* dst = ws_slab(p, 2 + (n0 >> 9));
      const int c0 = n0 & 511;
#pragma unroll
      for (int m = 0; m < 4; ++m)
#pragma unroll
        for (int n = 0; n < 4; ++n)
#pragma unroll
          for (int j = 0; j < 4; ++j) {
            int row = mt * 256 + wr * 64 + m * 16 + q * 4 + j;
            int col = c0 + wc * 64 + n * 16 + r;
            u16 v = f2bf(acc[m][n][j]);
            dst[(size_t)row * 512 + col] = v;
            if (n0 < 1536) {
              int rr = row & 63;
              if (rr == 0 || rr == 63) HALO[((size_t)(row >> 6) * 2 + (rr == 63 ? 1 : 0)) * 1536 + n0 + wc * 64 + n * 16 + r] = v;
            }
          }
    } else {
      if (wc == 0) {
#pragma unroll
        for (int m = 0; m < 4; ++m)
#pragma unroll
          for (int j = 0; j < 4; ++j) {
            int row = mt * 256 + wr * 64 + m * 16 + q * 4 + j;
            DAB[(size_t)row * 16 + r] = acc[m][0][j];
          }
      }
    }
  }
}

DI void phase_merge(const Params& p, u16* smem, int tid, int bid, int nblk) {
  const u16* H = ws_h(p);
  const u16* Wmg = ws_w(p) + WIN + (size_t)(2816 + 2176) * 1024;
  const u16* Wbr = ws_w(p) + WBR;
  u16* out = ws_slab(p, 2);
  const int lane = tid & 63, w = tid >> 6, wr = w >> 1, wc = w & 1, r = lane & 15, q = lane >> 4;
  for (int tile = bid; tile < 320 * 8; tile += nblk) {
    const int mt = tile / 8, nt = tile % 8;
    f32x4 mrg[2][4];
    zero_acc<2>(mrg);
#pragma unroll 1
    for (int b = 0; b < 3; ++b) {
      f32x4 g[2][4];
      zero_acc<2>(g);
      gemm_main<2>(H, 1024, Wmg + (size_t)b * 1024 * 1024, 1024, 1024, mt * 128, nt * 128, g, smem, tid);
#pragma unroll
      for (int m = 0; m < 2; ++m)
#pragma unroll
        for (int n = 0; n < 4; ++n)
#pragma unroll
          for (int j = 0; j < 4; ++j) g[m][n][j] = sigmoid_f(g[m][n][j]);
      f32x4 acc[2][4];
      zero_acc<2>(acc);
      const u16* br = ws_slab(p, b == 0 ? 0 : (b == 1 ? 1 : 7));
      gemm_main<2>(br, 512, Wbr + (size_t)b * 524288, 512, 512, mt * 128, nt * 128, acc, smem, tid);
#pragma unroll
      for (int m = 0; m < 2; ++m)
#pragma unroll
        for (int n = 0; n < 4; ++n)
#pragma unroll
          for (int j = 0; j < 4; ++j) mrg[m][n][j] += g[m][n][j] * acc[m][n][j];
    }
#pragma unroll
    for (int m = 0; m < 2; ++m)
#pragma unroll
      for (int n = 0; n < 4; ++n)
#pragma unroll
        for (int j = 0; j < 4; ++j) {
          int row = mt * 128 + wr * 32 + m * 16 + q * 4 + j;
          int col = nt * 128 + wc * 64 + n * 16 + r;
          out[(size_t)row * 1024 + col] = f2bf(mrg[m][n][j]);
        }
  }
}

DI void phase_g5(const Params& p, int l, u16* smem, int tid, int bid, int nblk) {
  const u16* A = ws_slab(p, 2);
  const u16* Bt = ws_w(p) + WOUT;
  const int lane = tid & 63, w = tid >> 6, wr = w >> 1, wc = w & 1, r = lane & 15, q = lane >> 4;
  for (int tile = bid; tile < 160 * 8; tile += nblk) {
    const int mt = tile / 8, nt = tile % 8;
    f32x4 acc[4][4];
    zero_acc<4>(acc);
    gemm_main<4>(A, 1024, Bt, 1024, 1024, mt * 256, nt * 128, acc, smem, tid);
    const float* gm = ws_mods(p) + (size_t)(l * 9 + modrow_of(mt * 256)) * 9216 + 5 * 1024;
#pragma unroll
    for (int m = 0; m < 4; ++m)
#pragma unroll
      for (int n = 0; n < 4; ++n)
#pragma unroll
        for (int j = 0; j < 4; ++j) {
          int row = mt * 256 + wr * 64 + m * 16 + q * 4 + j;
          int col = nt * 128 + wc * 64 + n * 16 + r;
          float* xp = p.out + (size_t)row * DM + col;
          *xp = *xp + gm[col] * acc[m][n][j];
        }
  }
}

DI void phase_prep(const Params& p, int l, int tid, int bid, int nblk) {
  const int lane = tid & 63;
  const int gw = bid * 8 + (tid >> 6), nw = nblk * 8;
  u16* AQ = ws_slab(p, 0); u16* RQ = ws_slab(p, 2); u16* RK = ws_slab(p, 3);
  const u16* KV = ws_slab(p, 6);
  u16* KC = ws_slab(p, 7);
  const float wq = p.k.in[15][l * 64 + lane], wk = p.k.in[16][l * 64 + lane];
  for (int t = gw; t < TT; t += nw) {
    const bool g2 = t >= TI;
    const int s = g2 ? 32 + ((t - TI) >> 12) : (t >> 8);
    const int tl = t - seq_base(s);
    const int S = g2 ? 4352 : 256;
    float cs = 1.f, sn = 0.f;
    if (g2) {
      int i = lane & 31, f = i & 15;
      float inv = exp2f(-(float)f * (13.287712379549449f / 16.f));
      float pos = (i < 16) ? (float)(tl >> 6) : (float)(tl & 63);
      sincosf(pos * inv, &sn, &cs);
    }
    const float sgn = (lane < 32) ? -1.f : 1.f;
#pragma unroll
    for (int h = 0; h < 8; ++h) {
      u16* pq = AQ + (size_t)t * 512 + h * 64 + lane;
      float x = bf2f(*pq);
      float ss = wave_sum(x * x);
      float y = x * rsqrtf(ss * (1.f / 64.f) + EPSF) * wq;
      if (g2) { float pr = __shfl_xor(y, 32); y = y * cs + sgn * pr * sn; }
      *pq = f2bf(y);
    }
#pragma unroll
    for (int kv = 0; kv < 2; ++kv) {
      float x = bf2f(KV[(size_t)t * 256 + kv * 64 + lane]);
      float ss = wave_sum(x * x);
      float y = x * rsqrtf(ss * (1.f / 64.f) + EPSF) * wk;
      if (!g2) p.out[OCK + ((((size_t)s * 2 + l) * 256 + tl) * 2 + kv) * 64 + lane] = y;
      else { float pr = __shfl_xor(y, 32); y = y * cs + sgn * pr * sn; }
      KC[kv_base(s, kv) + (size_t)tl * 64 + lane] = f2bf(y);
      u16 vraw = KV[(size_t)t * 256 + 128 + kv * 64 + lane];
      if (!g2) p.out[OCV + ((((size_t)s * 2 + l) * 256 + tl) * 2 + kv) * 64 + lane] = bf2f(vraw);
      KC[KC_VT_OFF + kv_base(s, kv) + (size_t)lane * S + tl] = vraw;
    }
#pragma unroll
    for (int h = 0; h < 8; ++h) {
      u16* pq = RQ + (size_t)t * 512 + h * 64 + lane;
      float y = bf2f(*pq);
      if (g2) { float pr = __shfl_xor(y, 32); y = y * cs + sgn * pr * sn; }
      *pq = f2bf(y * 0.125f);
      if (g2) {
        u16* pk = RK + (size_t)t * 512 + h * 64 + lane;
        float z = bf2f(*pk);
        float pz = __shfl_xor(z, 32);
        *pk = f2bf(z * cs + sgn * pz * sn);
      }
    }
  }
  const int gt = bid * NTHREADS + tid, ngt = nblk * NTHREADS;
  for (int idx = gt; idx < 8 * 256 * 2 * 64; idx += ngt) {
    int d = idx & 63, kv = (idx >> 6) & 1, j = (idx >> 7) & 255, b = idx >> 15;
    size_t src = ((((size_t)b * 2 + l) * 256 + j) * 2 + kv) * 64 + d;
    KC[kv_base(32 + b, kv) + (size_t)(4096 + j) * 64 + d] = f2bf(p.k.in[2][src]);
    KC[KC_VT_OFF + kv_base(32 + b, kv) + (size_t)d * 4352 + 4096 + j] = f2bf(p.k.in[3][src]);
  }
}

DI void attn_item(const Params& p, int s, int head, int qt, u16* smem, int tid) {
  const int lane = tid & 63, w = tid >> 6, r = lane & 15, q = lane >> 4;
  const int base = seq_base(s);
  const int S = s < 32 ? 256 : 4352;
  const int kvh = head >> 2;
  const u16* Kc = ws_slab(p, 7) + kv_base(s, kvh);
  const u16* Vt = ws_slab(p, 7) + KC_VT_OFF + kv_base(s, kvh);
  u16* Qb = ws_slab(p, 0);
  const int row0 = base + qt * 256 + w * 32;
  bf16x8 qf[2][2];
#pragma unroll
  for (int m = 0; m < 2; ++m)
#pragma unroll
    for (int ks = 0; ks < 2; ++ks) qf[m][ks] = *(const bf16x8*)(Qb + (size_t)(row0 + m * 16 + r) * 512 + head * 64 + ks * 32 + q * 8);
  f32x4 o[2][4];
  zero_acc<2>(o);
  float mx[2][4], ls[2][4];
#pragma unroll
  for (int m = 0; m < 2; ++m)
#pragma unroll
    for (int j = 0; j < 4; ++j) { mx[m][j] = -INFINITY; ls[m][j] = 0.f; }
  u16* sK = smem;
  u16* sV = smem + 2 * 64 * 72;
  u16* sP = smem + 4 * 64 * 72 + w * 32 * 72;
  const int nkt = S >> 6;
  const int lrow = tid >> 3, lseg = tid & 7;
  const float c = 0.125f * 1.4426950408889634f;
  uint4 rk = *(const uint4*)(Kc + (size_t)lrow * 64 + lseg * 8);
  uint4 rv = *(const uint4*)(Vt + (size_t)lrow * S + lseg * 8);
  *(uint4*)(sK + lrow * 72 + lseg * 8) = rk;
  *(uint4*)(sV + lrow * 72 + lseg * 8) = rv;
  __syncthreads();
  for (int kt = 0; kt < nkt; ++kt) {
    const bool more = kt + 1 < nkt;
    if (more) {
      rk = *(const uint4*)(Kc + (size_t)((kt + 1) * 64 + lrow) * 64 + lseg * 8);
      rv = *(const uint4*)(Vt + (size_t)lrow * S + (kt + 1) * 64 + lseg * 8);
    }
    const u16* cK = sK + (kt & 1) * 64 * 72;
    const u16* cV = sV + (kt & 1) * 64 * 72;
    f32x4 sc[2][4];
    zero_acc<2>(sc);
#pragma unroll
    for (int ks = 0; ks < 2; ++ks)
#pragma unroll
      for (int n = 0; n < 4; ++n) {
        bf16x8 b = *(const bf16x8*)(cK + (n * 16 + r) * 72 + ks * 32 + q * 8);
#pragma unroll
        for (int m = 0; m < 2; ++m) sc[m][n] = mfma16(qf[m][ks], b, sc[m][n]);
      }
#pragma unroll
    for (int m = 0; m < 2; ++m)
#pragma unroll
      for (int j = 0; j < 4; ++j) {
        float rm = fmaxf(fmaxf(sc[m][0][j], sc[m][1][j]), fmaxf(sc[m][2][j], sc[m][3][j]));
        rm = max16(rm);
        float mnew = fmaxf(mx[m][j], rm);
        float alpha = exp2f((mx[m][j] - mnew) * c);
        mx[m][j] = mnew;
        float psum = 0.f;
#pragma unroll
        for (int n = 0; n < 4; ++n) {
          float pv = exp2f((sc[m][n][j] - mnew) * c);
          psum += pv;
          sP[(m * 16 + q * 4 + j) * 72 + n * 16 + r] = f2bf(pv);
          o[m][n][j] *= alpha;
        }
        ls[m][j] = ls[m][j] * alpha + psum;
      }
#pragma unroll
    for (int ks = 0; ks < 2; ++ks) {
      bf16x8 a[2];
#pragma unroll
      for (int m = 0; m < 2; ++m) a[m] = *(const bf16x8*)(sP + (m * 16 + r) * 72 + ks * 32 + q * 8);
#pragma unroll
      for (int n = 0; n < 4; ++n) {
        bf16x8 b = *(const bf16x8*)(cV + (n * 16 + r) * 72 + ks * 32 + q * 8);
#pragma unroll
        for (int m = 0; m < 2; ++m) o[m][n] = mfma16(a[m], b, o[m][n]);
      }
    }
    if (more) {
      *(uint4*)(sK + ((kt + 1) & 1) * 64 * 72 + lrow * 72 + lseg * 8) = rk;
      *(uint4*)(sV + ((kt + 1) & 1) * 64 * 72 + lrow * 72 + lseg * 8) = rv;
    }
    __syncthreads();
  }
#pragma unroll
  for (int m = 0; m < 2; ++m)
#pragma unroll
    for (int j = 0; j < 4; ++j) {
      float inv = 1.f / sum16(ls[m][j]);
#pragma unroll
      for (int n = 0; n < 4; ++n)
        Qb[(size_t)(row0 + m * 16 + q * 4 + j) * 512 + head * 64 + n * 16 + r] = f2bf(o[m][n][j] * inv);
    }
}

DI void ret_item(const Params& p, int l, int s, int h, u16* smem, int tid) {
  const int lane = tid & 63, r = lane & 15, q = lane >> 4;
  const int dir = tid >> 8, ct = tid & 255, wv = (tid >> 6) & 3;
  const int base = seq_base(s), len = seq_len(s), N = len >> 6;
  const bool g2 = s >= 32;
  const float lg = log1pf(-exp2f(-(dir ? 5.5f : 5.0f) - (float)h));
  u16* cs = smem + dir * (6 * 4608);
  u16* Qs = cs; u16* Ks = cs + 4608; u16* Vt = cs + 2 * 4608; u16* Kdt = cs + 3 * 4608; u16* Ps = cs + 4 * 4608; u16* St = cs + 5 * 4608;
  const u16* RQ = ws_slab(p, 2); const u16* RK = ws_slab(p, 3); const u16* RV = ws_slab(p, 4); const u16* RG = ws_slab(p, 5);
  u16* RO = ws_slab(p, 1);
  const float* rnw = p.k.in[17] + l * 512 + h * 64;
  f32x4 accS[4];
#pragma unroll
  for (int n = 0; n < 4; ++n)
#pragma unroll
    for (int j = 0; j < 4; ++j) {
      float v0 = 0.f;
      if (g2) v0 = p.k.in[4][(((((size_t)(s - 32) * 2 + l) * 2 + dir) * 8 + h) * 64 + (n * 16 + r)) * 64 + (wv * 16 + q * 4 + j)];
      accS[n][j] = v0;
      St[(wv * 16 + q * 4 + j) * 72 + n * 16 + r] = f2bf(v0);
    }
  const float cdec = expf(lg * 64.f);
  for (int n = 0; n < N; ++n) {
#pragma unroll
    for (int i = 0; i < 2; ++i) {
      int ch = ct + 256 * i, row = ch >> 3, seg = ch & 7;
      int pp = n * 64 + row;
      int t = base + (dir ? len - 1 - pp : pp);
      size_t off = (size_t)t * 512 + h * 64 + seg * 8;
      uint4 qv = *(const uint4*)(RQ + off), kv = *(const uint4*)(RK + off), vv = *(const uint4*)(RV + off);
      *(uint4*)(Qs + row * 72 + seg * 8) = qv;
      *(uint4*)(Ks + row * 72 + seg * 8) = kv;
      float kdec = expf(lg * (float)(63 - row));
      unsigned ku[4] = {kv.x, kv.y, kv.z, kv.w}, vu[4] = {vv.x, vv.y, vv.z, vv.w};
#pragma unroll
      for (int e = 0; e < 4; ++e) {
        Kdt[(seg * 8 + 2 * e) * 72 + row] = f2bf(bflo(ku[e]) * kdec);
        Kdt[(seg * 8 + 2 * e + 1) * 72 + row] = f2bf(bfhi(ku[e]) * kdec);
        Vt[(seg * 8 + 2 * e) * 72 + row] = (u16)(vu[e] & 0xffffu);
        Vt[(seg * 8 + 2 * e + 1) * 72 + row] = (u16)(vu[e] >> 16);
      }
    }
    __syncthreads();
    f32x4 sa[4];
#pragma unroll
    for (int nn = 0; nn < 4; ++nn) sa[nn] = f32x4{0.f, 0.f, 0.f, 0.f};
    wave_mma<4, 2>(Qs, 72, wv * 16, Ks, 72, 0, sa, lane);
#pragma unroll
    for (int nn = 0; nn < 4; ++nn)
#pragma unroll
      for (int j = 0; j < 4; ++j) {
        int i = wv * 16 + q * 4 + j, jj = nn * 16 + r;
        float pv = (i >= jj) ? sa[nn][j] * expf(lg * (float)(i - jj)) : 0.f;
        Ps[i * 72 + jj] = f2bf(pv);
      }
    f32x4 a1[4], a2[4];
#pragma unroll
    for (int nn = 0; nn < 4; ++nn) { a1[nn] = f32x4{0.f, 0.f, 0.f, 0.f}; a2[nn] = f32x4{0.f, 0.f, 0.f, 0.f}; }
    wave_mma<4, 2>(Ps, 72, wv * 16, Vt, 72, 0, a1, lane);
    wave_mma<4, 2>(Qs, 72, wv * 16, St, 72, 0, a2, lane);
#pragma unroll
    for (int j = 0; j < 4; ++j) {
      int i = wv * 16 + q * 4 + j;
      float qd = expf(lg * (float)(i + 1));
      int pp = n * 64 + i;
      int t = base + (dir ? len - 1 - pp : pp);
      u16* po = RO + (size_t)t * 512 + h * 64 + r;
      float vals[4];
#pragma unroll
      for (int nn = 0; nn < 4; ++nn) vals[nn] = a1[nn][j] + qd * a2[nn][j];
      if (n < (N >> 1)) {
#pragma unroll
        for (int nn = 0; nn < 4; ++nn) po[nn * 16] = f2bf(vals[nn]);
      } else {
        float s1 = 0.f;
#pragma unroll
        for (int nn = 0; nn < 4; ++nn) { vals[nn] += bf2f(po[nn * 16]); s1 += vals[nn]; }
        float mu = sum16(s1) * (1.f / 64.f);
        float s2 = 0.f;
#pragma unroll
        for (int nn = 0; nn < 4; ++nn) { float dlt = vals[nn] - mu; s2 += dlt * dlt; }
        float rs = rsqrtf(sum16(s2) * (1.f / 64.f) + EPSF);
        const u16* pg = RG + (size_t)t * 512 + h * 64 + r;
#pragma unroll
        for (int nn = 0; nn < 4; ++nn) {
          float gte = silu_f(bf2f(pg[nn * 16]));
          po[nn * 16] = f2bf((vals[nn] - mu) * rs * rnw[nn * 16 + r] * gte);
        }
      }
    }
#pragma unroll
    for (int nn = 0; nn < 4; ++nn)
#pragma unroll
      for (int j = 0; j < 4; ++j) accS[nn][j] *= cdec;
    wave_mma<4, 2>(Vt, 72, wv * 16, Kdt, 72, 0, accS, lane);
    __syncthreads();
#pragma unroll
    for (int nn = 0; nn < 4; ++nn)
#pragma unroll
      for (int j = 0; j < 4; ++j) St[(wv * 16 + q * 4 + j) * 72 + nn * 16 + r] = f2bf(accS[nn][j]);
  }
  if (!g2) {
#pragma unroll
    for (int nn = 0; nn < 4; ++nn)
#pragma unroll
      for (int j = 0; j < 4; ++j)
        p.out[OSR + (((((size_t)s * 2 + l) * 2 + dir) * 8 + h) * 64 + (nn * 16 + r)) * 64 + (wv * 16 + q * 4 + j)] = accS[nn][j];
  }
  __syncthreads();
}

DI void phase_mix_ab(const Params& p, int l, u16* smem, int* s_item, int tid) {
  int* ctr = (int*)(p.ws + WS_CTR) + l * 4;
  while (true) {
    if (tid == 0) *s_item = atomicAdd(ctr, 1);
    __syncthreads();
    const int it = *s_item;
    __syncthreads();
    if (it >= 1600) break;
    int kind, s, h, qt = 0;
    if (it < 64) { kind = 0; s = 32 + (it >> 3); h = it & 7; }
    else if (it < 1088) { int a = it - 64; kind = 1; s = 32 + (a >> 7); h = (a >> 4) & 7; qt = a & 15; }
    else if (it < 1344) { int a = it - 1088; kind = 0; s = a >> 3; h = a & 7; }
    else { int a = it - 1344; kind = 1; s = a >> 3; h = a & 7; }
    if (kind == 0) ret_item(p, l, s, h, smem, tid);
    else attn_item(p, s, h, qt, smem, tid);
  }
}

DI void dn_pre_item(const Params& p, int l, int cgk, int h, u16* smem, int tid) {
  const int lane = tid & 63, w = tid >> 6, r = lane & 15, q = lane >> 4;
  u16* Ks = smem;
  float* sKK = (float*)(smem + 64 * 136);
  float* sA = sKK + 64 * 65;
  float* sX = sA + 2 * 4096;
  float* sg = sX + 2 * 64 * 68;
  float* sb = sg + 128;
  float* sG = sb + 128;
  const int t0 = cgk * 64;
  const int s = t0 < TI ? (t0 >> 8) : 32 + ((t0 - TI) >> 12);
  const int base = seq_base(s), len = seq_len(s);
  const u16* HALO = (const u16*)(p.ws + WS_HALO);
  {
    const int rr = tid >> 3, cseg = tid & 7;
    const int t = t0 + rr;
    const int col0 = h * 128 + cseg * 16;
    unsigned res[3][8];
#pragma unroll
    for (int xi = 0; xi < 3; ++xi) {
      const u16* X = ws_slab(p, 2 + xi);
      uint4 c0 = *(const uint4*)(X + (size_t)t * 512 + col0), c1 = *(const uint4*)(X + (size_t)t * 512 + col0 + 8);
      uint4 p0 = uint4{0, 0, 0, 0}, p1 = p0, n0 = p0, n1 = p0;
      if (t > base) {
        const u16* src = (rr > 0) ? X + (size_t)(t - 1) * 512 + col0 : HALO + ((size_t)(cgk - 1) * 2 + 1) * 1536 + xi * 512 + col0;
        p0 = *(const uint4*)src; p1 = *(const uint4*)(src + 8);
      }
      if (t + 1 < base + len) {
        const u16* src = (rr < 63) ? X + (size_t)(t + 1) * 512 + col0 : HALO + ((size_t)(cgk + 1) * 2 + 0) * 1536 + xi * 512 + col0;
        n0 = *(const uint4*)src; n1 = *(const uint4*)(src + 8);
      }
      const float* cw = p.k.in[18] + (size_t)l * 3 * 1536 + xi * 512 + col0;
      unsigned cu[8] = {c0.x, c0.y, c0.z, c0.w, c1.x, c1.y, c1.z, c1.w};
      unsigned pu[8] = {p0.x, p0.y, p0.z, p0.w, p1.x, p1.y, p1.z, p1.w};
      unsigned nu[8] = {n0.x, n0.y, n0.z, n0.w, n1.x, n1.y, n1.z, n1.w};
      float y[16];
      float ss = 0.f;
#pragma unroll
      for (int e = 0; e < 8; ++e) {
        float a0 = cw[2 * e] * bflo(pu[e]) + cw[1536 + 2 * e] * bflo(cu[e]) + cw[3072 + 2 * e] * bflo(nu[e]);
        float a1 = cw[2 * e + 1] * bfhi(pu[e]) + cw[1536 + 2 * e + 1] * bfhi(cu[e]) + cw[3072 + 2 * e + 1] * bfhi(nu[e]);
        a0 = silu_f(a0); a1 = silu_f(a1);
        y[2 * e] = a0; y[2 * e + 1] = a1;
        ss += a0 * a0 + a1 * a1;
      }
      if (xi < 2) {
        ss += __shfl_xor(ss, 1); ss += __shfl_xor(ss, 2); ss += __shfl_xor(ss, 4);
        float rn = rsqrtf(ss + EPSF) * (xi == 0 ? 0.08838834764831845f : 1.f);
#pragma unroll
        for (int e = 0; e < 16; ++e) y[e] *= rn;
      }
#pragma unroll
      for (int e = 0; e < 8; ++e) res[xi][e] = cvtpk(y[2 * e], y[2 * e + 1]);
    }
    *(uint4*)(Ks + rr * 136 + cseg * 16) = uint4{res[1][0], res[1][1], res[1][2], res[1][3]};
    *(uint4*)(Ks + rr * 136 + cseg * 16 + 8) = uint4{res[1][4], res[1][5], res[1][6], res[1][7]};
    __syncthreads();
#pragma unroll
    for (int xi = 0; xi < 3; ++xi) {
      u16* X = ws_slab(p, 2 + xi);
      *(uint4*)(X + (size_t)t * 512 + col0) = uint4{res[xi][0], res[xi][1], res[xi][2], res[xi][3]};
      *(uint4*)(X + (size_t)t * 512 + col0 + 8) = uint4{res[xi][4], res[xi][5], res[xi][6], res[xi][7]};
    }
  }
  const float* DAB = (const float*)(p.ws + WS_DAB);
  float* GBG = (float*)(p.ws + WS_GBG);
  float* GBB = (float*)(p.ws + WS_GBB);
  if (tid < 128) {
    int dir = tid >> 6, i = tid & 63;
    int t = t0 + (dir ? 63 - i : i);
    float da = DAB[(size_t)t * 16 + dir * 4 + h], db = DAB[(size_t)t * 16 + 8 + dir * 4 + h];
    float x = da + p.k.in[20][l * 8 + dir * 4 + h];
    float sp = (x > 20.f) ? x : log1pf(expf(x));
    sg[tid] = -expf(p.k.in[19][l * 8 + dir * 4 + h]) * sp;
    sb[tid] = 1.f / (1.f + expf(-db));
  }
  __syncthreads();
  if (tid == 0 || tid == 64) {
    float run = 0.f;
    for (int i = 0; i < 64; ++i) { run += sg[tid + i]; sG[tid + i] = run; }
  }
  {
    f32x4 kk[2];
    kk[0] = f32x4{0.f, 0.f, 0.f, 0.f}; kk[1] = kk[0];
    wave_mma<2, 4>(Ks, 136, (w >> 1) * 16, Ks, 136, (w & 1) * 32, kk, lane);
#pragma unroll
    for (int nn = 0; nn < 2; ++nn)
#pragma unroll
      for (int j = 0; j < 4; ++j) sKK[((w >> 1) * 16 + q * 4 + j) * 65 + (w & 1) * 32 + nn * 16 + r] = kk[nn][j];
  }
  __syncthreads();
  if (tid < 128) {
    int dir = tid >> 6, i = tid & 63;
    int t = t0 + (dir ? 63 - i : i);
    GBG[(size_t)t * 8 + dir * 4 + h] = sG[tid];
    GBB[(size_t)t * 8 + dir * 4 + h] = sb[tid];
  }
  for (int idx = tid; idx < 2 * 4096; idx += NTHREADS) {
    int dir = idx >> 12, i = (idx >> 6) & 63, j = idx & 63;
    int ri = dir ? 63 - i : i, rj = dir ? 63 - j : j;
    float a = 0.f;
    if (i > j) a = sb[dir * 64 + i] * sKK[ri * 65 + rj] * expf(sG[dir * 64 + i] - sG[dir * 64 + j]);
    sA[idx] = a;
    sX[(dir * 64 + i) * 68 + j] = (i == j) ? 1.f : 0.f;
  }
  __syncthreads();
  if (tid < 128) {
    const int dir = tid >> 6, c = tid & 63;
    float* xr = sX + (dir * 64 + c) * 68;
    const float* ar = sA + dir * 4096;
    for (int i = 1; i < 64; ++i) {
      float sacc = (i == c) ? 1.f : 0.f;
      for (int j4 = 0; j4 < i; j4 += 4) {
        float4 a4 = *(const float4*)(ar + i * 64 + j4);
        float4 x4 = *(const float4*)(xr + j4);
        sacc -= a4.x * x4.x + a4.y * x4.y + a4.z * x4.z + a4.w * x4.w;
      }
      xr[i] = sacc;
    }
  }
  __syncthreads();
  u16* TM = ws_slab(p, 6);
  for (int idx = tid; idx < 2 * 4096; idx += NTHREADS) {
    int dir = idx >> 12, i = (idx >> 6) & 63, c = idx & 63;
    TM[(((size_t)cgk * 4 + h) * 2 + dir) * 4096 + i * 64 + c] = f2bf(sX[(dir * 64 + c) * 68 + i]);
  }
  __syncthreads();
}

DI void phase_dn_pre(const Params& p, int l, u16* smem, int tid, int bid, int nblk) {
  for (int it = bid; it < 640 * 4; it += nblk) dn_pre_item(p, l, it >> 2, it & 3, smem, tid);
}

DI void dn_scan_item(const Params& p, int l, int s, int h, int dir, u16* smem, int tid) {
  const int lane = tid & 63, w = tid >> 6, r = lane & 15, q = lane >> 4;
  u16* Qs = smem;
  u16* Ks = Qs + 8704;
  u16* Kdt = Ks + 8704;
  u16* Rt = Kdt + 9216;
  u16* Vnt = Rt + 9216;
  u16* St = Vnt + 9216;
  u16* Tms = St + 17408;
  u16* Atm = Tms + 4608;
  float* sG = (float*)(Atm + 4608);
  float* sB = sG + 64;
  float* sEG = sB + 64;
  const int base = seq_base(s), len = seq_len(s), N = len >> 6;
  const bool g2 = s >= 32;
  const u16* DQ = ws_slab(p, 2); const u16* DK = ws_slab(p, 3); const u16* DV = ws_slab(p, 4);
  const u16* TM = ws_slab(p, 6);
  u16* OUT = ws_slab(p, 7 + dir);
  const float* GBG = (const float*)(p.ws + WS_GBG);
  const float* GBB = (const float*)(p.ws + WS_GBB);
  const int mP = w >> 1, nP0 = (w & 1) * 4;
  f32x4 ST[8];
#pragma unroll
  for (int n = 0; n < 8; ++n)
#pragma unroll
    for (int j = 0; j < 4; ++j) {
      float v0 = 0.f;
      if (g2) v0 = p.k.in[5][(((((size_t)(s - 32) * 2 + l) * 2 + dir) * 4 + h) * 128 + (n * 16 + r)) * 128 + (w * 16 + q * 4 + j)];
      ST[n][j] = v0;
      St[(w * 16 + q * 4 + j) * 136 + n * 16 + r] = f2bf(v0);
    }
  for (int n = 0; n < N; ++n) {
    const int cgk = (base >> 6) + (dir ? N - 1 - n : n);
    {
      const int row = tid >> 3, seg = tid & 7;
      const int pp = n * 64 + row;
      const int t = base + (dir ? len - 1 - pp : pp);
      const int tlast = base + (dir ? len - 1 - (n * 64 + 63) : n * 64 + 63);
      const size_t off = (size_t)t * 512 + h * 128 + seg * 16;
      uint4 q0 = *(const uint4*)(DQ + off), q1 = *(const uint4*)(DQ + off + 8);
      uint4 k0 = *(const uint4*)(DK + off), k1 = *(const uint4*)(DK + off + 8);
      uint4 v0 = *(const uint4*)(DV + off), v1 = *(const uint4*)(DV + off + 8);
      const float grow = GBG[(size_t)t * 8 + dir * 4 + h], glast = GBG[(size_t)tlast * 8 + dir * 4 + h];
      *(uint4*)(Qs + row * 136 + seg * 16) = q0; *(uint4*)(Qs + row * 136 + seg * 16 + 8) = q1;
      *(uint4*)(Ks + row * 136 + seg * 16) = k0; *(uint4*)(Ks + row * 136 + seg * 16 + 8) = k1;
      const float kd = expf(glast - grow);
      unsigned ku[8] = {k0.x, k0.y, k0.z, k0.w, k1.x, k1.y, k1.z, k1.w};
      unsigned vu[8] = {v0.x, v0.y, v0.z, v0.w, v1.x, v1.y, v1.z, v1.w};
#pragma unroll
      for (int e = 0; e < 8; ++e) {
        Kdt[(seg * 16 + 2 * e) * 72 + row] = f2bf(bflo(ku[e]) * kd);
        Kdt[(seg * 16 + 2 * e + 1) * 72 + row] = f2bf(bfhi(ku[e]) * kd);
        Rt[(seg * 16 + 2 * e) * 72 + row] = (u16)(vu[e] & 0xffffu);
        Rt[(seg * 16 + 2 * e + 1) * 72 + row] = (u16)(vu[e] >> 16);
      }
      *(uint4*)(Tms + row * 72 + seg * 8) = *(const uint4*)(TM + (((size_t)cgk * 4 + h) * 2 + dir) * 4096 + row * 64 + seg * 8);
      if (tid < 64) {
        const int ti = base + (dir ? len - 1 - (n * 64 + tid) : n * 64 + tid);
        float G = GBG[(size_t)ti * 8 + dir * 4 + h];
        sG[tid] = G; sEG[tid] = expf(G); sB[tid] = GBB[(size_t)ti * 8 + dir * 4 + h];
      }
    }
    __syncthreads();
    f32x4 p1[4], qs[4], at[2];
#pragma unroll
    for (int nn = 0; nn < 4; ++nn) { p1[nn] = f32x4{0.f, 0.f, 0.f, 0.f}; qs[nn] = p1[nn]; }
    at[0] = f32x4{0.f, 0.f, 0.f, 0.f}; at[1] = at[0];
    wave_mma<4, 4>(Ks, 136, mP * 16, St, 136, nP0 * 16, p1, lane);
    wave_mma<4, 4>(Qs, 136, mP * 16, St, 136, nP0 * 16, qs, lane);
    wave_mma<2, 4>(Qs, 136, mP * 16, Ks, 136, (w & 1) * 32, at, lane);
    const int i0 = mP * 16 + q * 4;
    float bi[4], egi[4], gi[4];
#pragma unroll
    for (int j = 0; j < 4; ++j) { bi[j] = sB[i0 + j]; egi[j] = sEG[i0 + j]; gi[j] = sG[i0 + j]; }
#pragma unroll
    for (int nn = 0; nn < 4; ++nn) {
      const int v = (nP0 + nn) * 16 + r;
      uint2 raw = *(const uint2*)(Rt + v * 72 + i0);
      float f0 = bi[0] * (bflo(raw.x) - egi[0] * p1[nn][0]);
      float f1 = bi[1] * (bfhi(raw.x) - egi[1] * p1[nn][1]);
      float f2 = bi[2] * (bflo(raw.y) - egi[2] * p1[nn][2]);
      float f3 = bi[3] * (bfhi(raw.y) - egi[3] * p1[nn][3]);
      *(uint2*)(Rt + v * 72 + i0) = uint2{cvtpk(f0, f1), cvtpk(f2, f3)};
    }
#pragma unroll
    for (int nn = 0; nn < 2; ++nn) {
      const int jj = (w & 1) * 32 + nn * 16 + r;
      const float gj = sG[jj];
#pragma unroll
      for (int j = 0; j < 4; ++j) {
        int i = i0 + j;
        float val = (i >= jj) ? at[nn][j] * expf(gi[j] - gj) : 0.f;
        Atm[i * 72 + jj] = f2bf(val);
      }
    }
    __syncthreads();
    f32x4 vn[4];
#pragma unroll
    for (int nn = 0; nn < 4; ++nn) vn[nn] = f32x4{0.f, 0.f, 0.f, 0.f};
    wave_mma<4, 2>(Tms, 72, mP * 16, Rt, 72, nP0 * 16, vn, lane);
#pragma unroll
    for (int nn = 0; nn < 4; ++nn) {
      const int v = (nP0 + nn) * 16 + r;
      *(uint2*)(Vnt + v * 72 + i0) = uint2{cvtpk(vn[nn][0], vn[nn][1]), cvtpk(vn[nn][2], vn[nn][3])};
    }
    __syncthreads();
#pragma unroll
    for (int nn = 0; nn < 4; ++nn)
#pragma unroll
      for (int j = 0; j < 4; ++j) qs[nn][j] *= egi[j];
    wave_mma<4, 2>(Atm, 72, mP * 16, Vnt, 72, nP0 * 16, qs, lane);
#pragma unroll
    for (int j = 0; j < 4; ++j) {
      const int pp = n * 64 + i0 + j;
      const int t = base + (dir ? len - 1 - pp : pp);
#pragma unroll
      for (int nn = 0; nn < 4; ++nn) OUT[(size_t)t * 512 + h * 128 + (nP0 + nn) * 16 + r] = f2bf(qs[nn][j]);
    }
    const float egl = sEG[63];
#pragma unroll
    for (int n8 = 0; n8 < 8; ++n8)
#pragma unroll
      for (int j = 0; j < 4; ++j) ST[n8][j] *= egl;
    wave_mma<8, 2>(Vnt, 72, w * 16, Kdt, 72, 0, ST, lane);
#pragma unroll
    for (int n8 = 0; n8 < 8; ++n8)
#pragma unroll
      for (int j = 0; j < 4; ++j) St[(w * 16 + q * 4 + j) * 136 + n8 * 16 + r] = f2bf(ST[n8][j]);
    __syncthreads();
  }
  if (!g2) {
#pragma unroll
    for (int n8 = 0; n8 < 8; ++n8)
#pragma unroll
      for (int j = 0; j < 4; ++j)
        p.out[OSD + (((((size_t)s * 2 + l) * 2 + dir) * 4 + h) * 128 + (n8 * 16 + r)) * 128 + (w * 16 + q * 4 + j)] = ST[n8][j];
  }
  __syncthreads();
}

DI void phase_dn_scan(const Params& p, int l, u16* smem, int* s_item, int tid) {
  int* ctr = (int*)(p.ws + WS_CTR) + l * 4 + 1;
  while (true) {
    if (tid == 0) *s_item = atomicAdd(ctr, 1);
    __syncthreads();
    const int it = *s_item;
    __syncthreads();
    if (it >= 320) break;
    const int a = (it < 64) ? it : it - 64;
    dn_scan_item(p, l, (it < 64 ? 32 : 0) + (a >> 3), (a >> 1) & 3, a & 1, smem, tid);
  }
}

DI void phase_dn_post(const Params& p, int l, int tid, int bid, int nblk) {
  const int lane = tid & 63;
  const int gw = bid * 8 + (tid >> 6), nw = nblk * 8;
  u16* OF = ws_slab(p, 7); const u16* OB = ws_slab(p, 8); const u16* DG = ws_slab(p, 5);
  const float* nwp = p.k.in[21] + l * 128 + (lane & 15) * 8;
  for (int t = gw; t < TT; t += nw) {
    size_t off = (size_t)t * 512 + lane * 8;
    uint4 a = *(const uint4*)(OF + off), b = *(const uint4*)(OB + off), g = *(const uint4*)(DG + off);
    unsigned au[4] = {a.x, a.y, a.z, a.w}, bu[4] = {b.x, b.y, b.z, b.w}, gu[4] = {g.x, g.y, g.z, g.w};
    float y[8];
    float ss = 0.f;
#pragma unroll
    for (int e = 0; e < 4; ++e) {
      y[2 * e] = bflo(au[e]) + bflo(bu[e]); y[2 * e + 1] = bfhi(au[e]) + bfhi(bu[e]);
      ss += y[2 * e] * y[2 * e] + y[2 * e + 1] * y[2 * e + 1];
    }
    float rn = rsqrtf(sum16(ss) * (1.f / 128.f) + EPSF);
    unsigned o[4];
#pragma unroll
    for (int e = 0; e < 4; ++e) {
      float y0 = y[2 * e] * rn * nwp[2 * e] * silu_f(bflo(gu[e]));
      float y1 = y[2 * e + 1] * rn * nwp[2 * e + 1] * silu_f(bfhi(gu[e]));
      o[e] = cvtpk(y0, y1);
    }
    *(uint4*)(OF + off) = uint4{o[0], o[1], o[2], o[3]};
  }
}

#define PHASE_BEGIN int t_ = tid, b_ = bid, l_ = l; size_t z_ = 0; \
  asm volatile("" : "+v"(t_)); asm volatile("" : "+s"(b_)); asm volatile("" : "+s"(l_)); asm volatile("" : "+s"(z_)); \
  unsigned char* w_ = kp.ws + z_; float* o_ = kp.out + z_; \
  Params q{kp, o_, w_};

__global__ void __launch_bounds__(NTHREADS) trunk_megakernel(KParams kp) {
  __shared__ __attribute__((aligned(16))) u16 smem[73728];
  __shared__ int s_item;
  cg::grid_group grid = cg::this_grid();
  const int tid = threadIdx.x, bid = blockIdx.x, nblk = gridDim.x;
#pragma unroll 1
  for (int l = 0; l < 2; ++l) {
    if (PH(0)) { PHASE_BEGIN phase_convert(q, l_, smem, t_, b_, nblk); }
    grid.sync();
    if (PH(1)) { PHASE_BEGIN phase_norm(q, l_, 0, l_ == 0, t_, b_, nblk); }
    grid.sync();
    if (PH(2)) { PHASE_BEGIN phase_g1(q, 0, smem, t_, b_, nblk); }
    grid.sync();
    if (PH(3)) { PHASE_BEGIN phase_g2(q, l_, 0, l_ == 0, smem, t_, b_, nblk); }
    grid.sync();
    if (PH(4)) { PHASE_BEGIN phase_norm(q, l_, 1, false, t_, b_, nblk); }
    grid.sync();
    if (PH(5)) { PHASE_BEGIN phase_g3a(q, smem, t_, b_, nblk); }
    grid.sync();
    if (PH(6)) { PHASE_BEGIN phase_prep(q, l_, t_, b_, nblk); }
    grid.sync();
    if (PH(7)) { PHASE_BEGIN phase_mix_ab(q, l_, smem, &s_item, t_); }
    grid.sync();
    if (PH(8)) { PHASE_BEGIN phase_g3b(q, smem, t_, b_, nblk); }
    grid.sync();
    if (PH(9)) { PHASE_BEGIN phase_dn_pre(q, l_, smem, t_, b_, nblk); }
    grid.sync();
    if (PH(10)) { PHASE_BEGIN phase_dn_scan(q, l_, smem, &s_item, t_); }
    grid.sync();
    if (PH(11)) { PHASE_BEGIN phase_dn_post(q, l_, t_, b_, nblk); }
    grid.sync();
    if (PH(12)) { PHASE_BEGIN phase_merge(q, smem, t_, b_, nblk); }
    grid.sync();
    if (PH(13)) { PHASE_BEGIN phase_g5(q, l_, smem, t_, b_, nblk); }
    grid.sync();
    if (PH(14)) { PHASE_BEGIN phase_norm(q, l_, 2, false, t_, b_, nblk); }
    grid.sync();
    if (PH(15)) { PHASE_BEGIN phase_g1(q, 1, smem, t_, b_, nblk); }
    grid.sync();
    if (PH(16)) { PHASE_BEGIN phase_g2(q, l_, 1, false, smem, t_, b_, nblk); }
    grid.sync();
  }
  if (PH(17)) { Params q{kp, kp.out, kp.ws}; phase_final_norm(q, tid, bid, nblk); }
}

extern "C" void kernel_launch(void* const* d_in, const int* in_sizes, int n_in, void* d_out, int out_size, void* d_ws, size_t ws_size,
                              hipStream_t stream) {
  static int grid_blocks = 0;
  if (!grid_blocks) {
    int dev = 0, cus = 0, per_cu = 0;
    hipGetDevice(&dev);
    hipDeviceGetAttribute(&cus, hipDeviceAttributeMultiprocessorCount, dev);
    hipOccupancyMaxActiveBlocksPerMultiprocessor(&per_cu, trunk_megakernel, NTHREADS, 0);
    if (per_cu < 1) per_cu = 1;
    grid_blocks = cus * per_cu;
  }
  if (ws_size < WS_END) { fprintf(stderr, "workspace too small: %zu < %zu\n", ws_size, (size_t)WS_END); return; }
  KParams p{};
  for (int i = 0; i < 30; ++i) p.in[i] = (const float*)d_in[i];
  p.out = (float*)d_out;
  p.ws = (unsigned char*)d_ws;
  void* args[] = {&p};
  hipError_t e = hipLaunchCooperativeKernel((void*)trunk_megakernel, dim3(grid_blocks), dim3(NTHREADS), args, 0, stream);
  if (e != hipSuccess) fprintf(stderr, "cooperative launch failed: %s (grid %d)\n", hipGetErrorString(e), grid_blocks);
}
```

```cpp
#include <hip/hip_runtime.h>
#include <hip/hip_cooperative_groups.h>
#include <cstdio>
namespace cg = cooperative_groups;

typedef unsigned short u16;
using bf16x8 = __attribute__((ext_vector_type(8))) short;
using f32x4 = __attribute__((ext_vector_type(4))) float;
#define DI __device__ __forceinline__

constexpr int TT = 40960;
constexpr int TI = 8192;
constexpr int DM = 1024;
constexpr int DFF = 2816;
constexpr float EPSF = 1e-6f;
constexpr int NTHREADS = 512;
constexpr int LDS_WORK = 161536;
constexpr int LDS_DYN = LDS_WORK + 32;
#ifndef PHMASK
#define PHMASK 0xffffffffu
#endif
#define PH(i) ((PHMASK >> (i)) & 1u)

constexpr size_t OCK = 41943040, OCV = 44040192, OSR = 46137344, OSD = 50331648;

constexpr size_t W1IN = 0, W1OUT = 5767168, WIN = 8650752, WBR = 17039360, WOUT = 18612224, W2IN = 19660800, W2OUT = 25427968, WTOTAL = 28311552;
constexpr size_t WS_W = 0;
constexpr size_t WS_H = WTOTAL * 2;
constexpr size_t SLABB = (size_t)TT * 512 * 2;
constexpr size_t WS_SLAB = WS_H + (size_t)TT * 1024 * 2;
constexpr size_t WS_MODS = WS_SLAB + 9 * SLABB;
constexpr size_t WS_DAB = WS_MODS + 2 * 9 * 9216 * 4;
constexpr size_t WS_GBG = WS_DAB + (size_t)TT * 16 * 4;
constexpr size_t WS_GBB = WS_GBG + (size_t)TT * 8 * 4;
constexpr size_t WS_HALO = WS_GBB + (size_t)TT * 8 * 4;
constexpr size_t WS_CTR = WS_HALO + (size_t)640 * 2 * 1536 * 2;
constexpr size_t WS_ROPE = WS_CTR + 256;
constexpr size_t WS_END = WS_ROPE + 2 * 1024 * 4;
constexpr size_t KC_VT_OFF = 5505024;

struct KParams {
  const float* in[30];
  float* out;
  unsigned char* ws;
};
struct Params {
  const KParams& k;
  float* out;
  unsigned char* ws;
};

typedef __bf16 bf16v2_t __attribute__((ext_vector_type(2)));
typedef float f32v2_t __attribute__((ext_vector_type(2)));
typedef float f32x2_t __attribute__((ext_vector_type(2)));
DI unsigned cvtpk(float lo, float hi) { f32v2_t v = {lo, hi}; bf16v2_t b = __builtin_convertvector(v, bf16v2_t); return __builtin_bit_cast(unsigned, b); }
DI u16 f2bf(float x) { return (u16)(cvtpk(x, 0.f) & 0xffffu); }
DI float bf2f(u16 h) { return __uint_as_float(((unsigned)h) << 16); }
DI float bflo(unsigned u) { return __uint_as_float(u << 16); }
DI float bfhi(unsigned u) { return __uint_as_float(u & 0xffff0000u); }
DI f32x4 mfma16(bf16x8 a, bf16x8 b, f32x4 c) { return __builtin_amdgcn_mfma_f32_16x16x32_bf16(a, b, c, 0, 0, 0); }
DI float silu_f(float x) { return x / (1.f + __expf(-x)); }
DI float sigmoid_f(float x) { return 1.f / (1.f + __expf(-x)); }
DI float wave_sum(float x) {
#pragma unroll
  for (int o = 32; o >= 1; o >>= 1) x += __shfl_xor(x, o);
  return x;
}
DI float sum16(float x) {
  x += __shfl_xor(x, 1); x += __shfl_xor(x, 2); x += __shfl_xor(x, 4); x += __shfl_xor(x, 8);
  return x;
}
DI float max16(float x) {
  x = fmaxf(x, __shfl_xor(x, 1)); x = fmaxf(x, __shfl_xor(x, 2)); x = fmaxf(x, __shfl_xor(x, 4)); x = fmaxf(x, __shfl_xor(x, 8));
  return x;
}
DI void lds_barrier() { asm volatile("s_waitcnt lgkmcnt(0)" ::: "memory"); __builtin_amdgcn_s_barrier(); asm volatile("" ::: "memory"); }
DI int seq_base(int s) { return s < 32 ? s * 256 : TI + (s - 32) * 4096; }
DI int seq_len(int s) { return s < 32 ? 256 : 4096; }
DI int modrow_of(int t) { return t < TI ? 0 : 1 + ((t - TI) >> 12); }
DI const float* xin_row(const Params& p, int t) { return t < TI ? p.k.in[0] + (size_t)t * DM : p.k.in[1] + (size_t)(t - TI) * DM; }
DI size_t kv_base(int s, int kvh) { return s < 32 ? (size_t)(s * 2 + kvh) * (256 * 64) : (size_t)1048576 + (size_t)((s - 32) * 2 + kvh) * (4352 * 64); }

DI u16* ws_w(const Params& p) { return (u16*)(p.ws + WS_W); }
DI u16* ws_h(const Params& p) { return (u16*)(p.ws + WS_H); }
DI u16* ws_slab(const Params& p, int i) { return (u16*)(p.ws + WS_SLAB + (size_t)i * SLABB); }
DI float* ws_mods(const Params& p) { return (float*)(p.ws + WS_MODS); }

template <int NT, int KS>
DI void wave_mma(const u16* A, int lda, int arow0, const u16* B, int ldb, int brow0, f32x4 (&acc)[NT], int lane) {
  const int r = lane & 15, q = lane >> 4;
#pragma unroll
  for (int ks = 0; ks < KS; ++ks) {
    bf16x8 a = *(const bf16x8*)(A + (arow0 + r) * lda + ks * 32 + q * 8);
#pragma unroll
    for (int n = 0; n < NT; ++n) {
      bf16x8 b = *(const bf16x8*)(B + (brow0 + n * 16 + r) * ldb + ks * 32 + q * 8);
      acc[n] = mfma16(a, b, acc[n]);
    }
  }
}

namespace pg8 {
#define PG8_LAS __attribute__((address_space(3)))
typedef unsigned short bf16_t;
typedef short bf16x8 __attribute__((ext_vector_type(8)));
typedef float f32x4 __attribute__((ext_vector_type(4)));
typedef unsigned u32x4 __attribute__((ext_vector_type(4)));
constexpr int BM = 256, BK = 64, HALF = 128, HTB = HALF * BK * 2  , STAGE_BYTES = 8 * HTB, NXCD = 8, WGM = 8;

__host__ __device__ __forceinline__ int lds_byte(int r, int c) { const int st = (r >> 4) * 2 + (c >> 5), rr = r & 15, cc = c & 31, ob = rr * 64 + cc * 2; return st * 1024 + (ob ^ (((ob >> 9) & 1) << 5)); }
__host__ __device__ __forceinline__ void stage_rc(int b, int& R, int& C) { const int st = b / 1024, sb = b % 1024, swz = sb ^ (((sb >> 9) & 1) << 5); R = (st >> 1) * 16 + swz / 64; C = (st & 1) * 32 + (swz % 64) / 2; }
__host__ __device__ __forceinline__ int perm32(int rho) { const int n = rho >> 4, i = rho & 15; return 8 * (i >> 2) + 4 * n + (i & 3); }

struct Unit { int pm, pn; };
struct Gemm { const bf16_t* A; const bf16_t* Bt; int M, N, K; };

struct StaticOrder {
    int nM, nN, nwg, G, c;
    __host__ __device__ void init(int M, int N, int G_, int c_) { nM = M / BM; nN = N / BM; nwg = nM * nN; G = G_; c = c_; }
    __host__ __device__ bool next(int i, Unit& u) const {
        const long L = (long)i * G + c; if (L >= nwg) return false;
        int wgid = (int)L; { const int q = nwg / NXCD, r = nwg % NXCD, xcd = wgid % NXCD, off = wgid / NXCD; wgid = (xcd < r ? xcd * (q + 1) : r * (q + 1) + (xcd - r) * q) + off; }
        const int nig = WGM * nN, gid = wgid / nig, fm = gid * WGM, gsz = (nM - fm) < WGM ? (nM - fm) : WGM;
        u.pm = fm + ((wgid % nig) % gsz); u.pn = (wgid % nig) / gsz; return true;
    }
    __device__ __forceinline__ void a_ready(const Unit&) const {}
    __device__ __forceinline__ void done(const Unit&) const {}
};
template <class Epi, class Sched, bool STAMP = false>
__device__ __forceinline__ void gemm_phase(PG8_LAS unsigned char* lds, const Gemm g, const Sched& S, const Epi& E, unsigned long long* stamps, int tid_in) {
    const int tid = tid_in, wid = __builtin_amdgcn_readfirstlane(tid >> 6), lane = tid & 63, wr = wid >> 2, wc = wid & 3, fr = lane & 15, fq = lane >> 4;
    const int K = g.K, nt = K / BK;
    float zf_ = 0.f; asm volatile("" : "+v"(zf_));
    int ts_lo = 0, ts_hi = 0, nts = 0; const unsigned long long rt_entry = STAMP ? (unsigned long long)wall_clock64() : 0ull;
#define PG8_STAMP() do { if (STAMP && wid == 0 && nts < 64) { const unsigned long long _c = (unsigned long long)clock64(); \
        ts_lo = (lane == nts) ? (int)(unsigned)_c : ts_lo; ts_hi = (lane == nts) ? (int)(unsigned)(_c >> 32) : ts_hi; ++nts; } } while (0)
    PG8_STAMP();
    unsigned voffA[2], voffB[2];
#pragma unroll
    for (int i = 0; i < 2; ++i) { int R, C; stage_rc(tid * 16 + i * 8192, R, C); const int Rb = Epi::PERM ? ((R & ~31) + perm32(R & 31)) : R;
        voffA[i] = (unsigned)(R * K + C) * 2u; voffB[i] = (unsigned)(Rb * K + C) * 2u; }
    const size_t kstep = (size_t)(BK * 2);
    const size_t hstep = (size_t)HALF * K * 2;
    const size_t tstep = 2 * hstep;
    const unsigned ldsw = (unsigned)wid * 1024u;
    const int aoff = lds_byte(wr * 64 + fr, fq * 8), boff = lds_byte(wc * 32 + fr, fq * 8);
#define PG8_SA(b, h) (((b) * 2 + (h)) * HTB)
#define PG8_SB(b, h) ((4 + (b) * 2 + (h)) * HTB)
#define PG8_STAGE(bufoff, gbase, voff) do { _Pragma("unroll") for (int _i = 0; _i < 2; ++_i) \
        __builtin_amdgcn_global_load_lds((const unsigned*)((const char*)(gbase) + (voff)[_i]), (PG8_LAS unsigned*)(lds + (bufoff) + ldsw + _i * 8192), 16, 0, 0); } while (0)
#define PG8_LDA(dst, b, h) do { _Pragma("unroll") for (int m = 0; m < 4; ++m) _Pragma("unroll") for (int k = 0; k < 2; ++k) dst[m][k] = *(const PG8_LAS bf16x8*)(lds + PG8_SA(b, h) + aoff + m * 2048 + k * 1024); } while (0)
#define PG8_LDB(dst, b, h) do { _Pragma("unroll") for (int n = 0; n < 2; ++n) _Pragma("unroll") for (int k = 0; k < 2; ++k) dst[n][k] = *(const PG8_LAS bf16x8*)(lds + PG8_SB(b, h) + boff + n * 2048 + k * 1024); } while (0)
#define PG8_MMA(ai, bj, At, Bt) do { __builtin_amdgcn_s_setprio(1); _Pragma("unroll") for (int m = 0; m < 4; ++m) _Pragma("unroll") for (int n = 0; n < 2; ++n) _Pragma("unroll") for (int k = 0; k < 2; ++k) \
        acc[ai][bj][m][n] = __builtin_amdgcn_mfma_f32_16x16x32_bf16(Bt[n][k], At[m][k], acc[ai][bj][m][n], 0, 0, 0); __builtin_amdgcn_s_setprio(0); } while (0)
#define PG8_WAIT_V(n) asm volatile("s_waitcnt vmcnt(" #n ")" ::: "memory")
#define PG8_WAIT_L(n) asm volatile("s_waitcnt lgkmcnt(" #n ")" ::: "memory")
#define PG8_BAR __builtin_amdgcn_s_barrier()
#define PG8_SCHED __builtin_amdgcn_sched_barrier(0)
    Unit cur, nxt; int ui = 0;
    if (!S.next(0, cur)) return;
    f32x4 acc[2][2][4][2];
#pragma unroll
    for (int a = 0; a < 2; ++a)
#pragma unroll
        for (int b = 0; b < 2; ++b)
#pragma unroll
            for (int m = 0; m < 4; ++m)
#pragma unroll
                for (int n = 0; n < 2; ++n) acc[a][b][m][n] = (f32x4){zf_, zf_, zf_, zf_};
    bf16x8 At[4][2], B0[2][2], B1[2][2];
    const char* cA = (const char*)g.A + (size_t)cur.pm * tstep; const char* cB = (const char*)g.Bt + (size_t)cur.pn * tstep;
    S.a_ready(cur);
    PG8_STAGE(PG8_SB(0, 0), cB, voffB); PG8_STAGE(PG8_SA(0, 0), cA, voffA); PG8_STAGE(PG8_SB(0, 1), cB + hstep, voffB); PG8_STAGE(PG8_SA(0, 1), cA + hstep, voffA);
    if (wr == 1) PG8_BAR;
    PG8_WAIT_V(4); PG8_BAR;
    PG8_STAGE(PG8_SB(1, 0), cB + kstep, voffB); PG8_STAGE(PG8_SA(1, 0), cA + kstep, voffA); PG8_STAGE(PG8_SB(1, 1), cB + hstep + kstep, voffB);
    PG8_WAIT_V(6); PG8_BAR;
    PG8_STAMP();
    for (;;) {
        const bool has_next = S.next(ui + 1, nxt);
        const char* nA = has_next ? (const char*)g.A + (size_t)nxt.pm * tstep : cA; const char* nB = has_next ? (const char*)g.Bt + (size_t)nxt.pn * tstep : cB;
        for (int t = 0; t < nt; t += 2) {
            const bool last = (t == nt - 2);
            const char* a1 = cA + (size_t)(t + 1) * kstep;
            const char* a2 = last ? nA : cA + (size_t)(t + 2) * kstep; const char* b2 = last ? nB : cB + (size_t)(t + 2) * kstep;
            const char* a3 = a2 + kstep; const char* b3 = b2 + kstep;
            if (last && has_next) S.a_ready(nxt);
            PG8_LDB(B0, 0, 0); PG8_SCHED; PG8_LDA(At, 0, 0); PG8_STAGE(PG8_SA(1, 1), a1 + hstep, voffA);
            PG8_WAIT_L(8); PG8_BAR; PG8_WAIT_L(0); PG8_MMA(0, 0, At, B0); PG8_BAR; PG8_SCHED;
            PG8_LDB(B1, 0, 1); PG8_STAGE(PG8_SB(0, 0), b2, voffB);
            PG8_BAR; PG8_WAIT_L(0); PG8_MMA(0, 1, At, B1); PG8_BAR;
            PG8_LDA(At, 0, 1); PG8_STAGE(PG8_SA(0, 0), a2, voffA);
            PG8_BAR; PG8_WAIT_L(0); PG8_MMA(1, 0, At, B0); PG8_BAR; PG8_SCHED;
            PG8_STAGE(PG8_SB(0, 1), b2 + hstep, voffB);
            PG8_WAIT_V(6); PG8_BAR; PG8_MMA(1, 1, At, B1); PG8_BAR;
            PG8_LDB(B0, 1, 0); PG8_SCHED; PG8_LDA(At, 1, 0); PG8_STAGE(PG8_SA(0, 1), a2 + hstep, voffA);
            PG8_WAIT_L(8); PG8_BAR; PG8_WAIT_L(0); PG8_MMA(0, 0, At, B0); PG8_BAR; PG8_SCHED;
            PG8_LDB(B1, 1, 1); PG8_STAGE(PG8_SB(1, 0), b3, voffB);
            PG8_BAR; PG8_WAIT_L(0); PG8_MMA(0, 1, At, B1); PG8_BAR;
            PG8_LDA(At, 1, 1); PG8_STAGE(PG8_SA(1, 0), a3, voffA);
            PG8_BAR; PG8_WAIT_L(0); PG8_MMA(1, 0, At, B0); PG8_BAR; PG8_SCHED;
            PG8_STAGE(PG8_SB(1, 1), b3 + hstep, voffB);
            PG8_WAIT_V(6); PG8_BAR; PG8_MMA(1, 1, At, B1); PG8_BAR;
        }
        PG8_STAMP();
        if constexpr (!Epi::AFTER_DRAIN) { E(acc, cur, wr, wc, fr, fq); S.done(cur); }
        PG8_STAMP();
        if (!has_next) break;
#pragma unroll
        for (int a = 0; a < 2; ++a)
#pragma unroll
            for (int b = 0; b < 2; ++b)
#pragma unroll
                for (int m = 0; m < 4; ++m)
#pragma unroll
                    for (int n = 0; n < 2; ++n) acc[a][b][m][n] = (f32x4){zf_, zf_, zf_, zf_};
        cur = nxt; cA = nA; cB = nB; ++ui;
    }
    PG8_WAIT_V(0);
    if (wr == 0) PG8_BAR;
    PG8_BAR;
    if constexpr (Epi::AFTER_DRAIN) { E.fused(acc, cur, wr, wc, fr, fq, lds, wid, lane); S.done(cur); }
    PG8_STAMP();
    if (STAMP && wid == 0) { stamps[lane] = lane < nts ? (((unsigned long long)(unsigned)ts_hi << 32) | (unsigned)ts_lo) : 0ull;
        if (lane == 62) stamps[62] = rt_entry; if (lane == 63) stamps[63] = (unsigned long long)wall_clock64(); }
#undef PG8_STAMP
#undef PG8_SA
#undef PG8_SB
#undef PG8_STAGE
#undef PG8_LDA
#undef PG8_LDB
#undef PG8_MMA
#undef PG8_WAIT_V
#undef PG8_WAIT_L
#undef PG8_BAR
#undef PG8_SCHED
}
}

template <int MT>
DI void zero_acc(f32x4 (&acc)[MT][4]) {
#pragma unroll
  for (int m = 0; m < MT; ++m)
#pragma unroll
    for (int n = 0; n < 4; ++n) acc[m][n] = f32x4{0.f, 0.f, 0.f, 0.f};
}

DI int map_row(int type, int col) {
  if (type == 0) return col;
  if (type == 1) { if (col < DFF) return 256 * (col >> 7) + (col & 127); int c = col - DFF; return 256 * (c >> 7) + 128 + (c & 127); }
  if (col < 4352) return col;
  if (col < 4368) return 2816 + 1536 + (col - 4352);
  if (col < 4880) return 2816 + 1792 + (col - 4368);
  return 5120 + (col - 4880);
}

DI void conv_tile(const float* __restrict__ src, int ld, int ncols, int k0, int c0, u16* __restrict__ dst, int K, int type, u16* sm, int tid) {
  {
    const int n = tid & 63, kk = tid >> 6;
    const bool ok = (c0 + n) < ncols;
#pragma unroll
    for (int i = 0; i < 8; ++i) {
      int k = kk + 8 * i;
      float v = ok ? src[(size_t)(k0 + k) * ld + c0 + n] : 0.f;
      sm[n * 72 + k] = f2bf(v);
    }
  }
  lds_barrier();
  {
    const int n2 = tid >> 3, seg = tid & 7;
    const int col = c0 + n2;
    if (col < ncols) {
      int row = map_row(type, col);
      *(uint4*)(dst + (size_t)row * K + k0 + seg * 8) = *(const uint4*)(sm + n2 * 72 + seg * 8);
    }
  }
  lds_barrier();
}

DI void phase_convert(const Params& p, int l, u16* smem, int tid, int bid, int nblk) {
  u16* W = ws_w(p);
  const int NJ = 9;
  const int cum[NJ + 1] = {0, 1408, 2112, 4112, 4240, 4368, 4496, 4752, 6160, 6864};
  const int nconv = 6864;
  const int nmod = 0;
  const int total = nconv + 1 + nmod;
  for (int it = bid; it < total; it += nblk) {
    if (it < nconv) {
      int j = 0;
#pragma unroll
      for (int jj = 1; jj < NJ; ++jj) if (it >= cum[jj]) j = jj;
      int t = it - cum[j];
      const float* src; int ld, ncols, K, type = 0, nct; u16* dst;
      switch (j) {
        case 0: src = p.k.in[11] + (size_t)l * 1024 * 5632; ld = 5632; ncols = 5632; K = 1024; type = 1; nct = 88; dst = W + W1IN; break;
        case 1: src = p.k.in[12] + (size_t)l * 2816 * 1024; ld = 1024; ncols = 1024; K = 2816; nct = 16; dst = W + W1OUT; break;
        case 2: src = p.k.in[14] + (size_t)l * 1024 * 7952; ld = 7952; ncols = 7952; K = 1024; type = 2; nct = 125; dst = W + WIN; break;
        case 3: src = p.k.in[22] + (size_t)l * 512 * 1024; ld = 1024; ncols = 1024; K = 512; nct = 16; dst = W + WBR; break;
        case 4: src = p.k.in[23] + (size_t)l * 512 * 1024; ld = 1024; ncols = 1024; K = 512; nct = 16; dst = W + WBR + 524288; break;
        case 5: src = p.k.in[24] + (size_t)l * 512 * 1024; ld = 1024; ncols = 1024; K = 512; nct = 16; dst = W + WBR + 2 * 524288; break;
        case 6: src = p.k.in[25] + (size_t)l * 1024 * 1024; ld = 1024; ncols = 1024; K = 1024; nct = 16; dst = W + WOUT; break;
        case 7: src = p.k.in[27] + (size_t)l * 1024 * 5632; ld = 5632; ncols = 5632; K = 1024; type = 1; nct = 88; dst = W + W2IN; break;
        default: src = p.k.in[28] + (size_t)l * 2816 * 1024; ld = 1024; ncols = 1024; K = 2816; nct = 16; dst = W + W2OUT; break;
      }
      int kt = t / nct, ct = t % nct;
      conv_tile(src, ld, ncols, kt * 64, ct * 64, dst, K, type, smem, tid);
    } else if (it == nconv) {
      u16* z = W + WIN + (size_t)(2816 + 1552) * 1024;
      unsigned zu = 0u; asm volatile("" : "+v"(zu));
      for (int i = tid; i < 240 * 1024 / 8; i += NTHREADS) *(uint4*)(z + i * 8) = uint4{zu, zu, zu, zu};
    }
  }
}

DI void phase_mods(const Params& p, u16* smem, int tid, int bid, int nblk) {
  if (bid == 0 && tid < 64) ((int*)(p.ws + WS_CTR))[tid] = 0;
  if (bid == 1) {
    float* ROPE = (float*)(p.ws + WS_ROPE);
    for (int i = tid; i < 1024; i += NTHREADS) {
      float inv = exp2f(-(float)(i & 15) * (13.287712379549449f / 16.f));
      float sn, cs;
      sincosf((float)(i >> 4) * inv, &sn, &cs);
      ROPE[i] = cs; ROPE[1024 + i] = sn;
    }
  }
  const int nconv = -1;
  for (int it = bid; it < 288; it += nblk) {
    {
      int mi = it - nconv - 1;
      int ml = mi / 144, cb = mi % 144;
      float* sc = (float*)smem;
      float* red = sc + 9 * 1024;
      for (int i = tid; i < 9 * 1024; i += NTHREADS) {
        int r = i >> 10, k = i & 1023;
        float c = (r == 0) ? p.k.in[7][k] : p.k.in[6][(r - 1) * 1024 + k];
        sc[i] = silu_f(c);
      }
      __syncthreads();
      const int n = tid & 63, kg = tid >> 6;
      const float* Wm = p.k.in[8] + (size_t)ml * 1024 * 9216 + cb * 64 + n;
      float a[9];
#pragma unroll
      for (int r = 0; r < 9; ++r) a[r] = 0.f;
#pragma unroll 8
      for (int k = kg * 128; k < kg * 128 + 128; ++k) {
        float wv = Wm[(size_t)k * 9216];
#pragma unroll
        for (int r = 0; r < 9; ++r) a[r] += sc[r * 1024 + k] * wv;
      }
#pragma unroll
      for (int r = 0; r < 9; ++r) red[(kg * 9 + r) * 64 + n] = a[r];
      __syncthreads();
      for (int i = tid; i < 576; i += NTHREADS) {
        int r = i >> 6, nn = i & 63;
        float s = p.k.in[9][(size_t)ml * 9216 + cb * 64 + nn];
#pragma unroll
        for (int g = 0; g < 8; ++g) s += red[(g * 9 + r) * 64 + nn];
        ws_mods(p)[(size_t)(ml * 9 + r) * 9216 + cb * 64 + nn] = s;
      }
      __syncthreads();
    }
  }
}

DI void phase_norm(const Params& p, int l, int which, bool first, int tid, int bid, int nblk) {
  const int lane = tid & 63;
  const int gw = bid * 8 + (tid >> 6), nw = nblk * 8;
  const float* nwp = p.k.in[which == 0 ? 10 : (which == 1 ? 13 : 26)] + l * 1024;
  u16* H = ws_h(p);
  for (int t0 = gw; t0 < TT; t0 += 2 * nw) {
    const int t1 = t0 + nw;
    const bool has1 = t1 < TT;
    const float* xr0 = first ? xin_row(p, t0) : p.out + (size_t)t0 * DM;
    const float* xr1 = has1 ? (first ? xin_row(p, t1) : p.out + (size_t)t1 * DM) : xr0;
    float4 v[2][4];
#pragma unroll
    for (int i = 0; i < 4; ++i) { v[0][i] = *(const float4*)(xr0 + i * 256 + lane * 4); v[1][i] = *(const float4*)(xr1 + i * 256 + lane * 4); }
#pragma unroll
    for (int rr = 0; rr < 2; ++rr) {
      if (rr == 1 && !has1) break;
      const int t = rr ? t1 : t0;
      float ss = 0.f;
#pragma unroll
      for (int i = 0; i < 4; ++i) ss += v[rr][i].x * v[rr][i].x + v[rr][i].y * v[rr][i].y + v[rr][i].z * v[rr][i].z + v[rr][i].w * v[rr][i].w;
      ss = wave_sum(ss);
      const float rstd = rsqrtf(ss * (1.f / 1024.f) + EPSF);
      const float* mod = ws_mods(p) + (size_t)(l * 9 + modrow_of(t)) * 9216;
      const float* sh = mod + (3 * which) * 1024;
      const float* sc = mod + (3 * which + 1) * 1024;
#pragma unroll
      for (int i = 0; i < 4; ++i) {
        int c = i * 256 + lane * 4;
        float4 wv = *(const float4*)(nwp + c), s4 = *(const float4*)(sc + c), h4 = *(const float4*)(sh + c);
        float y0 = v[rr][i].x * rstd * wv.x * (1.f + s4.x) + h4.x;
        float y1 = v[rr][i].y * rstd * wv.y * (1.f + s4.y) + h4.y;
        float y2 = v[rr][i].z * rstd * wv.z * (1.f + s4.z) + h4.z;
        float y3 = v[rr][i].w * rstd * wv.w * (1.f + s4.w) + h4.w;
        *(uint2*)(H + (size_t)t * 1024 + c) = uint2{cvtpk(y0, y1), cvtpk(y2, y3)};
      }
    }
  }
}

DI void phase_final_norm(const Params& p, int tid, int bid, int nblk) {
  const int lane = tid & 63;
  const int gw = bid * 8 + (tid >> 6), nw = nblk * 8;
  const float* nwp = p.k.in[29];
  for (int t0 = gw; t0 < TT; t0 += 2 * nw) {
    const int t1 = t0 + nw;
    const bool has1 = t1 < TT;
    float* xr0 = p.out + (size_t)t0 * DM;
    float* xr1 = has1 ? p.out + (size_t)t1 * DM : xr0;
    float4 v[2][4];
#pragma unroll
    for (int i = 0; i < 4; ++i) { v[0][i] = *(const float4*)(xr0 + i * 256 + lane * 4); v[1][i] = *(const float4*)(xr1 + i * 256 + lane * 4); }
#pragma unroll
    for (int rr = 0; rr < 2; ++rr) {
      if (rr == 1 && !has1) break;
      float* xr = rr ? xr1 : xr0;
      float ss = 0.f;
#pragma unroll
      for (int i = 0; i < 4; ++i) ss += v[rr][i].x * v[rr][i].x + v[rr][i].y * v[rr][i].y + v[rr][i].z * v[rr][i].z + v[rr][i].w * v[rr][i].w;
      ss = wave_sum(ss);
      const float rstd = rsqrtf(ss * (1.f / 1024.f) + EPSF);
#pragma unroll
      for (int i = 0; i < 4; ++i) {
        int c = i * 256 + lane * 4;
        float4 wv = *(const float4*)(nwp + c);
        *(float4*)(xr + c) = float4{v[rr][i].x * rstd * wv.x, v[rr][i].y * rstd * wv.y, v[rr][i].z * rstd * wv.z, v[rr][i].w * rstd * wv.w};
      }
    }
  }
}

typedef __attribute__((address_space(3))) unsigned char lds_u8;

struct EpiSwiglu {
  static constexpr bool PERM = true, AFTER_DRAIN = false;
  u16* hid;
  DI void operator()(const f32x4 (&acc)[2][2][4][2], const pg8::Unit& u, int wr, int wc, int fr, int fq) const {
    const int row0 = u.pm * 256 + wr * 64 + fr, col0 = u.pn * 128 + wc * 32 + fq * 8;
#pragma unroll
    for (int ai = 0; ai < 2; ++ai)
#pragma unroll
      for (int m = 0; m < 4; ++m) {
        const f32x4 g0 = acc[ai][0][m][0], g1 = acc[ai][0][m][1], u0 = acc[ai][1][m][0], u1 = acc[ai][1][m][1];
        uint4 o;
        o.x = cvtpk(silu_f(g0[0]) * u0[0], silu_f(g0[1]) * u0[1]);
        o.y = cvtpk(silu_f(g0[2]) * u0[2], silu_f(g0[3]) * u0[3]);
        o.z = cvtpk(silu_f(g1[0]) * u1[0], silu_f(g1[1]) * u1[1]);
        o.w = cvtpk(silu_f(g1[2]) * u1[2], silu_f(g1[3]) * u1[3]);
        *(uint4*)(hid + (size_t)(row0 + ai * 128 + m * 16) * DFF + col0) = o;
      }
  }
};

struct EpiResid {
  static constexpr bool PERM = false, AFTER_DRAIN = false;
  const float* x0; const float* x1; float* out; const float* gm_base; float scale; bool first;
  DI const float* src_row(int row) const { return first ? (row < TI ? x0 + (size_t)row * DM : x1 + (size_t)(row - TI) * DM) : out + (size_t)row * DM; }
  DI void operator()(const f32x4 (&acc)[2][2][4][2], const pg8::Unit& u, int wr, int wc, int fr, int fq) const {
    const float* gm = gm_base + (size_t)modrow_of(u.pm * 256) * 9216;
    const int row0 = u.pm * 256 + wr * 64 + fr, col0 = u.pn * 256 + wc * 32 + 4 * fq;
    f32x4 gv[2][2];
#pragma unroll
    for (int bj = 0; bj < 2; ++bj)
#pragma unroll
      for (int n = 0; n < 2; ++n) gv[bj][n] = *(const f32x4*)(gm + col0 + bj * 128 + n * 16) * scale;
    f32x4 xa[2][2], xb[2][2];
    {
      const float* __restrict__ xr = src_row(row0) + col0;
      const float* __restrict__ xs = src_row(row0 + 16) + col0;
#pragma unroll
      for (int bj = 0; bj < 2; ++bj)
#pragma unroll
        for (int n = 0; n < 2; ++n) { xa[bj][n] = *(const f32x4*)(xr + bj * 128 + n * 16); xb[bj][n] = *(const f32x4*)(xs + bj * 128 + n * 16); }
    }
#pragma unroll
    for (int rr = 0; rr < 8; ++rr) {
      const int ai = rr >> 2, m = rr & 3;
      f32x4 nx[2][2];
      if (rr + 2 < 8) {
        const float* __restrict__ xr = src_row(row0 + ((rr + 2) >> 2) * 128 + ((rr + 2) & 3) * 16) + col0;
#pragma unroll
        for (int bj = 0; bj < 2; ++bj)
#pragma unroll
          for (int n = 0; n < 2; ++n) nx[bj][n] = *(const f32x4*)(xr + bj * 128 + n * 16);
      }
      float* __restrict__ xo = out + (size_t)(row0 + ai * 128 + m * 16) * DM + col0;
#pragma unroll
      for (int bj = 0; bj < 2; ++bj)
#pragma unroll
        for (int n = 0; n < 2; ++n) *(f32x4*)(xo + bj * 128 + n * 16) = xa[bj][n] + gv[bj][n] * acc[ai][bj][m][n];
#pragma unroll
      for (int bj = 0; bj < 2; ++bj)
#pragma unroll
        for (int n = 0; n < 2; ++n) { xa[bj][n] = xb[bj][n]; if (rr + 2 < 8) xb[bj][n] = nx[bj][n]; }
    }
  }
};

DI uint4 pack8(const f32x4& a, const f32x4& b) { return uint4{cvtpk(a[0], a[1]), cvtpk(a[2], a[3]), cvtpk(b[0], b[1]), cvtpk(b[2], b[3])}; }

struct EpiProjA {
  static constexpr bool PERM = true, AFTER_DRAIN = false;
  unsigned char* slab0;
  DI void operator()(const f32x4 (&acc)[2][2][4][2], const pg8::Unit& u, int wr, int wc, int fr, int fq) const {
    u16* dst; int ldd, c0;
    if (u.pn < 2) { dst = (u16*)slab0; ldd = 512; c0 = u.pn * 256; }
    else if (u.pn == 2) { dst = (u16*)(slab0 + 6 * SLABB); ldd = 256; c0 = 0; }
    else { dst = (u16*)(slab0 + (size_t)(2 + ((u.pn - 3) >> 1)) * SLABB); ldd = 512; c0 = ((u.pn - 3) & 1) * 256; }
    const int row0 = u.pm * 256 + wr * 64 + fr, col0 = c0 + wc * 32 + fq * 8;
#pragma unroll
    for (int ai = 0; ai < 2; ++ai)
#pragma unroll
      for (int m = 0; m < 4; ++m)
#pragma unroll
        for (int bj = 0; bj < 2; ++bj)
          *(uint4*)(dst + (size_t)(row0 + ai * 128 + m * 16) * ldd + col0 + bj * 128) = pack8(acc[ai][bj][m][0], acc[ai][bj][m][1]);
  }
};

struct EpiProjB {
  static constexpr bool PERM = true, AFTER_DRAIN = false;
  unsigned char* slab0; float* dab; u16* halo;
  DI void operator()(const f32x4 (&acc)[2][2][4][2], const pg8::Unit& u, int wr, int wc, int fr, int fq) const {
    const int row0 = u.pm * 256 + wr * 64 + fr;
    if (u.pn < 6) {
      u16* dst = (u16*)(slab0 + (size_t)(2 + (u.pn >> 1)) * SLABB);
      const int col0 = (u.pn & 1) * 256 + wc * 32 + fq * 8;
      const int hcol0 = u.pn * 256 + wc * 32 + fq * 8;
#pragma unroll
      for (int ai = 0; ai < 2; ++ai)
#pragma unroll
        for (int m = 0; m < 4; ++m)
#pragma unroll
          for (int bj = 0; bj < 2; ++bj) {
            const int row = row0 + ai * 128 + m * 16;
            const uint4 v = pack8(acc[ai][bj][m][0], acc[ai][bj][m][1]);
            *(uint4*)(dst + (size_t)row * 512 + col0 + bj * 128) = v;
            if (m == 0 && fr == 0) *(uint4*)(halo + ((size_t)(row >> 6) * 2 + 0) * 1536 + hcol0 + bj * 128) = v;
            if (m == 3 && fr == 15) *(uint4*)(halo + ((size_t)(row >> 6) * 2 + 1) * 1536 + hcol0 + bj * 128) = v;
          }
    } else {
      if (wc == 0 && fq < 2) {
#pragma unroll
        for (int ai = 0; ai < 2; ++ai)
#pragma unroll
          for (int m = 0; m < 4; ++m)
#pragma unroll
            for (int n = 0; n < 2; ++n)
              *(f32x4*)(dab + (size_t)(row0 + ai * 128 + m * 16) * 16 + 8 * fq + 4 * n) = acc[ai][0][m][n];
      }
    }
  }
};

struct EpiProjDG {
  static constexpr bool PERM = true, AFTER_DRAIN = false;
  u16* dst;
  DI void operator()(const f32x4 (&acc)[2][2][4][2], const pg8::Unit& u, int wr, int wc, int fr, int fq) const {
    const int row0 = u.pm * 256 + wr * 64 + fr, col0 = u.pn * 256 + wc * 32 + fq * 8;
#pragma unroll
    for (int ai = 0; ai < 2; ++ai)
#pragma unroll
      for (int m = 0; m < 4; ++m)
#pragma unroll
        for (int bj = 0; bj < 2; ++bj)
          *(uint4*)(dst + (size_t)(row0 + ai * 128 + m * 16) * 512 + col0 + bj * 128) = pack8(acc[ai][bj][m][0], acc[ai][bj][m][1]);
  }
};

DI f32x4 sig4(const f32x4& a) { return f32x4{sigmoid_f(a[0]), sigmoid_f(a[1]), sigmoid_f(a[2]), sigmoid_f(a[3])}; }

struct EpiMG {
  static constexpr bool PERM = true, AFTER_DRAIN = false;
  u16* G;
  DI void operator()(const f32x4 (&acc)[2][2][4][2], const pg8::Unit& u, int wr, int wc, int fr, int fq) const {
    const int row0 = u.pm * 256 + wr * 64 + fr, col0 = u.pn * 256 + wc * 32 + fq * 8;
#pragma unroll
    for (int ai = 0; ai < 2; ++ai)
#pragma unroll
      for (int m = 0; m < 4; ++m)
#pragma unroll
        for (int bj = 0; bj < 2; ++bj)
          *(uint4*)(G + (size_t)(row0 + ai * 128 + m * 16) * 3072 + col0 + bj * 128) = pack8(sig4(acc[ai][bj][m][0]), sig4(acc[ai][bj][m][1]));
  }
};

struct EpiBR {
  static constexpr bool PERM = true, AFTER_DRAIN = false;
  const u16* G; u16* mrg; int b;
  DI void operator()(const f32x4 (&acc)[2][2][4][2], const pg8::Unit& u, int wr, int wc, int fr, int fq) const {
    const int row0 = u.pm * 256 + wr * 64 + fr, col0 = u.pn * 256 + wc * 32 + fq * 8;
    uint4 g[2], pv[2];
    {
      const size_t row = (size_t)row0;
#pragma unroll
      for (int bj = 0; bj < 2; ++bj) {
        g[bj] = *(const uint4*)(G + row * 3072 + b * 1024 + col0 + bj * 128);
        pv[bj] = uint4{0, 0, 0, 0};
        if (b > 0) pv[bj] = *(const uint4*)(mrg + row * 1024 + col0 + bj * 128);
      }
    }
#pragma unroll
    for (int rr = 0; rr < 8; ++rr) {
      const int ai = rr >> 2, m = rr & 3;
      uint4 ng[2], npv[2];
      if (rr + 1 < 8) {
        const size_t row = (size_t)(row0 + ((rr + 1) >> 2) * 128 + ((rr + 1) & 3) * 16);
#pragma unroll
        for (int bj = 0; bj < 2; ++bj) {
          ng[bj] = *(const uint4*)(G + row * 3072 + b * 1024 + col0 + bj * 128);
          npv[bj] = uint4{0, 0, 0, 0};
          if (b > 0) npv[bj] = *(const uint4*)(mrg + row * 1024 + col0 + bj * 128);
        }
      }
      const size_t row = (size_t)(row0 + ai * 128 + m * 16);
#pragma unroll
      for (int bj = 0; bj < 2; ++bj) {
        const f32x4 a0 = acc[ai][bj][m][0], a1 = acc[ai][bj][m][1];
        uint4 o;
        o.x = cvtpk(bflo(pv[bj].x) + bflo(g[bj].x) * a0[0], bfhi(pv[bj].x) + bfhi(g[bj].x) * a0[1]);
        o.y = cvtpk(bflo(pv[bj].y) + bflo(g[bj].y) * a0[2], bfhi(pv[bj].y) + bfhi(g[bj].y) * a0[3]);
        o.z = cvtpk(bflo(pv[bj].z) + bflo(g[bj].z) * a1[0], bfhi(pv[bj].z) + bfhi(g[bj].z) * a1[1]);
        o.w = cvtpk(bflo(pv[bj].w) + bflo(g[bj].w) * a1[2], bfhi(pv[bj].w) + bfhi(g[bj].w) * a1[3]);
        *(uint4*)(mrg + row * 1024 + col0 + bj * 128) = o;
      }
      if (rr + 1 < 8) {
#pragma unroll
        for (int bj = 0; bj < 2; ++bj) { g[bj] = ng[bj]; pv[bj] = npv[bj]; }
      }
    }
  }
};

template <class Epi>
DI void run_gemm(u16* smem, const u16* A, const u16* Bt, int N, int K, const Epi& E, int tid, int bid) {
  pg8::Gemm g{A, Bt, TT, N, K};
  pg8::StaticOrder S;
  S.init(TT, N, (int)gridDim.x, bid);
  pg8::gemm_phase<Epi, pg8::StaticOrder, false>((lds_u8*)smem, g, S, E, nullptr, tid);
}

DI void phase_g1(const Params& p, int which, u16* smem, int tid, int bid) {
  EpiSwiglu E{ws_slab(p, 0)};
  run_gemm(smem, ws_h(p), ws_w(p) + (which ? W2IN : W1IN), 5632, 1024, E, tid, bid);
}
DI void phase_g2(const Params& p, int l, int which, bool first, u16* smem, int tid, int bid) {
  EpiResid E{p.k.in[0], p.k.in[1], p.out, ws_mods(p) + (size_t)(l * 9) * 9216 + (which ? 8 : 2) * 1024, 0.5f, first};
  run_gemm(smem, ws_slab(p, 0), ws_w(p) + (which ? W2OUT : W1OUT), 1024, DFF, E, tid, bid);
}
DI void phase_g3a(const Params& p, u16* smem, int tid, int bid) {
  EpiProjA E{p.ws + WS_SLAB};
  run_gemm(smem, ws_h(p), ws_w(p) + WIN, 2816, 1024, E, tid, bid);
}
DI void phase_g3b(const Params& p, u16* smem, int tid, int bid) {
  EpiProjB E{p.ws + WS_SLAB, (float*)(p.ws + WS_DAB), (u16*)(p.ws + WS_HALO)};
  run_gemm(smem, ws_h(p), ws_w(p) + WIN + (size_t)2816 * 1024, 1792, 1024, E, tid, bid);
}
DI void phase_g3c(const Params& p, u16* smem, int tid, int bid) {
  EpiProjDG E{ws_slab(p, 5)};
  run_gemm(smem, ws_h(p), ws_w(p) + WIN + (size_t)4608 * 1024, 512, 1024, E, tid, bid);
}
DI void phase_mg(const Params& p, u16* smem, int tid, int bid) {
  EpiMG E{ws_slab(p, 3)};
  run_gemm(smem, ws_h(p), ws_w(p) + WIN + (size_t)5120 * 1024, 3072, 1024, E, tid, bid);
}
DI void phase_br(const Params& p, int b, u16* smem, int tid, int bid) {
  EpiBR E{ws_slab(p, 3), ws_h(p), b};
  run_gemm(smem, ws_slab(p, b), ws_w(p) + WBR + (size_t)b * 524288, 1024, 512, E, tid, bid);
}
DI void phase_g5(const Params& p, int l, u16* smem, int tid, int bid) {
  EpiResid E{p.k.in[0], p.k.in[1], p.out, ws_mods(p) + (size_t)(l * 9) * 9216 + 5 * 1024, 1.0f, false};
  run_gemm(smem, ws_h(p), ws_w(p) + WOUT, 1024, 1024, E, tid, bid);
}

DI void phase_prep(const Params& p, int l, int tid, int bid, int nblk) {
  const int lane = tid & 63, hl = lane & 7;
  const int gw = bid * 8 + (tid >> 6), nw = nblk * 8;
  u16* AQ = ws_slab(p, 0); u16* RQ = ws_slab(p, 2); u16* RK = ws_slab(p, 3);
  const u16* KV = ws_slab(p, 6);
  u16* KC = ws_slab(p, 7);
  const float* ROPE = (const float*)(p.ws + WS_ROPE);
  float wq[8], wk[8];
#pragma unroll
  for (int e = 0; e < 8; ++e) { wq[e] = p.k.in[15][l * 64 + hl * 8 + e]; wk[e] = p.k.in[16][l * 64 + hl * 8 + e]; }
  const float sgn = (hl < 4) ? -1.f : 1.f;
  for (int t = gw; t < TT; t += nw) {
    const bool g2 = t >= TI;
    const int s = g2 ? 32 + ((t - TI) >> 12) : (t >> 8);
    const int tl = t - seq_base(s);
    const int S = g2 ? 4352 : 256;
    float cs[8], sn[8];
    if (g2) {
      const int i0 = (hl & 3) * 8;
      const int pos = (i0 < 16) ? (tl >> 6) : (tl & 63);
      const float* rp = ROPE + pos * 16 + (i0 & 15);
      float4 c0 = *(const float4*)rp, c1 = *(const float4*)(rp + 4), s0 = *(const float4*)(rp + 1024), s1 = *(const float4*)(rp + 1028);
      cs[0] = c0.x; cs[1] = c0.y; cs[2] = c0.z; cs[3] = c0.w; cs[4] = c1.x; cs[5] = c1.y; cs[6] = c1.z; cs[7] = c1.w;
      sn[0] = s0.x; sn[1] = s0.y; sn[2] = s0.z; sn[3] = s0.w; sn[4] = s1.x; sn[5] = s1.y; sn[6] = s1.z; sn[7] = s1.w;
    } else {
#pragma unroll
      for (int e = 0; e < 8; ++e) { cs[e] = 1.f; sn[e] = 0.f; }
    }
    const uint4 raw_aq = *(const uint4*)(AQ + (size_t)t * 512 + lane * 8);
    const uint4 raw_kv = (lane < 32) ? *(const uint4*)(KV + (size_t)t * 256 + lane * 8) : uint4{0, 0, 0, 0};
    const uint4 raw_rq = *(const uint4*)(RQ + (size_t)t * 512 + lane * 8);
    const uint4 raw_rk = g2 ? *(const uint4*)(RK + (size_t)t * 512 + lane * 8) : uint4{0, 0, 0, 0};
    {
      u16* pq = AQ + (size_t)t * 512 + lane * 8;
      uint4 raw = raw_aq;
      float x[8] = {bflo(raw.x), bfhi(raw.x), bflo(raw.y), bfhi(raw.y), bflo(raw.z), bfhi(raw.z), bflo(raw.w), bfhi(raw.w)};
      float ss = 0.f;
#pragma unroll
      for (int e = 0; e < 8; ++e) ss += x[e] * x[e];
      ss += __shfl_xor(ss, 1); ss += __shfl_xor(ss, 2); ss += __shfl_xor(ss, 4);
      const float rstd = rsqrtf(ss * (1.f / 64.f) + EPSF);
#pragma unroll
      for (int e = 0; e < 8; ++e) x[e] = x[e] * rstd * wq[e];
      if (g2) {
#pragma unroll
        for (int e = 0; e < 8; ++e) { float pr = __shfl_xor(x[e], 4); x[e] = x[e] * cs[e] + sgn * pr * sn[e]; }
      }
      *(uint4*)pq = uint4{cvtpk(x[0], x[1]), cvtpk(x[2], x[3]), cvtpk(x[4], x[5]), cvtpk(x[6], x[7])};
    }
    if (lane < 32) {
      const int kv = (lane >> 3) & 1;
      uint4 raw = raw_kv;
      float x[8] = {bflo(raw.x), bfhi(raw.x), bflo(raw.y), bfhi(raw.y), bflo(raw.z), bfhi(raw.z), bflo(raw.w), bfhi(raw.w)};
      if (lane < 16) {
        float ss = 0.f;
#pragma unroll
        for (int e = 0; e < 8; ++e) ss += x[e] * x[e];
        ss += __shfl_xor(ss, 1); ss += __shfl_xor(ss, 2); ss += __shfl_xor(ss, 4);
        const float rstd = rsqrtf(ss * (1.f / 64.f) + EPSF);
#pragma unroll
        for (int e = 0; e < 8; ++e) x[e] = x[e] * rstd * wk[e];
        if (!g2) {
          float* oc = p.out + OCK + ((((size_t)s * 2 + l) * 256 + tl) * 2 + kv) * 64 + hl * 8;
          *(float4*)oc = float4{x[0], x[1], x[2], x[3]};
          *(float4*)(oc + 4) = float4{x[4], x[5], x[6], x[7]};
        } else {
#pragma unroll
          for (int e = 0; e < 8; ++e) { float pr = __shfl_xor(x[e], 4); x[e] = x[e] * cs[e] + sgn * pr * sn[e]; }
        }
        *(uint4*)(KC + kv_base(s, kv) + (size_t)tl * 64 + hl * 8) = uint4{cvtpk(x[0], x[1]), cvtpk(x[2], x[3]), cvtpk(x[4], x[5]), cvtpk(x[6], x[7])};
      } else {
        if (!g2) {
          float* oc = p.out + OCV + ((((size_t)s * 2 + l) * 256 + tl) * 2 + kv) * 64 + hl * 8;
          *(float4*)oc = float4{x[0], x[1], x[2], x[3]};
          *(float4*)(oc + 4) = float4{x[4], x[5], x[6], x[7]};
        }
        u16* vt = KC + KC_VT_OFF + kv_base(s, kv) + (size_t)(hl * 8) * S + tl;
        unsigned ru[4] = {raw.x, raw.y, raw.z, raw.w};
#pragma unroll
        for (int e = 0; e < 4; ++e) { vt[(size_t)(2 * e) * S] = (u16)(ru[e] & 0xffffu); vt[(size_t)(2 * e + 1) * S] = (u16)(ru[e] >> 16); }
      }
    }
    {
      u16* pq = RQ + (size_t)t * 512 + lane * 8;
      uint4 raw = raw_rq;
      float x[8] = {bflo(raw.x), bfhi(raw.x), bflo(raw.y), bfhi(raw.y), bflo(raw.z), bfhi(raw.z), bflo(raw.w), bfhi(raw.w)};
      if (g2) {
#pragma unroll
        for (int e = 0; e < 8; ++e) { float pr = __shfl_xor(x[e], 4); x[e] = x[e] * cs[e] + sgn * pr * sn[e]; }
      }
      *(uint4*)pq = uint4{cvtpk(x[0] * 0.125f, x[1] * 0.125f), cvtpk(x[2] * 0.125f, x[3] * 0.125f), cvtpk(x[4] * 0.125f, x[5] * 0.125f), cvtpk(x[6] * 0.125f, x[7] * 0.125f)};
    }
    if (g2) {
      u16* pk = RK + (size_t)t * 512 + lane * 8;
      uint4 raw = raw_rk;
      float x[8] = {bflo(raw.x), bfhi(raw.x), bflo(raw.y), bfhi(raw.y), bflo(raw.z), bfhi(raw.z), bflo(raw.w), bfhi(raw.w)};
#pragma unroll
      for (int e = 0; e < 8; ++e) { float pr = __shfl_xor(x[e], 4); x[e] = x[e] * cs[e] + sgn * pr * sn[e]; }
      *(uint4*)pk = uint4{cvtpk(x[0], x[1]), cvtpk(x[2], x[3]), cvtpk(x[4], x[5]), cvtpk(x[6], x[7])};
    }
  }
  const int gt = bid * NTHREADS + tid, ngt = nblk * NTHREADS;
  for (int idx = gt; idx < 8 * 256 * 2 * 64; idx += ngt) {
    int d = idx & 63, kv = (idx >> 6) & 1, j = (idx >> 7) & 255, b = idx >> 15;
    size_t src = ((((size_t)b * 2 + l) * 256 + j) * 2 + kv) * 64 + d;
    KC[kv_base(32 + b, kv) + (size_t)(4096 + j) * 64 + d] = f2bf(p.k.in[2][src]);
    KC[KC_VT_OFF + kv_base(32 + b, kv) + (size_t)d * 4352 + 4096 + j] = f2bf(p.k.in[3][src]);
  }
}

DI void attn_qk(const u16* cK, const bf16x8 (&qf)[2][2], f32x4 (&st)[2][4], int r, int q) {
  zero_acc<2>(st);
#pragma unroll
  for (int ks = 0; ks < 2; ++ks)
#pragma unroll
    for (int t = 0; t < 4; ++t) {
      bf16x8 a = *(const bf16x8*)(cK + (t * 16 + r) * 72 + ks * 32 + q * 8);
#pragma unroll
      for (int m = 0; m < 2; ++m) st[m][t] = mfma16(a, qf[m][ks], st[m][t]);
    }
}

DI void attn_item(const Params& p, int s, int head, int qt, u16* smem, int tid) {
  const int lane = tid & 63, w = tid >> 6, r = lane & 15, q = lane >> 4;
  const int base = seq_base(s);
  const int S = s < 32 ? 256 : 4352;
  const int kvh = head >> 2;
  const u16* Kc = ws_slab(p, 7) + kv_base(s, kvh);
  const u16* Vt = ws_slab(p, 7) + KC_VT_OFF + kv_base(s, kvh);
  u16* Qb = ws_slab(p, 0);
  const int row0 = base + qt * 256 + w * 32;
  bf16x8 qf[2][2];
#pragma unroll
  for (int m = 0; m < 2; ++m)
#pragma unroll
    for (int ks = 0; ks < 2; ++ks) qf[m][ks] = *(const bf16x8*)(Qb + (size_t)(row0 + m * 16 + r) * 512 + head * 64 + ks * 32 + q * 8);
  f32x4 o[2][4];
  zero_acc<2>(o);
  float mx[2] = {-INFINITY, -INFINITY}, ls[2] = {0.f, 0.f};
  u16* sK = smem;
  u16* sV = smem + 2 * 64 * 72;
  const int nkt = S >> 6;
  const int lrow = tid >> 3, lseg = tid & 7;
  const float c = 0.125f * 1.4426950408889634f;
  const u16* kp = Kc + (size_t)lrow * 64 + lseg * 8;
  const u16* vp0 = Vt + (size_t)lrow * S + lseg * 8;
  const int lofs = lrow * 72 + lseg * 8;
  {
    uint4 k0 = *(const uint4*)kp, k1 = *(const uint4*)(kp + 4096), v0 = *(const uint4*)vp0;
    *(uint4*)(sK + lofs) = k0; *(uint4*)(sK + 4608 + lofs) = k1; *(uint4*)(sV + lofs) = v0;
  }
  uint4 rk = *(const uint4*)(kp + 2 * 4096);
  uint4 rv = *(const uint4*)(vp0 + 64);
  lds_barrier();
  f32x4 stn[2][4];
  attn_qk(sK, qf, stn, r, q);
  lds_barrier();
  for (int kt = 0; kt < nkt; ++kt) {
    if (kt + 2 < nkt) *(uint4*)(sK + (kt & 1) * 4608 + lofs) = rk;
    if (kt + 1 < nkt) *(uint4*)(sV + ((kt + 1) & 1) * 4608 + lofs) = rv;
    if (kt + 3 < nkt) rk = *(const uint4*)(kp + (size_t)(kt + 3) * 4096);
    if (kt + 2 < nkt) rv = *(const uint4*)(vp0 + (kt + 2) * 64);
    const u16* nK = sK + ((kt + 1) & 1) * 4608;
    const u16* cV = sV + (kt & 1) * 4608;
    f32x4 st[2][4];
#pragma unroll
    for (int m = 0; m < 2; ++m)
#pragma unroll
      for (int t = 0; t < 4; ++t) { st[m][t] = stn[m][t]; stn[m][t] = f32x4{0.f, 0.f, 0.f, 0.f}; }
#pragma unroll
    for (int ks = 0; ks < 2; ++ks) {
      bf16x8 kf[4];
#pragma unroll
      for (int t = 0; t < 4; ++t) kf[t] = *(const bf16x8*)(nK + (t * 16 + r) * 72 + ks * 32 + q * 8);
      __builtin_amdgcn_sched_barrier(0);
#pragma unroll
      for (int t = 0; t < 4; ++t)
#pragma unroll
        for (int m = 0; m < 2; ++m) stn[m][t] = mfma16(kf[t], qf[m][ks], stn[m][t]);
      __builtin_amdgcn_sched_barrier(0);
    }
#pragma unroll
    for (int m = 0; m < 2; ++m) {
      float rm = fmaxf(fmaxf(st[m][0][0], st[m][0][1]), fmaxf(st[m][0][2], st[m][0][3]));
#pragma unroll
      for (int t = 1; t < 4; ++t) { rm = fmaxf(fmaxf(rm, st[m][t][0]), st[m][t][1]); rm = fmaxf(fmaxf(rm, st[m][t][2]), st[m][t][3]); }
      rm = fmaxf(rm, __shfl_xor(rm, 16));
      rm = fmaxf(rm, __shfl_xor(rm, 32));
      const float mnew = fmaxf(mx[m], rm);
      const float alpha = __builtin_amdgcn_exp2f((mx[m] - mnew) * c);
      mx[m] = mnew;
      const f32x2_t c2 = {c, c}, mc2 = {mnew * c, mnew * c};
      f32x2_t ps2 = {0.f, 0.f};
#pragma unroll
      for (int t = 0; t < 4; ++t)
#pragma unroll
        for (int jp = 0; jp < 2; ++jp) {
          f32x2_t v = {st[m][t][2 * jp], st[m][t][2 * jp + 1]};
          v = v * c2 - mc2;
          v.x = __builtin_amdgcn_exp2f(v.x); v.y = __builtin_amdgcn_exp2f(v.y);
          ps2 += v;
          st[m][t][2 * jp] = v.x; st[m][t][2 * jp + 1] = v.y;
        }
      ls[m] = ls[m] * alpha + ps2.x + ps2.y;
#pragma unroll
      for (int dt = 0; dt < 4; ++dt) o[m][dt] = o[m][dt] * alpha;
    }
#pragma unroll
    for (int kb = 0; kb < 2; ++kb) {
      bf16x8 vf[4];
#pragma unroll
      for (int dt = 0; dt < 4; ++dt) {
        const u16* vp = cV + (dt * 16 + r) * 72 + kb * 32 + 4 * q;
        uint2 lo = *(const uint2*)vp, hi = *(const uint2*)(vp + 16);
        vf[dt] = __builtin_bit_cast(bf16x8, uint4{lo.x, lo.y, hi.x, hi.y});
      }
      bf16x8 pb[2];
#pragma unroll
      for (int m = 0; m < 2; ++m) {
        uint4 u = uint4{cvtpk(st[m][2 * kb][0], st[m][2 * kb][1]), cvtpk(st[m][2 * kb][2], st[m][2 * kb][3]),
                        cvtpk(st[m][2 * kb + 1][0], st[m][2 * kb + 1][1]), cvtpk(st[m][2 * kb + 1][2], st[m][2 * kb + 1][3])};
        pb[m] = __builtin_bit_cast(bf16x8, u);
      }
      __builtin_amdgcn_sched_barrier(0);
#pragma unroll
      for (int dt = 0; dt < 4; ++dt)
#pragma unroll
        for (int m = 0; m < 2; ++m) o[m][dt] = mfma16(vf[dt], pb[m], o[m][dt]);
      __builtin_amdgcn_sched_barrier(0);
    }
    lds_barrier();
  }
#pragma unroll
  for (int m = 0; m < 2; ++m) {
    float l = ls[m];
    l += __shfl_xor(l, 16);
    l += __shfl_xor(l, 32);
    const float inv = 1.f / l;
#pragma unroll
    for (int dt = 0; dt < 4; ++dt)
      *(uint2*)(Qb + (size_t)(row0 + m * 16 + r) * 512 + head * 64 + dt * 16 + 4 * q) =
          uint2{cvtpk(o[m][dt][0] * inv, o[m][dt][1] * inv), cvtpk(o[m][dt][2] * inv, o[m][dt][3] * inv)};
  }
}

DI void ret_stage(u16* Qs, u16* Ks, u16* Kdt, u16* Vt, int row, int seg, const uint4& qv, const uint4& kv, const uint4& vv, float kdec) {
  *(uint4*)(Qs + row * 72 + seg * 8) = qv;
  *(uint4*)(Ks + row * 72 + seg * 8) = kv;
  u16* kd = Kdt + (seg * 8) * 72 + row;
  u16* vt = Vt + (seg * 8) * 72 + row;
  kd[0 * 72] = f2bf(bflo(kv.x) * kdec); kd[1 * 72] = f2bf(bfhi(kv.x) * kdec);
  kd[2 * 72] = f2bf(bflo(kv.y) * kdec); kd[3 * 72] = f2bf(bfhi(kv.y) * kdec);
  kd[4 * 72] = f2bf(bflo(kv.z) * kdec); kd[5 * 72] = f2bf(bfhi(kv.z) * kdec);
  kd[6 * 72] = f2bf(bflo(kv.w) * kdec); kd[7 * 72] = f2bf(bfhi(kv.w) * kdec);
  vt[0 * 72] = (u16)(vv.x & 0xffffu); vt[1 * 72] = (u16)(vv.x >> 16);
  vt[2 * 72] = (u16)(vv.y & 0xffffu); vt[3 * 72] = (u16)(vv.y >> 16);
  vt[4 * 72] = (u16)(vv.z & 0xffffu); vt[5 * 72] = (u16)(vv.z >> 16);
  vt[6 * 72] = (u16)(vv.w & 0xffffu); vt[7 * 72] = (u16)(vv.w >> 16);
}

DI void ret_rowwise(const float* Os, u16* RO, int t, int h, int ct, bool fin, const uint4& f0, const uint4& f1, const uint4& f2, const uint4& f3, const float (&rw)[16]) {
  const int row = ct >> 2, c4 = ct & 3;
  float x[16];
#pragma unroll
  for (int e4 = 0; e4 < 4; ++e4) {
    float4 v = *(const float4*)(Os + row * 68 + c4 * 16 + e4 * 4);
    x[e4 * 4] = v.x; x[e4 * 4 + 1] = v.y; x[e4 * 4 + 2] = v.z; x[e4 * 4 + 3] = v.w;
  }
  u16* po = RO + (size_t)t * 512 + h * 64 + c4 * 16;
  if (fin) {
    const unsigned pu[8] = {f0.x, f0.y, f0.z, f0.w, f1.x, f1.y, f1.z, f1.w};
    const unsigned gu[8] = {f2.x, f2.y, f2.z, f2.w, f3.x, f3.y, f3.z, f3.w};
    float s1 = 0.f;
#pragma unroll
    for (int e = 0; e < 8; ++e) { x[2 * e] += bflo(pu[e]); x[2 * e + 1] += bfhi(pu[e]); s1 += x[2 * e] + x[2 * e + 1]; }
    s1 += __shfl_xor(s1, 1); s1 += __shfl_xor(s1, 2);
    const float mu = s1 * (1.f / 64.f);
    float s2 = 0.f;
#pragma unroll
    for (int e = 0; e < 16; ++e) { float d = x[e] - mu; s2 += d * d; }
    s2 += __shfl_xor(s2, 1); s2 += __shfl_xor(s2, 2);
    const float rs = rsqrtf(s2 * (1.f / 64.f) + EPSF);
#pragma unroll
    for (int e = 0; e < 8; ++e) {
      x[2 * e] = (x[2 * e] - mu) * rs * rw[2 * e] * silu_f(bflo(gu[e]));
      x[2 * e + 1] = (x[2 * e + 1] - mu) * rs * rw[2 * e + 1] * silu_f(bfhi(gu[e]));
    }
  }
  *(uint4*)po = uint4{cvtpk(x[0], x[1]), cvtpk(x[2], x[3]), cvtpk(x[4], x[5]), cvtpk(x[6], x[7])};
  *(uint4*)(po + 8) = uint4{cvtpk(x[8], x[9]), cvtpk(x[10], x[11]), cvtpk(x[12], x[13]), cvtpk(x[14], x[15])};
}

DI void ret_item(const Params& p, int l, int s, int h, u16* smem, int tid) {
  const int lane = tid & 63, r = lane & 15, q = lane >> 4;
  const int dir = tid >> 8, ct = tid & 255, wv = (tid >> 6) & 3;
  const int base = seq_base(s), len = seq_len(s), N = len >> 6;
  const bool g2 = s >= 32;
  const float lg = log1pf(-exp2f(-(dir ? 5.5f : 5.0f) - (float)h));
  u16* cs = smem + dir * 36352;
  u16* Qs = cs; u16* Ks = cs + 4608; u16* Vt = cs + 2 * 4608; u16* Kdt = cs + 3 * 4608; u16* Ps = cs + 4 * 4608; u16* St = cs + 5 * 4608;
  float* Os = (float*)(cs + 6 * 4608);
  const u16* RQ = ws_slab(p, 2); const u16* RK = ws_slab(p, 3); const u16* RV = ws_slab(p, 4); const u16* RG = ws_slab(p, 5);
  u16* RO = ws_slab(p, 1);
  f32x4 accS[4];
#pragma unroll
  for (int n = 0; n < 4; ++n)
#pragma unroll
    for (int j = 0; j < 4; ++j) {
      float v0 = 0.f;
      if (g2) v0 = p.k.in[4][(((((size_t)(s - 32) * 2 + l) * 2 + dir) * 8 + h) * 64 + (n * 16 + r)) * 64 + (wv * 16 + q * 4 + j)];
      accS[n][j] = v0;
      St[(wv * 16 + q * 4 + j) * 72 + n * 16 + r] = f2bf(v0);
    }
  const float cdec = __expf(lg * 64.f);
  float rw[16];
  {
    const float* rnw = p.k.in[17] + l * 512 + h * 64 + (ct & 3) * 16;
#pragma unroll
    for (int e = 0; e < 16; ++e) rw[e] = rnw[e];
  }
  float rowf[4], colf[4], qdf[4];
#pragma unroll
  for (int j = 0; j < 4; ++j) {
    rowf[j] = __expf(lg * (float)(wv * 16 + q * 4 + j)); colf[j] = __expf(-lg * (float)(j * 16 + r));
    qdf[j] = __expf(lg * (float)(wv * 16 + q * 4 + j + 1));
  }
  uint4 pq0, pq1, pk0, pk1, pv0, pv1;
  {
    const int t = base + (dir ? len - 1 - lane : lane);
    const size_t off0 = (size_t)t * 512 + h * 64 + wv * 8, off1 = off0 + 32;
    pq0 = *(const uint4*)(RQ + off0); pk0 = *(const uint4*)(RK + off0); pv0 = *(const uint4*)(RV + off0);
    pq1 = *(const uint4*)(RQ + off1); pk1 = *(const uint4*)(RK + off1); pv1 = *(const uint4*)(RV + off1);
  }
  const float kdec = __expf(lg * (float)(63 - lane));
  uint4 f0 = uint4{0, 0, 0, 0}, f1 = f0, f2 = f0, f3 = f0;
  const int erow = ct >> 2;
  for (int n = 0; n < N; ++n) {
    if (n > 0) {
      const int pp = (n - 1) * 64 + erow;
      ret_rowwise(Os, RO, base + (dir ? len - 1 - pp : pp), h, ct, (n - 1) >= (N >> 1), f0, f1, f2, f3, rw);
    }
    ret_stage(Qs, Ks, Kdt, Vt, lane, wv, pq0, pk0, pv0, kdec);
    ret_stage(Qs, Ks, Kdt, Vt, lane, wv + 4, pq1, pk1, pv1, kdec);
    if (n + 1 < N) {
      const int pp = (n + 1) * 64 + lane;
      const int t = base + (dir ? len - 1 - pp : pp);
      const size_t off0 = (size_t)t * 512 + h * 64 + wv * 8, off1 = off0 + 32;
      pq0 = *(const uint4*)(RQ + off0); pk0 = *(const uint4*)(RK + off0); pv0 = *(const uint4*)(RV + off0);
      pq1 = *(const uint4*)(RQ + off1); pk1 = *(const uint4*)(RK + off1); pv1 = *(const uint4*)(RV + off1);
    }
    if (n == (N >> 1)) __syncthreads(); else lds_barrier();
    if (n >= (N >> 1)) {
      const int pp = n * 64 + erow;
      const int t = base + (dir ? len - 1 - pp : pp);
      const size_t off = (size_t)t * 512 + h * 64 + (ct & 3) * 16;
      f0 = *(const uint4*)(RO + off); f1 = *(const uint4*)(RO + off + 8);
      f2 = *(const uint4*)(RG + off); f3 = *(const uint4*)(RG + off + 8);
    }
    f32x4 sa[4];
#pragma unroll
    for (int nn = 0; nn < 4; ++nn) sa[nn] = f32x4{0.f, 0.f, 0.f, 0.f};
    wave_mma<4, 2>(Qs, 72, wv * 16, Ks, 72, 0, sa, lane);
#pragma unroll
    for (int nn = 0; nn < 4; ++nn)
#pragma unroll
      for (int j = 0; j < 4; ++j) {
        int i = wv * 16 + q * 4 + j, jj = nn * 16 + r;
        float pv = (i >= jj) ? sa[nn][j] * (rowf[j] * colf[nn]) : 0.f;
        Ps[i * 72 + jj] = f2bf(pv);
      }
    f32x4 a1[4], a2[4];
#pragma unroll
    for (int nn = 0; nn < 4; ++nn) { a1[nn] = f32x4{0.f, 0.f, 0.f, 0.f}; a2[nn] = f32x4{0.f, 0.f, 0.f, 0.f}; }
    wave_mma<4, 2>(Ps, 72, wv * 16, Vt, 72, 0, a1, lane);
    wave_mma<4, 2>(Qs, 72, wv * 16, St, 72, 0, a2, lane);
#pragma unroll
    for (int j = 0; j < 4; ++j)
#pragma unroll
      for (int nn = 0; nn < 4; ++nn) Os[(wv * 16 + q * 4 + j) * 68 + nn * 16 + r] = a1[nn][j] + qdf[j] * a2[nn][j];
#pragma unroll
    for (int nn = 0; nn < 4; ++nn)
#pragma unroll
      for (int j = 0; j < 4; ++j) accS[nn][j] *= cdec;
    wave_mma<4, 2>(Vt, 72, wv * 16, Kdt, 72, 0, accS, lane);
    lds_barrier();
#pragma unroll
    for (int nn = 0; nn < 4; ++nn)
#pragma unroll
      for (int j = 0; j < 4; ++j) St[(wv * 16 + q * 4 + j) * 72 + nn * 16 + r] = f2bf(accS[nn][j]);
  }
  {
    const int pp = (N - 1) * 64 + erow;
    ret_rowwise(Os, RO, base + (dir ? len - 1 - pp : pp), h, ct, true, f0, f1, f2, f3, rw);
  }
  if (!g2) {
#pragma unroll
    for (int nn = 0; nn < 4; ++nn)
#pragma unroll
      for (int j = 0; j < 4; ++j)
        p.out[OSR + (((((size_t)s * 2 + l) * 2 + dir) * 8 + h) * 64 + (nn * 16 + r)) * 64 + (wv * 16 + q * 4 + j)] = accS[nn][j];
  }
  lds_barrier();
}

constexpr int ATT_X1 = 320;
DI void phase_mix1(const Params& p, int l, u16* smem, int* s_item, int tid) {
  int* ctr = (int*)(p.ws + WS_CTR) + l * 4;
  while (true) {
    if (tid == 0) *s_item = atomicAdd(ctr, 1);
    lds_barrier();
    const int it = *s_item;
    lds_barrier();
    if (it >= 64 + ATT_X1 + 512) break;
    int kind, s, h, qt = 0;
    if (it < 64) { kind = 0; s = 32 + (it >> 3); h = it & 7; }
    else if (it < 64 + ATT_X1) { int a = it - 64; kind = 1; s = 32 + (a >> 7); h = (a >> 4) & 7; qt = a & 15; }
    else if (it < 64 + ATT_X1 + 256) { int a = it - 64 - ATT_X1; kind = 0; s = a >> 3; h = a & 7; }
    else { int a = it - 64 - ATT_X1 - 256; kind = 1; s = a >> 3; h = a & 7; }
#ifdef PROBE_MAX
    unsigned long long tb_ = wall_clock64();
#endif
    if (kind == 0) ret_item(p, l, s, h, smem, tid);
    else attn_item(p, s, h, qt, smem, tid);
#ifdef PROBE_MAX
    if (tid == 0 && kind == (PROBE_MAX)) atomicMax((int*)(p.ws + WS_CTR) + 32 + l, (int)(wall_clock64() - tb_));
#endif
  }
}

DI void dn_pre_item(const Params& p, int l, int cgk, int h, u16* smem, int tid) {
  const int lane = tid & 63, w = tid >> 6, r = lane & 15, q = lane >> 4;
  u16* Ks = smem;
  float* sKK = (float*)(smem + 64 * 136);
  float* sA = sKK + 64 * 65;
  float* sX = sA + 2 * 4096;
  float* sg = sX + 2 * 64 * 68;
  float* sb = sg + 128;
  float* sG = sb + 128;
  const int t0 = cgk * 64;
  const int s = t0 < TI ? (t0 >> 8) : 32 + ((t0 - TI) >> 12);
  const int base = seq_base(s), len = seq_len(s);
  const u16* HALO = (const u16*)(p.ws + WS_HALO);
  float pre_da = 0.f, pre_db = 0.f;
  if (tid < 128) {
    const int dir_ = tid >> 6, i_ = tid & 63;
    const int t_ = t0 + (dir_ ? 63 - i_ : i_);
    const float* DAB_ = (const float*)(p.ws + WS_DAB);
    pre_da = DAB_[(size_t)t_ * 16 + dir_ * 4 + h]; pre_db = DAB_[(size_t)t_ * 16 + 8 + dir_ * 4 + h];
  }
  {
    const int rr = tid >> 3, cseg = tid & 7;
    const int t = t0 + rr;
    const int col0 = h * 128 + cseg * 16;
    unsigned res[3][8];
#pragma unroll
    for (int xi = 0; xi < 3; ++xi) {
      const u16* X = ws_slab(p, 2 + xi);
      uint4 c0 = *(const uint4*)(X + (size_t)t * 512 + col0), c1 = *(const uint4*)(X + (size_t)t * 512 + col0 + 8);
      uint4 p0 = uint4{0, 0, 0, 0}, p1 = p0, n0 = p0, n1 = p0;
      if (t > base) {
        const u16* src = (rr > 0) ? X + (size_t)(t - 1) * 512 + col0 : HALO + ((size_t)(cgk - 1) * 2 + 1) * 1536 + xi * 512 + col0;
        p0 = *(const uint4*)src; p1 = *(const uint4*)(src + 8);
      }
      if (t + 1 < base + len) {
        const u16* src = (rr < 63) ? X + (size_t)(t + 1) * 512 + col0 : HALO + ((size_t)(cgk + 1) * 2 + 0) * 1536 + xi * 512 + col0;
        n0 = *(const uint4*)src; n1 = *(const uint4*)(src + 8);
      }
      const float* cw = p.k.in[18] + (size_t)l * 3 * 1536 + xi * 512 + col0;
      unsigned cu[8] = {c0.x, c0.y, c0.z, c0.w, c1.x, c1.y, c1.z, c1.w};
      unsigned pu[8] = {p0.x, p0.y, p0.z, p0.w, p1.x, p1.y, p1.z, p1.w};
      unsigned nu[8] = {n0.x, n0.y, n0.z, n0.w, n1.x, n1.y, n1.z, n1.w};
      float y[16];
      float ss = 0.f;
#pragma unroll
      for (int e = 0; e < 8; ++e) {
        float a0 = cw[2 * e] * bflo(pu[e]) + cw[1536 + 2 * e] * bflo(cu[e]) + cw[3072 + 2 * e] * bflo(nu[e]);
        float a1 = cw[2 * e + 1] * bfhi(pu[e]) + cw[1536 + 2 * e + 1] * bfhi(cu[e]) + cw[3072 + 2 * e + 1] * bfhi(nu[e]);
        a0 = silu_f(a0); a1 = silu_f(a1);
        y[2 * e] = a0; y[2 * e + 1] = a1;
        ss += a0 * a0 + a1 * a1;
      }
      if (xi < 2) {
        ss += __shfl_xor(ss, 1); ss += __shfl_xor(ss, 2); ss += __shfl_xor(ss, 4);
        float rn = rsqrtf(ss + EPSF) * (xi == 0 ? 0.08838834764831845f : 1.f);
#pragma unroll
        for (int e = 0; e < 16; ++e) y[e] *= rn;
      }
#pragma unroll
      for (int e = 0; e < 8; ++e) res[xi][e] = cvtpk(y[2 * e], y[2 * e + 1]);
    }
    *(uint4*)(Ks + rr * 136 + cseg * 16) = uint4{res[1][0], res[1][1], res[1][2], res[1][3]};
    *(uint4*)(Ks + rr * 136 + cseg * 16 + 8) = uint4{res[1][4], res[1][5], res[1][6], res[1][7]};
    __syncthreads();
#pragma unroll
    for (int xi = 0; xi < 3; ++xi) {
      u16* X = ws_slab(p, 2 + xi);
      *(uint4*)(X + (size_t)t * 512 + col0) = uint4{res[xi][0], res[xi][1], res[xi][2], res[xi][3]};
      *(uint4*)(X + (size_t)t * 512 + col0 + 8) = uint4{res[xi][4], res[xi][5], res[xi][6], res[xi][7]};
    }
  }
  const float* DAB = (const float*)(p.ws + WS_DAB);
  float* GBG = (float*)(p.ws + WS_GBG);
  float* GBB = (float*)(p.ws + WS_GBB);
  if (tid < 128) {
    int dir = tid >> 6, i = tid & 63;
    int t = t0 + (dir ? 63 - i : i);
    float da = pre_da, db = pre_db;
    float x = da + p.k.in[20][l * 8 + dir * 4 + h];
    float sp = (x > 20.f) ? x : log1pf(expf(x));
    sg[tid] = -expf(p.k.in[19][l * 8 + dir * 4 + h]) * sp;
    sb[tid] = 1.f / (1.f + expf(-db));
  }
  lds_barrier();
  if (tid < 128) {
    float x = sg[tid];
#pragma unroll
    for (int o = 1; o < 64; o <<= 1) { float y = __shfl_up(x, o); if ((tid & 63) >= o) x += y; }
    sG[tid] = x;
  }
  {
    f32x4 kk[2];
    kk[0] = f32x4{0.f, 0.f, 0.f, 0.f}; kk[1] = kk[0];
    wave_mma<2, 4>(Ks, 136, (w >> 1) * 16, Ks, 136, (w & 1) * 32, kk, lane);
#pragma unroll
    for (int nn = 0; nn < 2; ++nn)
#pragma unroll
      for (int j = 0; j < 4; ++j) sKK[((w >> 1) * 16 + q * 4 + j) * 65 + (w & 1) * 32 + nn * 16 + r] = kk[nn][j];
  }
  lds_barrier();
  if (tid < 128) {
    int dir = tid >> 6, i = tid & 63;
    int t = t0 + (dir ? 63 - i : i);
    GBG[(size_t)t * 8 + dir * 4 + h] = sG[tid];
    GBB[(size_t)t * 8 + dir * 4 + h] = sb[tid];
  }
  for (int idx = tid; idx < 2 * 4096; idx += NTHREADS) {
    int dir = idx >> 12, i = (idx >> 6) & 63, j = idx & 63;
    int ri = dir ? 63 - i : i, rj = dir ? 63 - j : j;
    float a = 0.f;
    if (i > j) a = sb[dir * 64 + i] * sKK[ri * 65 + rj] * __expf(sG[dir * 64 + i] - sG[dir * 64 + j]);
    sA[idx] = a;
  }
  lds_barrier();
  {
    const int dir = tid >> 8, c = (tid >> 2) & 63, sl = tid & 3;
    const float* ar = sA + dir * 4096 + sl * 16;
    float x[16];
#pragma unroll
    for (int jj = 0; jj < 16; ++jj) x[jj] = (sl * 16 + jj == c) ? 1.f : 0.f;
    float4 an[4];
#pragma unroll
    for (int k = 0; k < 4; ++k) an[k] = *(const float4*)(ar + 64 + 4 * k);
    int ro = 64;
#pragma unroll
    for (int i = 1; i < 64; ++i) {
      float4 a4[4];
#pragma unroll
      for (int k = 0; k < 4; ++k) a4[k] = an[k];
      if (i + 1 < 64) {
        ro += 64;
        asm volatile("" : "+v"(ro));
#pragma unroll
        for (int k = 0; k < 4; ++k) an[k] = *(const float4*)(ar + ro + 4 * k);
      }
      __builtin_amdgcn_sched_barrier(0);
      float s0 = 0.f, s1 = 0.f;
#pragma unroll
      for (int k = 0; k < 4; ++k) {
        s0 += a4[k].x * x[4 * k] + a4[k].z * x[4 * k + 2];
        s1 += a4[k].y * x[4 * k + 1] + a4[k].w * x[4 * k + 3];
      }
      float tot = s0 + s1;
      tot += __builtin_bit_cast(float, __builtin_amdgcn_update_dpp(0, __builtin_bit_cast(int, tot), 0xB1, 0xF, 0xF, false));
      tot += __builtin_bit_cast(float, __builtin_amdgcn_update_dpp(0, __builtin_bit_cast(int, tot), 0x4E, 0xF, 0xF, false));
      x[i & 15] = (sl == (i >> 4)) ? x[i & 15] - tot : x[i & 15];
      __builtin_amdgcn_sched_barrier(0);
    }
    u16* TM = ws_slab(p, 5) + (((size_t)cgk * 4 + h) * 2 + dir) * 4096 + (size_t)(sl * 16) * 64 + c;
#pragma unroll
    for (int jj = 0; jj < 16; ++jj) TM[jj * 64] = f2bf(x[jj]);
  }
  lds_barrier();
}

DI void phase_dn_pre(const Params& p, int l, u16* smem, int tid, int bid, int nblk) {
  for (int it = bid; it < 640 * 4; it += nblk) dn_pre_item(p, l, it >> 2, it & 3, smem, tid);
}

DI void dn_scan_item(const Params& p, int l, int s, int h, int dir, u16* smem, int tid) {
  const int lane = tid & 63, w = tid >> 6, r = lane & 15, q = lane >> 4;
  u16* Qs = smem;
  u16* Ks = Qs + 8704;
  u16* Kdt = Ks + 8704;
  u16* Rt = Kdt + 9216;
  u16* Vnt = Rt + 9216;
  u16* St = Vnt + 9216;
  u16* Tms = St + 17408;
  u16* Atm = Tms + 4608;
  float* sG = (float*)(Atm + 4608);
  float* sB = sG + 64;
  float* sEG = sB + 64;
  u16* Os = (u16*)(sEG + 64);
  const int base = seq_base(s), len = seq_len(s), N = len >> 6;
  const bool g2 = s >= 32;
  const u16* DQ = ws_slab(p, 2); const u16* DK = ws_slab(p, 3); const u16* DV = ws_slab(p, 4);
  const u16* TM = ws_slab(p, 5);
  u16* OUT = ws_slab(p, dir ? 8 : 6);
  const float* GBG = (const float*)(p.ws + WS_GBG);
  const float* GBB = (const float*)(p.ws + WS_GBB);
  const int mP = w >> 1, nP0 = (w & 1) * 4;
  f32x4 ST[8];
#pragma unroll
  for (int n = 0; n < 8; ++n)
#pragma unroll
    for (int j = 0; j < 4; ++j) {
      float v0 = 0.f;
      if (g2) v0 = p.k.in[5][(((((size_t)(s - 32) * 2 + l) * 2 + dir) * 4 + h) * 128 + (n * 16 + r)) * 128 + (w * 16 + q * 4 + j)];
      ST[n][j] = v0;
      St[(w * 16 + q * 4 + j) * 136 + n * 16 + r] = f2bf(v0);
    }
  uint4 pq0, pq1, pk0, pk1, pv0, pv1, ptm;
  float pgrow, pglast, pbeta;
  {
    const int cg0 = (base >> 6) + (dir ? N - 1 : 0);
    const int t = base + (dir ? len - 1 - lane : lane);
    const int tlast = base + (dir ? len - 1 - 63 : 63);
    const size_t off = (size_t)t * 512 + h * 128 + w * 16;
    pq0 = *(const uint4*)(DQ + off); pq1 = *(const uint4*)(DQ + off + 8);
    pk0 = *(const uint4*)(DK + off); pk1 = *(const uint4*)(DK + off + 8);
    pv0 = *(const uint4*)(DV + off); pv1 = *(const uint4*)(DV + off + 8);
    ptm = *(const uint4*)(TM + (((size_t)cg0 * 4 + h) * 2 + dir) * 4096 + lane * 64 + w * 8);
    pgrow = GBG[(size_t)t * 8 + dir * 4 + h]; pglast = GBG[(size_t)tlast * 8 + dir * 4 + h]; pbeta = GBB[(size_t)t * 8 + dir * 4 + h];
  }
  const int orow = tid >> 3, oseg = tid & 7;
  for (int n = 0; n < N; ++n) {
    if (n > 0) {
      const int pp = (n - 1) * 64 + orow;
      const int t = base + (dir ? len - 1 - pp : pp);
      const uint4 o0 = *(const uint4*)(Os + orow * 136 + oseg * 16), o1 = *(const uint4*)(Os + orow * 136 + oseg * 16 + 8);
      *(uint4*)(OUT + (size_t)t * 512 + h * 128 + oseg * 16) = o0;
      *(uint4*)(OUT + (size_t)t * 512 + h * 128 + oseg * 16 + 8) = o1;
    }
    {
      const int row = lane, seg = w;
      *(uint4*)(Qs + row * 136 + seg * 16) = pq0; *(uint4*)(Qs + row * 136 + seg * 16 + 8) = pq1;
      *(uint4*)(Ks + row * 136 + seg * 16) = pk0; *(uint4*)(Ks + row * 136 + seg * 16 + 8) = pk1;
      const float kd = __expf(pglast - pgrow);
      unsigned ku[8] = {pk0.x, pk0.y, pk0.z, pk0.w, pk1.x, pk1.y, pk1.z, pk1.w};
      unsigned vu[8] = {pv0.x, pv0.y, pv0.z, pv0.w, pv1.x, pv1.y, pv1.z, pv1.w};
#pragma unroll
      for (int e = 0; e < 8; ++e) {
        Kdt[(seg * 16 + 2 * e) * 72 + row] = f2bf(bflo(ku[e]) * kd);
        Kdt[(seg * 16 + 2 * e + 1) * 72 + row] = f2bf(bfhi(ku[e]) * kd);
        Rt[(seg * 16 + 2 * e) * 72 + row] = (u16)(vu[e] & 0xffffu);
        Rt[(seg * 16 + 2 * e + 1) * 72 + row] = (u16)(vu[e] >> 16);
      }
      *(uint4*)(Tms + row * 72 + seg * 8) = ptm;
      if (w == 0) { sG[lane] = pgrow; sEG[lane] = __expf(pgrow); sB[lane] = pbeta; }
      if (n + 1 < N) {
        const int cgn = (base >> 6) + (dir ? N - 2 - n : n + 1);
        const int pp = (n + 1) * 64 + lane;
        const int t = base + (dir ? len - 1 - pp : pp);
        const int tlast = base + (dir ? len - 1 - ((n + 1) * 64 + 63) : (n + 1) * 64 + 63);
        const size_t off = (size_t)t * 512 + h * 128 + w * 16;
        pq0 = *(const uint4*)(DQ + off); pq1 = *(const uint4*)(DQ + off + 8);
        pk0 = *(const uint4*)(DK + off); pk1 = *(const uint4*)(DK + off + 8);
        pv0 = *(const uint4*)(DV + off); pv1 = *(const uint4*)(DV + off + 8);
        ptm = *(const uint4*)(TM + (((size_t)cgn * 4 + h) * 2 + dir) * 4096 + lane * 64 + w * 8);
        pgrow = GBG[(size_t)t * 8 + dir * 4 + h]; pglast = GBG[(size_t)tlast * 8 + dir * 4 + h]; pbeta = GBB[(size_t)t * 8 + dir * 4 + h];
      }
    }
    lds_barrier();
    f32x4 p1[4], qs[4], at[2];
#pragma unroll
    for (int nn = 0; nn < 4; ++nn) { p1[nn] = f32x4{0.f, 0.f, 0.f, 0.f}; qs[nn] = p1[nn]; }
    at[0] = f32x4{0.f, 0.f, 0.f, 0.f}; at[1] = at[0];
    wave_mma<4, 4>(Ks, 136, mP * 16, St, 136, nP0 * 16, p1, lane);
    wave_mma<4, 4>(Qs, 136, mP * 16, St, 136, nP0 * 16, qs, lane);
    wave_mma<2, 4>(Qs, 136, mP * 16, Ks, 136, (w & 1) * 32, at, lane);
    const int i0 = mP * 16 + q * 4;
    float bi[4], egi[4], gi[4];
#pragma unroll
    for (int j = 0; j < 4; ++j) { bi[j] = sB[i0 + j]; egi[j] = sEG[i0 + j]; gi[j] = sG[i0 + j]; }
#pragma unroll
    for (int nn = 0; nn < 4; ++nn) {
      const int v = (nP0 + nn) * 16 + r;
      uint2 raw = *(const uint2*)(Rt + v * 72 + i0);
      float f0 = bi[0] * (bflo(raw.x) - egi[0] * p1[nn][0]);
      float f1 = bi[1] * (bfhi(raw.x) - egi[1] * p1[nn][1]);
      float f2 = bi[2] * (bflo(raw.y) - egi[2] * p1[nn][2]);
      float f3 = bi[3] * (bfhi(raw.y) - egi[3] * p1[nn][3]);
      *(uint2*)(Rt + v * 72 + i0) = uint2{cvtpk(f0, f1), cvtpk(f2, f3)};
    }
#pragma unroll
    for (int nn = 0; nn < 2; ++nn) {
      const int jj = (w & 1) * 32 + nn * 16 + r;
      const float gj = sG[jj];
#pragma unroll
      for (int j = 0; j < 4; ++j) {
        int i = i0 + j;
        float val = (i >= jj) ? at[nn][j] * __expf(gi[j] - gj) : 0.f;
        Atm[i * 72 + jj] = f2bf(val);
      }
    }
    lds_barrier();
    f32x4 vn[4];
#pragma unroll
    for (int nn = 0; nn < 4; ++nn) vn[nn] = f32x4{0.f, 0.f, 0.f, 0.f};
    wave_mma<4, 2>(Tms, 72, mP * 16, Rt, 72, nP0 * 16, vn, lane);
#pragma unroll
    for (int nn = 0; nn < 4; ++nn) {
      const int v = (nP0 + nn) * 16 + r;
      *(uint2*)(Vnt + v * 72 + i0) = uint2{cvtpk(vn[nn][0], vn[nn][1]), cvtpk(vn[nn][2], vn[nn][3])};
    }
    lds_barrier();
#pragma unroll
    for (int nn = 0; nn < 4; ++nn)
#pragma unroll
      for (int j = 0; j < 4; ++j) qs[nn][j] *= egi[j];
    wave_mma<4, 2>(Atm, 72, mP * 16, Vnt, 72, nP0 * 16, qs, lane);
#pragma unroll
    for (int j = 0; j < 4; ++j)
#pragma unroll
      for (int nn = 0; nn < 4; ++nn) Os[(i0 + j) * 136 + (nP0 + nn) * 16 + r] = f2bf(qs[nn][j]);
    const float egl = sEG[63];
#pragma unroll
    for (int n8 = 0; n8 < 8; ++n8)
#pragma unroll
      for (int j = 0; j < 4; ++j) ST[n8][j] *= egl;
    wave_mma<8, 2>(Vnt, 72, w * 16, Kdt, 72, 0, ST, lane);
#pragma unroll
    for (int n8 = 0; n8 < 8; ++n8)
#pragma unroll
      for (int j = 0; j < 4; ++j) St[(w * 16 + q * 4 + j) * 136 + n8 * 16 + r] = f2bf(ST[n8][j]);
    lds_barrier();
  }
  {
    const int pp = (N - 1) * 64 + orow;
    const int t = base + (dir ? len - 1 - pp : pp);
    const uint4 o0 = *(const uint4*)(Os + orow * 136 + oseg * 16), o1 = *(const uint4*)(Os + orow * 136 + oseg * 16 + 8);
    *(uint4*)(OUT + (size_t)t * 512 + h * 128 + oseg * 16) = o0;
    *(uint4*)(OUT + (size_t)t * 512 + h * 128 + oseg * 16 + 8) = o1;
  }
  if (!g2) {
#pragma unroll
    for (int n8 = 0; n8 < 8; ++n8)
#pragma unroll
      for (int j = 0; j < 4; ++j)
        p.out[OSD + (((((size_t)s * 2 + l) * 2 + dir) * 4 + h) * 128 + (n8 * 16 + r)) * 128 + (w * 16 + q * 4 + j)] = ST[n8][j];
  }
  lds_barrier();
}

DI void phase_mix2(const Params& p, int l, u16* smem, int* s_item, int tid) {
  int* ctr = (int*)(p.ws + WS_CTR) + l * 4 + 1;
  constexpr int NA2 = 1024 - ATT_X1;
  while (true) {
    if (tid == 0) *s_item = atomicAdd(ctr, 1);
    lds_barrier();
    const int it = *s_item;
    lds_barrier();
    if (it >= 64 + NA2 + 256) break;
    if (it >= 64 && it < 64 + NA2) {
      const int a = it - 64 + ATT_X1;
#ifdef PROBE_MAX
      unsigned long long tb_ = wall_clock64();
#endif
      attn_item(p, 32 + (a >> 7), (a >> 4) & 7, a & 15, smem, tid);
#ifdef PROBE_MAX
      if (tid == 0 && (PROBE_MAX) == 3) atomicMax((int*)(p.ws + WS_CTR) + 32 + l, (int)(wall_clock64() - tb_));
#endif
    } else {
      const int a = (it < 64) ? it : it - 64 - NA2;
#ifdef PROBE_MAX
      unsigned long long tb_ = wall_clock64();
#endif
      dn_scan_item(p, l, (it < 64 ? 32 : 0) + (a >> 3), (a >> 1) & 3, a & 1, smem, tid);
#ifdef PROBE_MAX
      if (tid == 0 && (PROBE_MAX) == 2) atomicMax((int*)(p.ws + WS_CTR) + 32 + l, (int)(wall_clock64() - tb_));
#endif
    }
  }
}

DI void phase_dn_post(const Params& p, int l, int tid, int bid, int nblk) {
  const int lane = tid & 63;
  const int gw = bid * 8 + (tid >> 6), nw = nblk * 8;
  const u16* OF = ws_slab(p, 6); const u16* OB = ws_slab(p, 8); const u16* DG = ws_slab(p, 5); u16* DO = ws_slab(p, 2);
  const float* nwp = p.k.in[21] + l * 128 + (lane & 15) * 8;
  float nwv[8];
#pragma unroll
  for (int e = 0; e < 8; ++e) nwv[e] = nwp[e];
  for (int t0 = gw; t0 < TT; t0 += 4 * nw) {
    uint4 a[4], b[4], g[4];
#pragma unroll
    for (int u = 0; u < 4; ++u) {
      const int t = (t0 + u * nw < TT) ? t0 + u * nw : t0;
      const size_t off = (size_t)t * 512 + lane * 8;
      a[u] = *(const uint4*)(OF + off); b[u] = *(const uint4*)(OB + off); g[u] = *(const uint4*)(DG + off);
    }
#pragma unroll
    for (int u = 0; u < 4; ++u) {
      const int t = t0 + u * nw;
      if (t >= TT) break;
      const unsigned au[4] = {a[u].x, a[u].y, a[u].z, a[u].w}, bu[4] = {b[u].x, b[u].y, b[u].z, b[u].w}, gu[4] = {g[u].x, g[u].y, g[u].z, g[u].w};
      float y[8];
      float ss = 0.f;
#pragma unroll
      for (int e = 0; e < 4; ++e) {
        y[2 * e] = bflo(au[e]) + bflo(bu[e]); y[2 * e + 1] = bfhi(au[e]) + bfhi(bu[e]);
        ss += y[2 * e] * y[2 * e] + y[2 * e + 1] * y[2 * e + 1];
      }
      const float rn = rsqrtf(sum16(ss) * (1.f / 128.f) + EPSF);
      unsigned o[4];
#pragma unroll
      for (int e = 0; e < 4; ++e) {
        float y0 = y[2 * e] * rn * nwv[2 * e] * silu_f(bflo(gu[e]));
        float y1 = y[2 * e + 1] * rn * nwv[2 * e + 1] * silu_f(bfhi(gu[e]));
        o[e] = cvtpk(y0, y1);
      }
      *(uint4*)(DO + (size_t)t * 512 + lane * 8) = uint4{o[0], o[1], o[2], o[3]};
    }
  }
}

#define PHASE_BEGIN int t_ = tid, b_ = bid, l_ = l; size_t z_ = 0; \
  asm volatile("" : "+v"(t_)); asm volatile("" : "+s"(b_)); asm volatile("" : "+s"(l_)); asm volatile("" : "+s"(z_)); \
  unsigned char* w_ = kp.ws + z_; float* o_ = kp.out + z_; \
  Params q{kp, o_, w_};

__global__ void __launch_bounds__(NTHREADS) trunk_megakernel(KParams kp) {
  extern __shared__ __attribute__((aligned(16))) unsigned char dyn_lds[];
  u16* smem = (u16*)dyn_lds;
  int* s_item_p = (int*)(dyn_lds + LDS_WORK);
#ifdef PROBE_SEG
  if (threadIdx.x == 0) *(unsigned long long*)(dyn_lds + 147456 + 8) = 0ull;
  __syncthreads();
#endif
#ifdef PROBE_ITEM
  if (threadIdx.x == 0) *(unsigned long long*)(s_item_p + 2) = 0ull;
  __syncthreads();
#endif
  cg::grid_group grid = cg::this_grid();
  const int tid = threadIdx.x, bid = blockIdx.x, nblk = gridDim.x;
#ifdef TMASK
  unsigned long long tacc = 0, tprev = wall_clock64();
#endif
  { const int l = 0; PHASE_BEGIN phase_mods(q, smem, t_, b_, nblk); }
  grid.sync();
#pragma unroll 1
  for (int l = 0; l < 2; ++l) {
    if (PH(0)) { PHASE_BEGIN phase_convert(q, l_, smem, t_, b_, nblk); }
#ifdef TMASK
    { unsigned long long tn = wall_clock64(); if ((TMASK >> 0) & 1u) tacc += tn - tprev; tprev = tn; }
#endif
    if (PH(1)) { PHASE_BEGIN phase_norm(q, l_, 0, l_ == 0, t_, b_, nblk); }
    grid.sync();
#ifdef TMASK
    { unsigned long long tn = wall_clock64(); if ((TMASK >> 1) & 1u) tacc += tn - tprev; tprev = tn; }
#endif
    if (PH(2)) { PHASE_BEGIN phase_g1(q, 0, smem, t_, b_); }
#ifdef DUP_G1
    grid.sync();
#ifdef TMASK
    { unsigned long long tn = wall_clock64(); if ((TMASK >> 2) & 1u) tacc += tn - tprev; tprev = tn; }
#endif
    { PHASE_BEGIN phase_g1(q, 0, smem, t_, b_); }
#endif
    grid.sync();
    if (PH(3)) { PHASE_BEGIN phase_g2(q, l_, 0, l_ == 0, smem, t_, b_); }
    grid.sync();
#ifdef TMASK
    { unsigned long long tn = wall_clock64(); if ((TMASK >> 3) & 1u) tacc += tn - tprev; tprev = tn; }
#endif
    if (PH(4)) { PHASE_BEGIN phase_norm(q, l_, 1, false, t_, b_, nblk); }
    grid.sync();
#ifdef TMASK
    { unsigned long long tn = wall_clock64(); if ((TMASK >> 4) & 1u) tacc += tn - tprev; tprev = tn; }
#endif
    if (PH(5)) { PHASE_BEGIN phase_g3a(q, smem, t_, b_); }
    grid.sync();
#ifdef TMASK
    { unsigned long long tn = wall_clock64(); if ((TMASK >> 5) & 1u) tacc += tn - tprev; tprev = tn; }
#endif
    if (PH(6)) { PHASE_BEGIN phase_prep(q, l_, t_, b_, nblk); }
    grid.sync();
#ifdef TMASK
    { unsigned long long tn = wall_clock64(); if ((TMASK >> 6) & 1u) tacc += tn - tprev; tprev = tn; }
#endif
    if (PH(7)) { PHASE_BEGIN phase_mix1(q, l_, smem, s_item_p, t_); }
    grid.sync();
#ifdef TMASK
    { unsigned long long tn = wall_clock64(); if ((TMASK >> 7) & 1u) tacc += tn - tprev; tprev = tn; }
#endif
    if (PH(8)) { PHASE_BEGIN phase_g3b(q, smem, t_, b_); }
    grid.sync();
#ifdef TMASK
    { unsigned long long tn = wall_clock64(); if ((TMASK >> 8) & 1u) tacc += tn - tprev; tprev = tn; }
#endif
    if (PH(9)) { PHASE_BEGIN phase_dn_pre(q, l_, smem, t_, b_, nblk); }
    grid.sync();
#ifdef TMASK
    { unsigned long long tn = wall_clock64(); if ((TMASK >> 9) & 1u) tacc += tn - tprev; tprev = tn; }
#endif
    if (PH(10)) { PHASE_BEGIN phase_mix2(q, l_, smem, s_item_p, t_); }
    grid.sync();
#ifdef TMASK
    { unsigned long long tn = wall_clock64(); if ((TMASK >> 10) & 1u) tacc += tn - tprev; tprev = tn; }
#endif
    if (PH(18)) { PHASE_BEGIN phase_g3c(q, smem, t_, b_); }
    grid.sync();
#ifdef TMASK
    { unsigned long long tn = wall_clock64(); if ((TMASK >> 18) & 1u) tacc += tn - tprev; tprev = tn; }
#endif
    if (PH(11)) { PHASE_BEGIN phase_dn_post(q, l_, t_, b_, nblk); }
    grid.sync();
#ifdef TMASK
    { unsigned long long tn = wall_clock64(); if ((TMASK >> 11) & 1u) tacc += tn - tprev; tprev = tn; }
#endif
    if (PH(12)) { PHASE_BEGIN phase_mg(q, smem, t_, b_); }
    grid.sync();
    if (PH(12)) { PHASE_BEGIN
#pragma unroll 1
      for (int b = 0; b < 3; ++b) { int bb = b; asm volatile("" : "+s"(bb)); phase_br(q, bb, smem, t_, b_); } }
    grid.sync();
#ifdef TMASK
    { unsigned long long tn = wall_clock64(); if ((TMASK >> 12) & 1u) tacc += tn - tprev; tprev = tn; }
#endif
    if (PH(13)) { PHASE_BEGIN phase_g5(q, l_, smem, t_, b_); }
    grid.sync();
#ifdef TMASK
    { unsigned long long tn = wall_clock64(); if ((TMASK >> 13) & 1u) tacc += tn - tprev; tprev = tn; }
#endif
    if (PH(14)) { PHASE_BEGIN phase_norm(q, l_, 2, false, t_, b_, nblk); }
    grid.sync();
#ifdef TMASK
    { unsigned long long tn = wall_clock64(); if ((TMASK >> 14) & 1u) tacc += tn - tprev; tprev = tn; }
#endif
    if (PH(15)) { PHASE_BEGIN phase_g1(q, 1, smem, t_, b_); }
    grid.sync();
#ifdef TMASK
    { unsigned long long tn = wall_clock64(); if ((TMASK >> 15) & 1u) tacc += tn - tprev; tprev = tn; }
#endif
    if (PH(16)) { PHASE_BEGIN phase_g2(q, l_, 1, false, smem, t_, b_); }
    grid.sync();
#ifdef TMASK
    { unsigned long long tn = wall_clock64(); if ((TMASK >> 16) & 1u) tacc += tn - tprev; tprev = tn; }
#endif
  }
  if (PH(17)) { Params q{kp, kp.out, kp.ws}; phase_final_norm(q, tid, bid, nblk); }
#ifdef PROBE_MAX
  if (bid == 0 && tid == 0) { int* c_ = (int*)(kp.ws + WS_CTR) + 32; unsigned long long ta = (unsigned long long)(__hip_atomic_load(c_, __ATOMIC_RELAXED, __HIP_MEMORY_SCOPE_AGENT) + __hip_atomic_load(c_ + 1, __ATOMIC_RELAXED, __HIP_MEMORY_SCOPE_AGENT)); unsigned long long te = wall_clock64(); while (wall_clock64() - te < ta) { __builtin_amdgcn_s_sleep(8); } }
#endif
#ifdef PROBE_SEG
  if (tid == 0) { unsigned long long ta = *(unsigned long long*)(dyn_lds + 147456 + 8); unsigned long long te = wall_clock64(); while (wall_clock64() - te < ta) { __builtin_amdgcn_s_sleep(8); } }
#endif
#ifdef PROBE_ITEM
  if (bid == nblk - 1 && tid == 0) { unsigned long long ta = *(unsigned long long*)(s_item_p + 2); unsigned long long te = wall_clock64(); while (wall_clock64() - te < ta) { __builtin_amdgcn_s_sleep(8); } }
#endif
#ifdef TMASK
  if (bid == 0) { unsigned long long te = wall_clock64(); while (wall_clock64() - te < tacc) { __builtin_amdgcn_s_sleep(8); } }
#endif
}

extern "C" void kernel_launch(void* const* d_in, const int* in_sizes, int n_in, void* d_out, int out_size, void* d_ws, size_t ws_size,
                              hipStream_t stream) {
  static int grid_blocks = 0;
  if (!grid_blocks) {
    int dev = 0, cus = 0, per_cu = 0;
    hipGetDevice(&dev);
    hipDeviceGetAttribute(&cus, hipDeviceAttributeMultiprocessorCount, dev);
    hipFuncSetAttribute((const void*)trunk_megakernel, hipFuncAttributeMaxDynamicSharedMemorySize, LDS_DYN);
    hipOccupancyMaxActiveBlocksPerMultiprocessor(&per_cu, trunk_megakernel, NTHREADS, LDS_DYN);
    if (per_cu < 1) per_cu = 1;
    grid_blocks = cus * per_cu;
  }
  if (ws_size < WS_END) { fprintf(stderr, "workspace too small: %zu < %zu\n", ws_size, (size_t)WS_END); return; }
  KParams p{};
  for (int i = 0; i < 30; ++i) p.in[i] = (const float*)d_in[i];
  p.out = (float*)d_out;
  p.ws = (unsigned char*)d_ws;
  void* args[] = {&p};
  hipError_t e = hipLaunchCooperativeKernel((void*)trunk_megakernel, dim3(grid_blocks), dim3(NTHREADS), args, LDS_DYN, stream);
  if (e != hipSuccess) fprintf(stderr, "cooperative launch failed: %s (grid %d)\n", hipGetErrorString(e), grid_blocks);
}
```

```cpp
#include <hip/hip_runtime.h>
#include <hip/hip_cooperative_groups.h>
#include <cstdio>
namespace cg = cooperative_groups;

typedef unsigned short u16;
using bf16x8 = __attribute__((ext_vector_type(8))) short;
using f32x4 = __attribute__((ext_vector_type(4))) float;
#define DI __device__ __forceinline__

constexpr int TT = 40960;
constexpr int TI = 8192;
constexpr int DM = 1024;
constexpr int DFF = 2816;
constexpr float EPSF = 1e-6f;
constexpr int NTHREADS = 512;
constexpr int LDS_WORK = 161536;
constexpr int LDS_DYN = LDS_WORK + 32;
#ifndef PHMASK
#define PHMASK 0xffffffffu
#endif
#define PH(i) ((PHMASK >> (i)) & 1u)

constexpr size_t OCK = 41943040, OCV = 44040192, OSR = 46137344, OSD = 50331648;

constexpr size_t W1IN = 0, W1OUT = 5767168, WIN = 8650752, WBR = 17039360, WOUT = 18612224, W2IN = 19660800, W2OUT = 25427968, WTOTAL = 28311552;
constexpr size_t WS_W = 0;
constexpr size_t WS_H = WTOTAL * 2;
constexpr size_t SLABB = (size_t)TT * 512 * 2;
constexpr size_t WS_SLAB = WS_H + (size_t)TT * 1024 * 2;
constexpr size_t WS_MODS = WS_SLAB + 9 * SLABB;
constexpr size_t WS_DAB = WS_MODS + 2 * 9 * 9216 * 4;
constexpr size_t WS_GBG = WS_DAB + (size_t)TT * 16 * 4;
constexpr size_t WS_GBB = WS_GBG + (size_t)TT * 8 * 4;
constexpr size_t WS_HALO = WS_GBB + (size_t)TT * 8 * 4;
constexpr size_t WS_CTR = WS_HALO + (size_t)640 * 2 * 1536 * 2;
constexpr size_t WS_ROPE = WS_CTR + 256;
constexpr size_t WS_BAR = WS_ROPE + 2 * 1024 * 4;
constexpr size_t WS_END = WS_BAR + 256;
constexpr size_t KC_VT_OFF = 5505024;

struct KParams {
  const float* in[30];
  float* out;
  unsigned char* ws;
};
struct Params {
  const KParams& k;
  float* out;
  unsigned char* ws;
};

typedef __bf16 bf16v2_t __attribute__((ext_vector_type(2)));
typedef float f32v2_t __attribute__((ext_vector_type(2)));
typedef float f32x2_t __attribute__((ext_vector_type(2)));
DI unsigned cvtpk(float lo, float hi) { f32v2_t v = {lo, hi}; bf16v2_t b = __builtin_convertvector(v, bf16v2_t); return __builtin_bit_cast(unsigned, b); }
DI u16 f2bf(float x) { return (u16)(cvtpk(x, 0.f) & 0xffffu); }
DI float bf2f(u16 h) { return __uint_as_float(((unsigned)h) << 16); }
DI float bflo(unsigned u) { return __uint_as_float(u << 16); }
DI float bfhi(unsigned u) { return __uint_as_float(u & 0xffff0000u); }
DI f32x4 mfma16(bf16x8 a, bf16x8 b, f32x4 c) { return __builtin_amdgcn_mfma_f32_16x16x32_bf16(a, b, c, 0, 0, 0); }
DI float silu_f(float x) { return x / (1.f + __expf(-x)); }
DI float sigmoid_f(float x) { return 1.f / (1.f + __expf(-x)); }
DI float wave_sum(float x) {
#pragma unroll
  for (int o = 32; o >= 1; o >>= 1) x += __shfl_xor(x, o);
  return x;
}
DI float sum16(float x) {
  x += __shfl_xor(x, 1); x += __shfl_xor(x, 2); x += __shfl_xor(x, 4); x += __shfl_xor(x, 8);
  return x;
}
DI float max16(float x) {
  x = fmaxf(x, __shfl_xor(x, 1)); x = fmaxf(x, __shfl_xor(x, 2)); x = fmaxf(x, __shfl_xor(x, 4)); x = fmaxf(x, __shfl_xor(x, 8));
  return x;
}
DI void lds_barrier() { asm volatile("s_waitcnt lgkmcnt(0)" ::: "memory"); __builtin_amdgcn_s_barrier(); asm volatile("" ::: "memory"); }
DI int seq_base(int s) { return s < 32 ? s * 256 : TI + (s - 32) * 4096; }
DI int seq_len(int s) { return s < 32 ? 256 : 4096; }
DI int modrow_of(int t) { return t < TI ? 0 : 1 + ((t - TI) >> 12); }
DI const float* xin_row(const Params& p, int t) { return t < TI ? p.k.in[0] + (size_t)t * DM : p.k.in[1] + (size_t)(t - TI) * DM; }
DI size_t kv_base(int s, int kvh) { return s < 32 ? (size_t)(s * 2 + kvh) * (256 * 64) : (size_t)1048576 + (size_t)((s - 32) * 2 + kvh) * (4352 * 64); }

DI u16* ws_w(const Params& p) { return (u16*)(p.ws + WS_W); }
DI u16* ws_h(const Params& p) { return (u16*)(p.ws + WS_H); }
DI u16* ws_slab(const Params& p, int i) { return (u16*)(p.ws + WS_SLAB + (size_t)i * SLABB); }
DI float* ws_mods(const Params& p) { return (float*)(p.ws + WS_MODS); }

template <int NT, int KS>
DI void wave_mma(const u16* A, int lda, int arow0, const u16* B, int ldb, int brow0, f32x4 (&acc)[NT], int lane) {
  const int r = lane & 15, q = lane >> 4;
#pragma unroll
  for (int ks = 0; ks < KS; ++ks) {
    bf16x8 a = *(const bf16x8*)(A + (arow0 + r) * lda + ks * 32 + q * 8);
#pragma unroll
    for (int n = 0; n < NT; ++n) {
      bf16x8 b = *(const bf16x8*)(B + (brow0 + n * 16 + r) * ldb + ks * 32 + q * 8);
      acc[n] = mfma16(a, b, acc[n]);
    }
  }
}

namespace pg8 {
#define PG8_LAS __attribute__((address_space(3)))
typedef unsigned short bf16_t;
typedef short bf16x8 __attribute__((ext_vector_type(8)));
typedef float f32x4 __attribute__((ext_vector_type(4)));
typedef unsigned u32x4 __attribute__((ext_vector_type(4)));
constexpr int BM = 256, BK = 64, HALF = 128, HTB = HALF * BK * 2  , STAGE_BYTES = 8 * HTB, NXCD = 8, WGM = 8;

__host__ __device__ __forceinline__ int lds_byte(int r, int c) { const int st = (r >> 4) * 2 + (c >> 5), rr = r & 15, cc = c & 31, ob = rr * 64 + cc * 2; return st * 1024 + (ob ^ (((ob >> 9) & 1) << 5)); }
__host__ __device__ __forceinline__ void stage_rc(int b, int& R, int& C) { const int st = b / 1024, sb = b % 1024, swz = sb ^ (((sb >> 9) & 1) << 5); R = (st >> 1) * 16 + swz / 64; C = (st & 1) * 32 + (swz % 64) / 2; }
__host__ __device__ __forceinline__ int perm32(int rho) { const int n = rho >> 4, i = rho & 15; return 8 * (i >> 2) + 4 * n + (i & 3); }

struct Unit { int pm, pn; };
struct Gemm { const bf16_t* A; const bf16_t* Bt; int M, N, K; };

struct StaticOrder {
    int nM, nN, nwg, G, c;
    __host__ __device__ void init(int M, int N, int G_, int c_) { nM = M / BM; nN = N / BM; nwg = nM * nN; G = G_; c = c_; }
    __host__ __device__ bool next(int i, Unit& u) const {
        const long L = (long)i * G + c; if (L >= nwg) return false;
        int wgid = (int)L; { const int q = nwg / NXCD, r = nwg % NXCD, xcd = wgid % NXCD, off = wgid / NXCD; wgid = (xcd < r ? xcd * (q + 1) : r * (q + 1) + (xcd - r) * q) + off; }
        const int nig = WGM * nN, gid = wgid / nig, fm = gid * WGM, gsz = (nM - fm) < WGM ? (nM - fm) : WGM;
        u.pm = fm + ((wgid % nig) % gsz); u.pn = (wgid % nig) / gsz; return true;
    }
    __device__ __forceinline__ void a_ready(const Unit&) const {}
    __device__ __forceinline__ void done(const Unit&) const {}
};
template <class Epi, class Sched, bool STAMP = false>
__device__ __forceinline__ void gemm_phase(PG8_LAS unsigned char* lds, const Gemm g, const Sched& S, const Epi& E, unsigned long long* stamps, int tid_in) {
    const int tid = tid_in, wid = __builtin_amdgcn_readfirstlane(tid >> 6), lane = tid & 63, wr = wid >> 2, wc = wid & 3, fr = lane & 15, fq = lane >> 4;
    const int K = g.K, nt = K / BK;
    float zf_ = 0.f; asm volatile("" : "+v"(zf_));
    int ts_lo = 0, ts_hi = 0, nts = 0; const unsigned long long rt_entry = STAMP ? (unsigned long long)wall_clock64() : 0ull;
#define PG8_STAMP() do { if (STAMP && wid == 0 && nts < 64) { const unsigned long long _c = (unsigned long long)clock64(); \
        ts_lo = (lane == nts) ? (int)(unsigned)_c : ts_lo; ts_hi = (lane == nts) ? (int)(unsigned)(_c >> 32) : ts_hi; ++nts; } } while (0)
    PG8_STAMP();
    unsigned voffA[2], voffB[2];
#pragma unroll
    for (int i = 0; i < 2; ++i) { int R, C; stage_rc(tid * 16 + i * 8192, R, C); const int Rb = Epi::PERM ? ((R & ~31) + perm32(R & 31)) : R;
        voffA[i] = (unsigned)(R * K + C) * 2u; voffB[i] = (unsigned)(Rb * K + C) * 2u; }
    const size_t kstep = (size_t)(BK * 2);
    const size_t hstep = (size_t)HALF * K * 2;
    const size_t tstep = 2 * hstep;
    const unsigned ldsw = (unsigned)wid * 1024u;
    const int aoff = lds_byte(wr * 64 + fr, fq * 8), boff = lds_byte(wc * 32 + fr, fq * 8);
#define PG8_SA(b, h) (((b) * 2 + (h)) * HTB)
#define PG8_SB(b, h) ((4 + (b) * 2 + (h)) * HTB)
#define PG8_STAGE(bufoff, gbase, voff) do { _Pragma("unroll") for (int _i = 0; _i < 2; ++_i) \
        __builtin_amdgcn_global_load_lds((const unsigned*)((const char*)(gbase) + (voff)[_i]), (PG8_LAS unsigned*)(lds + (bufoff) + ldsw + _i * 8192), 16, 0, 0); } while (0)
#define PG8_LDA(dst, b, h) do { _Pragma("unroll") for (int m = 0; m < 4; ++m) _Pragma("unroll") for (int k = 0; k < 2; ++k) dst[m][k] = *(const PG8_LAS bf16x8*)(lds + PG8_SA(b, h) + aoff + m * 2048 + k * 1024); } while (0)
#define PG8_LDB(dst, b, h) do { _Pragma("unroll") for (int n = 0; n < 2; ++n) _Pragma("unroll") for (int k = 0; k < 2; ++k) dst[n][k] = *(const PG8_LAS bf16x8*)(lds + PG8_SB(b, h) + boff + n * 2048 + k * 1024); } while (0)
#define PG8_MMA(ai, bj, At, Bt) do { __builtin_amdgcn_s_setprio(1); _Pragma("unroll") for (int m = 0; m < 4; ++m) _Pragma("unroll") for (int n = 0; n < 2; ++n) _Pragma("unroll") for (int k = 0; k < 2; ++k) \
        acc[ai][bj][m][n] = __builtin_amdgcn_mfma_f32_16x16x32_bf16(Bt[n][k], At[m][k], acc[ai][bj][m][n], 0, 0, 0); __builtin_amdgcn_s_setprio(0); } while (0)
#define PG8_WAIT_V(n) asm volatile("s_waitcnt vmcnt(" #n ")" ::: "memory")
#define PG8_WAIT_L(n) asm volatile("s_waitcnt lgkmcnt(" #n ")" ::: "memory")
#define PG8_BAR __builtin_amdgcn_s_barrier()
#define PG8_SCHED __builtin_amdgcn_sched_barrier(0)
    Unit cur, nxt; int ui = 0;
    if (!S.next(0, cur)) return;
    f32x4 acc[2][2][4][2];
#pragma unroll
    for (int a = 0; a < 2; ++a)
#pragma unroll
        for (int b = 0; b < 2; ++b)
#pragma unroll
            for (int m = 0; m < 4; ++m)
#pragma unroll
                for (int n = 0; n < 2; ++n) acc[a][b][m][n] = (f32x4){zf_, zf_, zf_, zf_};
    bf16x8 At[4][2], B0[2][2], B1[2][2];
    const char* cA = (const char*)g.A + (size_t)cur.pm * tstep; const char* cB = (const char*)g.Bt + (size_t)cur.pn * tstep;
    S.a_ready(cur);
    PG8_STAGE(PG8_SB(0, 0), cB, voffB); PG8_STAGE(PG8_SA(0, 0), cA, voffA); PG8_STAGE(PG8_SB(0, 1), cB + hstep, voffB); PG8_STAGE(PG8_SA(0, 1), cA + hstep, voffA);
    if (wr == 1) PG8_BAR;
    PG8_WAIT_V(4); PG8_BAR;
    PG8_STAGE(PG8_SB(1, 0), cB + kstep, voffB); PG8_STAGE(PG8_SA(1, 0), cA + kstep, voffA); PG8_STAGE(PG8_SB(1, 1), cB + hstep + kstep, voffB);
    PG8_WAIT_V(6); PG8_BAR;
    PG8_STAMP();
    for (;;) {
        const bool has_next = S.next(ui + 1, nxt);
        const char* nA = has_next ? (const char*)g.A + (size_t)nxt.pm * tstep : cA; const char* nB = has_next ? (const char*)g.Bt + (size_t)nxt.pn * tstep : cB;
        for (int t = 0; t < nt; t += 2) {
            const bool last = (t == nt - 2);
            const char* a1 = cA + (size_t)(t + 1) * kstep;
            const char* a2 = last ? nA : cA + (size_t)(t + 2) * kstep; const char* b2 = last ? nB : cB + (size_t)(t + 2) * kstep;
            const char* a3 = a2 + kstep; const char* b3 = b2 + kstep;
            if (last && has_next) S.a_ready(nxt);
            PG8_LDB(B0, 0, 0); PG8_SCHED; PG8_LDA(At, 0, 0); PG8_STAGE(PG8_SA(1, 1), a1 + hstep, voffA);
            PG8_WAIT_L(8); PG8_BAR; PG8_WAIT_L(0); PG8_MMA(0, 0, At, B0); PG8_BAR; PG8_SCHED;
            PG8_LDB(B1, 0, 1); PG8_STAGE(PG8_SB(0, 0), b2, voffB);
            PG8_BAR; PG8_WAIT_L(0); PG8_MMA(0, 1, At, B1); PG8_BAR;
            PG8_LDA(At, 0, 1); PG8_STAGE(PG8_SA(0, 0), a2, voffA);
            PG8_BAR; PG8_WAIT_L(0); PG8_MMA(1, 0, At, B0); PG8_BAR; PG8_SCHED;
            PG8_STAGE(PG8_SB(0, 1), b2 + hstep, voffB);
            PG8_WAIT_V(6); PG8_BAR; PG8_MMA(1, 1, At, B1); PG8_BAR;
            PG8_LDB(B0, 1, 0); PG8_SCHED; PG8_LDA(At, 1, 0); PG8_STAGE(PG8_SA(0, 1), a2 + hstep, voffA);
            PG8_WAIT_L(8); PG8_BAR; PG8_WAIT_L(0); PG8_MMA(0, 0, At, B0); PG8_BAR; PG8_SCHED;
            PG8_LDB(B1, 1, 1); PG8_STAGE(PG8_SB(1, 0), b3, voffB);
            PG8_BAR; PG8_WAIT_L(0); PG8_MMA(0, 1, At, B1); PG8_BAR;
            PG8_LDA(At, 1, 1); PG8_STAGE(PG8_SA(1, 0), a3, voffA);
            PG8_BAR; PG8_WAIT_L(0); PG8_MMA(1, 0, At, B0); PG8_BAR; PG8_SCHED;
            PG8_STAGE(PG8_SB(1, 1), b3 + hstep, voffB);
            PG8_WAIT_V(6); PG8_BAR; PG8_MMA(1, 1, At, B1); PG8_BAR;
        }
        PG8_STAMP();
        if constexpr (!Epi::AFTER_DRAIN) { E(acc, cur, wr, wc, fr, fq); S.done(cur); }
        PG8_STAMP();
        if (!has_next) break;
#pragma unroll
        for (int a = 0; a < 2; ++a)
#pragma unroll
            for (int b = 0; b < 2; ++b)
#pragma unroll
                for (int m = 0; m < 4; ++m)
#pragma unroll
                    for (int n = 0; n < 2; ++n) acc[a][b][m][n] = (f32x4){zf_, zf_, zf_, zf_};
        cur = nxt; cA = nA; cB = nB; ++ui;
    }
    PG8_WAIT_V(0);
    if (wr == 0) PG8_BAR;
    PG8_BAR;
    if constexpr (Epi::AFTER_DRAIN) { E.fused(acc, cur, wr, wc, fr, fq, lds, wid, lane); S.done(cur); }
    PG8_STAMP();
    if (STAMP && wid == 0) { stamps[lane] = lane < nts ? (((unsigned long long)(unsigned)ts_hi << 32) | (unsigned)ts_lo) : 0ull;
        if (lane == 62) stamps[62] = rt_entry; if (lane == 63) stamps[63] = (unsigned long long)wall_clock64(); }
#undef PG8_STAMP
#undef PG8_SA
#undef PG8_SB
#undef PG8_STAGE
#undef PG8_LDA
#undef PG8_LDB
#undef PG8_MMA
#undef PG8_WAIT_V
#undef PG8_WAIT_L
#undef PG8_BAR
#undef PG8_SCHED
}
}

template <int MT>
DI void zero_acc(f32x4 (&acc)[MT][4]) {
#pragma unroll
  for (int m = 0; m < MT; ++m)
#pragma unroll
    for (int n = 0; n < 4; ++n) acc[m][n] = f32x4{0.f, 0.f, 0.f, 0.f};
}

DI int map_row(int type, int col) {
  if (type == 0) return col;
  if (type == 1) { if (col < DFF) return 256 * (col >> 7) + (col & 127); int c = col - DFF; return 256 * (c >> 7) + 128 + (c & 127); }
  if (col < 4352) return col;
  if (col < 4368) return 2816 + 1536 + (col - 4352);
  if (col < 4880) return 2816 + 1792 + (col - 4368);
  return 5120 + (col - 4880);
}

DI void conv_tile(const float* __restrict__ src, int ld, int ncols, int k0, int c0, u16* __restrict__ dst, int K, int type, u16* sm, int tid) {
  {
    const int n = tid & 63, kk = tid >> 6;
    const bool ok = (c0 + n) < ncols;
#pragma unroll
    for (int i = 0; i < 8; ++i) {
      int k = kk + 8 * i;
      float v = ok ? src[(size_t)(k0 + k) * ld + c0 + n] : 0.f;
      sm[n * 72 + k] = f2bf(v);
    }
  }
  lds_barrier();
  {
    const int n2 = tid >> 3, seg = tid & 7;
    const int col = c0 + n2;
    if (col < ncols) {
      int row = map_row(type, col);
      *(uint4*)(dst + (size_t)row * K + k0 + seg * 8) = *(const uint4*)(sm + n2 * 72 + seg * 8);
    }
  }
  lds_barrier();
}

DI void phase_convert(const Params& p, int l, u16* smem, int tid, int bid, int nblk) {
  u16* W = ws_w(p);
  const int NJ = 9;
  const int cum[NJ + 1] = {0, 1408, 2112, 4112, 4240, 4368, 4496, 4752, 6160, 6864};
  const int nconv = 6864;
  const int nmod = 0;
  const int total = nconv + 1 + nmod;
  for (int it = bid; it < total; it += nblk) {
    if (it < nconv) {
      int j = 0;
#pragma unroll
      for (int jj = 1; jj < NJ; ++jj) if (it >= cum[jj]) j = jj;
      int t = it - cum[j];
      const float* src; int ld, ncols, K, type = 0, nct; u16* dst;
      switch (j) {
        case 0: src = p.k.in[11] + (size_t)l * 1024 * 5632; ld = 5632; ncols = 5632; K = 1024; type = 1; nct = 88; dst = W + W1IN; break;
        case 1: src = p.k.in[12] + (size_t)l * 2816 * 1024; ld = 1024; ncols = 1024; K = 2816; nct = 16; dst = W + W1OUT; break;
        case 2: src = p.k.in[14] + (size_t)l * 1024 * 7952; ld = 7952; ncols = 7952; K = 1024; type = 2; nct = 125; dst = W + WIN; break;
        case 3: src = p.k.in[22] + (size_t)l * 512 * 1024; ld = 1024; ncols = 1024; K = 512; nct = 16; dst = W + WBR; break;
        case 4: src = p.k.in[23] + (size_t)l * 512 * 1024; ld = 1024; ncols = 1024; K = 512; nct = 16; dst = W + WBR + 524288; break;
        case 5: src = p.k.in[24] + (size_t)l * 512 * 1024; ld = 1024; ncols = 1024; K = 512; nct = 16; dst = W + WBR + 2 * 524288; break;
        case 6: src = p.k.in[25] + (size_t)l * 1024 * 1024; ld = 1024; ncols = 1024; K = 1024; nct = 16; dst = W + WOUT; break;
        case 7: src = p.k.in[27] + (size_t)l * 1024 * 5632; ld = 5632; ncols = 5632; K = 1024; type = 1; nct = 88; dst = W + W2IN; break;
        default: src = p.k.in[28] + (size_t)l * 2816 * 1024; ld = 1024; ncols = 1024; K = 2816; nct = 16; dst = W + W2OUT; break;
      }
      int kt = t / nct, ct = t % nct;
      conv_tile(src, ld, ncols, kt * 64, ct * 64, dst, K, type, smem, tid);
    } else if (it == nconv) {
      u16* z = W + WIN + (size_t)(2816 + 1552) * 1024;
      unsigned zu = 0u; asm volatile("" : "+v"(zu));
      for (int i = tid; i < 240 * 1024 / 8; i += NTHREADS) *(uint4*)(z + i * 8) = uint4{zu, zu, zu, zu};
    }
  }
}

DI void phase_mods(const Params& p, u16* smem, int tid, int bid, int nblk) {
  if (bid == 0 && tid < 64) ((int*)(p.ws + WS_CTR))[tid] = 0;
  if (bid == 1) {
    float* ROPE = (float*)(p.ws + WS_ROPE);
    for (int i = tid; i < 1024; i += NTHREADS) {
      float inv = exp2f(-(float)(i & 15) * (13.287712379549449f / 16.f));
      float sn, cs;
      sincosf((float)(i >> 4) * inv, &sn, &cs);
      ROPE[i] = cs; ROPE[1024 + i] = sn;
    }
  }
  const int nconv = -1;
  for (int it = bid; it < 288; it += nblk) {
    {
      int mi = it - nconv - 1;
      int ml = mi / 144, cb = mi % 144;
      float* sc = (float*)smem;
      float* red = sc + 9 * 1024;
      for (int i = tid; i < 9 * 1024; i += NTHREADS) {
        int r = i >> 10, k = i & 1023;
        float c = (r == 0) ? p.k.in[7][k] : p.k.in[6][(r - 1) * 1024 + k];
        sc[i] = silu_f(c);
      }
      __syncthreads();
      const int n = tid & 63, kg = tid >> 6;
      const float* Wm = p.k.in[8] + (size_t)ml * 1024 * 9216 + cb * 64 + n;
      float a[9];
#pragma unroll
      for (int r = 0; r < 9; ++r) a[r] = 0.f;
#pragma unroll 8
      for (int k = kg * 128; k < kg * 128 + 128; ++k) {
        float wv = Wm[(size_t)k * 9216];
#pragma unroll
        for (int r = 0; r < 9; ++r) a[r] += sc[r * 1024 + k] * wv;
      }
#pragma unroll
      for (int r = 0; r < 9; ++r) red[(kg * 9 + r) * 64 + n] = a[r];
      __syncthreads();
      for (int i = tid; i < 576; i += NTHREADS) {
        int r = i >> 6, nn = i & 63;
        float s = p.k.in[9][(size_t)ml * 9216 + cb * 64 + nn];
#pragma unroll
        for (int g = 0; g < 8; ++g) s += red[(g * 9 + r) * 64 + nn];
        ws_mods(p)[(size_t)(ml * 9 + r) * 9216 + cb * 64 + nn] = s;
      }
      __syncthreads();
    }
  }
}

DI void phase_norm(const Params& p, int l, int which, bool first, int tid, int bid, int nblk) {
  const int lane = tid & 63;
  const int gw = bid * 8 + (tid >> 6), nw = nblk * 8;
  const float* nwp = p.k.in[which == 0 ? 10 : (which == 1 ? 13 : 26)] + l * 1024;
  u16* H = ws_h(p);
  for (int t0 = gw; t0 < TT; t0 += 2 * nw) {
    const int t1 = t0 + nw;
    const bool has1 = t1 < TT;
    const float* xr0 = first ? xin_row(p, t0) : p.out + (size_t)t0 * DM;
    const float* xr1 = has1 ? (first ? xin_row(p, t1) : p.out + (size_t)t1 * DM) : xr0;
    float4 v[2][4];
#pragma unroll
    for (int i = 0; i < 4; ++i) { v[0][i] = *(const float4*)(xr0 + i * 256 + lane * 4); v[1][i] = *(const float4*)(xr1 + i * 256 + lane * 4); }
#pragma unroll
    for (int rr = 0; rr < 2; ++rr) {
      if (rr == 1 && !has1) break;
      const int t = rr ? t1 : t0;
      float ss = 0.f;
#pragma unroll
      for (int i = 0; i < 4; ++i) ss += v[rr][i].x * v[rr][i].x + v[rr][i].y * v[rr][i].y + v[rr][i].z * v[rr][i].z + v[rr][i].w * v[rr][i].w;
      ss = wave_sum(ss);
      const float rstd = rsqrtf(ss * (1.f / 1024.f) + EPSF);
      const float* mod = ws_mods(p) + (size_t)(l * 9 + modrow_of(t)) * 9216;
      const float* sh = mod + (3 * which) * 1024;
      const float* sc = mod + (3 * which + 1) * 1024;
#pragma unroll
      for (int i = 0; i < 4; ++i) {
        int c = i * 256 + lane * 4;
        float4 wv = *(const float4*)(nwp + c), s4 = *(const float4*)(sc + c), h4 = *(const float4*)(sh + c);
        float y0 = v[rr][i].x * rstd * wv.x * (1.f + s4.x) + h4.x;
        float y1 = v[rr][i].y * rstd * wv.y * (1.f + s4.y) + h4.y;
        float y2 = v[rr][i].z * rstd * wv.z * (1.f + s4.z) + h4.z;
        float y3 = v[rr][i].w * rstd * wv.w * (1.f + s4.w) + h4.w;
        *(uint2*)(H + (size_t)t * 1024 + c) = uint2{cvtpk(y0, y1), cvtpk(y2, y3)};
      }
    }
  }
}

DI void phase_final_norm(const Params& p, int tid, int bid, int nblk) {
  const int lane = tid & 63;
  const int gw = bid * 8 + (tid >> 6), nw = nblk * 8;
  const float* nwp = p.k.in[29];
  for (int t0 = gw; t0 < TT; t0 += 2 * nw) {
    const int t1 = t0 + nw;
    const bool has1 = t1 < TT;
    float* xr0 = p.out + (size_t)t0 * DM;
    float* xr1 = has1 ? p.out + (size_t)t1 * DM : xr0;
    float4 v[2][4];
#pragma unroll
    for (int i = 0; i < 4; ++i) { v[0][i] = *(const float4*)(xr0 + i * 256 + lane * 4); v[1][i] = *(const float4*)(xr1 + i * 256 + lane * 4); }
#pragma unroll
    for (int rr = 0; rr < 2; ++rr) {
      if (rr == 1 && !has1) break;
      float* xr = rr ? xr1 : xr0;
      float ss = 0.f;
#pragma unroll
      for (int i = 0; i < 4; ++i) ss += v[rr][i].x * v[rr][i].x + v[rr][i].y * v[rr][i].y + v[rr][i].z * v[rr][i].z + v[rr][i].w * v[rr][i].w;
      ss = wave_sum(ss);
      const float rstd = rsqrtf(ss * (1.f / 1024.f) + EPSF);
#pragma unroll
      for (int i = 0; i < 4; ++i) {
        int c = i * 256 + lane * 4;
        float4 wv = *(const float4*)(nwp + c);
        *(float4*)(xr + c) = float4{v[rr][i].x * rstd * wv.x, v[rr][i].y * rstd * wv.y, v[rr][i].z * rstd * wv.z, v[rr][i].w * rstd * wv.w};
      }
    }
  }
}

typedef __attribute__((address_space(3))) unsigned char lds_u8;

struct EpiSwiglu {
  static constexpr bool PERM = true, AFTER_DRAIN = false;
  u16* hid;
  DI void operator()(const f32x4 (&acc)[2][2][4][2], const pg8::Unit& u, int wr, int wc, int fr, int fq) const {
    const int row0 = u.pm * 256 + wr * 64 + fr, col0 = u.pn * 128 + wc * 32 + fq * 8;
#pragma unroll
    for (int ai = 0; ai < 2; ++ai)
#pragma unroll
      for (int m = 0; m < 4; ++m) {
        const f32x4 g0 = acc[ai][0][m][0], g1 = acc[ai][0][m][1], u0 = acc[ai][1][m][0], u1 = acc[ai][1][m][1];
        uint4 o;
        o.x = cvtpk(silu_f(g0[0]) * u0[0], silu_f(g0[1]) * u0[1]);
        o.y = cvtpk(silu_f(g0[2]) * u0[2], silu_f(g0[3]) * u0[3]);
        o.z = cvtpk(silu_f(g1[0]) * u1[0], silu_f(g1[1]) * u1[1]);
        o.w = cvtpk(silu_f(g1[2]) * u1[2], silu_f(g1[3]) * u1[3]);
        *(uint4*)(hid + (size_t)(row0 + ai * 128 + m * 16) * DFF + col0) = o;
      }
  }
};

struct EpiResid {
  static constexpr bool PERM = false, AFTER_DRAIN = false;
  const float* x0; const float* x1; float* out; const float* gm_base; float scale; bool first;
  DI const float* src_row(int row) const { return first ? (row < TI ? x0 + (size_t)row * DM : x1 + (size_t)(row - TI) * DM) : out + (size_t)row * DM; }
  DI void operator()(const f32x4 (&acc)[2][2][4][2], const pg8::Unit& u, int wr, int wc, int fr, int fq) const {
    const float* gm = gm_base + (size_t)modrow_of(u.pm * 256) * 9216;
    const int row0 = u.pm * 256 + wr * 64 + fr, col0 = u.pn * 256 + wc * 32 + 4 * fq;
    f32x4 gv[2][2];
#pragma unroll
    for (int bj = 0; bj < 2; ++bj)
#pragma unroll
      for (int n = 0; n < 2; ++n) gv[bj][n] = *(const f32x4*)(gm + col0 + bj * 128 + n * 16) * scale;
    f32x4 xa[2][2], xb[2][2];
    {
      const float* __restrict__ xr = src_row(row0) + col0;
      const float* __restrict__ xs = src_row(row0 + 16) + col0;
#pragma unroll
      for (int bj = 0; bj < 2; ++bj)
#pragma unroll
        for (int n = 0; n < 2; ++n) { xa[bj][n] = *(const f32x4*)(xr + bj * 128 + n * 16); xb[bj][n] = *(const f32x4*)(xs + bj * 128 + n * 16); }
    }
#pragma unroll
    for (int rr = 0; rr < 8; ++rr) {
      const int ai = rr >> 2, m = rr & 3;
      f32x4 nx[2][2];
      if (rr + 2 < 8) {
        const float* __restrict__ xr = src_row(row0 + ((rr + 2) >> 2) * 128 + ((rr + 2) & 3) * 16) + col0;
#pragma unroll
        for (int bj = 0; bj < 2; ++bj)
#pragma unroll
          for (int n = 0; n < 2; ++n) nx[bj][n] = *(const f32x4*)(xr + bj * 128 + n * 16);
      }
      float* __restrict__ xo = out + (size_t)(row0 + ai * 128 + m * 16) * DM + col0;
#pragma unroll
      for (int bj = 0; bj < 2; ++bj)
#pragma unroll
        for (int n = 0; n < 2; ++n) *(f32x4*)(xo + bj * 128 + n * 16) = xa[bj][n] + gv[bj][n] * acc[ai][bj][m][n];
#pragma unroll
      for (int bj = 0; bj < 2; ++bj)
#pragma unroll
        for (int n = 0; n < 2; ++n) { xa[bj][n] = xb[bj][n]; if (rr + 2 < 8) xb[bj][n] = nx[bj][n]; }
    }
  }
};

DI uint4 pack8(const f32x4& a, const f32x4& b) { return uint4{cvtpk(a[0], a[1]), cvtpk(a[2], a[3]), cvtpk(b[0], b[1]), cvtpk(b[2], b[3])}; }

struct EpiProjA {
  static constexpr bool PERM = true, AFTER_DRAIN = false;
  unsigned char* slab0;
  DI void operator()(const f32x4 (&acc)[2][2][4][2], const pg8::Unit& u, int wr, int wc, int fr, int fq) const {
    u16* dst; int ldd, c0;
    if (u.pn < 2) { dst = (u16*)slab0; ldd = 512; c0 = u.pn * 256; }
    else if (u.pn == 2) { dst = (u16*)(slab0 + 6 * SLABB); ldd = 256; c0 = 0; }
    else { dst = (u16*)(slab0 + (size_t)(2 + ((u.pn - 3) >> 1)) * SLABB); ldd = 512; c0 = ((u.pn - 3) & 1) * 256; }
    const int row0 = u.pm * 256 + wr * 64 + fr, col0 = c0 + wc * 32 + fq * 8;
#pragma unroll
    for (int ai = 0; ai < 2; ++ai)
#pragma unroll
      for (int m = 0; m < 4; ++m)
#pragma unroll
        for (int bj = 0; bj < 2; ++bj)
          *(uint4*)(dst + (size_t)(row0 + ai * 128 + m * 16) * ldd + col0 + bj * 128) = pack8(acc[ai][bj][m][0], acc[ai][bj][m][1]);
  }
};

struct EpiProjB {
  static constexpr bool PERM = true, AFTER_DRAIN = false;
  unsigned char* slab0; float* dab; u16* halo;
  DI void operator()(const f32x4 (&acc)[2][2][4][2], const pg8::Unit& u, int wr, int wc, int fr, int fq) const {
    const int row0 = u.pm * 256 + wr * 64 + fr;
    if (u.pn < 6) {
      u16* dst = (u16*)(slab0 + (size_t)(2 + (u.pn >> 1)) * SLABB);
      const int col0 = (u.pn & 1) * 256 + wc * 32 + fq * 8;
      const int hcol0 = u.pn * 256 + wc * 32 + fq * 8;
#pragma unroll
      for (int ai = 0; ai < 2; ++ai)
#pragma unroll
        for (int m = 0; m < 4; ++m)
#pragma unroll
          for (int bj = 0; bj < 2; ++bj) {
            const int row = row0 + ai * 128 + m * 16;
            const uint4 v = pack8(acc[ai][bj][m][0], acc[ai][bj][m][1]);
            *(uint4*)(dst + (size_t)row * 512 + col0 + bj * 128) = v;
            if (m == 0 && fr == 0) *(uint4*)(halo + ((size_t)(row >> 6) * 2 + 0) * 1536 + hcol0 + bj * 128) = v;
            if (m == 3 && fr == 15) *(uint4*)(halo + ((size_t)(row >> 6) * 2 + 1) * 1536 + hcol0 + bj * 128) = v;
          }
    } else {
      if (wc == 0 && fq < 2) {
#pragma unroll
        for (int ai = 0; ai < 2; ++ai)
#pragma unroll
          for (int m = 0; m < 4; ++m)
#pragma unroll
            for (int n = 0; n < 2; ++n)
              *(f32x4*)(dab + (size_t)(row0 + ai * 128 + m * 16) * 16 + 8 * fq + 4 * n) = acc[ai][0][m][n];
      }
    }
  }
};

struct EpiProjDG {
  static constexpr bool PERM = true, AFTER_DRAIN = false;
  u16* dst;
  DI void operator()(const f32x4 (&acc)[2][2][4][2], const pg8::Unit& u, int wr, int wc, int fr, int fq) const {
    const int row0 = u.pm * 256 + wr * 64 + fr, col0 = u.pn * 256 + wc * 32 + fq * 8;
#pragma unroll
    for (int ai = 0; ai < 2; ++ai)
#pragma unroll
      for (int m = 0; m < 4; ++m)
#pragma unroll
        for (int bj = 0; bj < 2; ++bj)
          *(uint4*)(dst + (size_t)(row0 + ai * 128 + m * 16) * 512 + col0 + bj * 128) = pack8(acc[ai][bj][m][0], acc[ai][bj][m][1]);
  }
};

DI f32x4 sig4(const f32x4& a) { return f32x4{sigmoid_f(a[0]), sigmoid_f(a[1]), sigmoid_f(a[2]), sigmoid_f(a[3])}; }

struct EpiMG {
  static constexpr bool PERM = true, AFTER_DRAIN = false;
  u16* G;
  DI void operator()(const f32x4 (&acc)[2][2][4][2], const pg8::Unit& u, int wr, int wc, int fr, int fq) const {
    const int row0 = u.pm * 256 + wr * 64 + fr, col0 = u.pn * 256 + wc * 32 + fq * 8;
#pragma unroll
    for (int ai = 0; ai < 2; ++ai)
#pragma unroll
      for (int m = 0; m < 4; ++m)
#pragma unroll
        for (int bj = 0; bj < 2; ++bj)
          *(uint4*)(G + (size_t)(row0 + ai * 128 + m * 16) * 3072 + col0 + bj * 128) = pack8(sig4(acc[ai][bj][m][0]), sig4(acc[ai][bj][m][1]));
  }
};

struct EpiBR {
  static constexpr bool PERM = true, AFTER_DRAIN = false;
  const u16* G; u16* mrg; int b;
  DI void operator()(const f32x4 (&acc)[2][2][4][2], const pg8::Unit& u, int wr, int wc, int fr, int fq) const {
    const int row0 = u.pm * 256 + wr * 64 + fr, col0 = u.pn * 256 + wc * 32 + fq * 8;
    uint4 g[2], pv[2];
    {
      const size_t row = (size_t)row0;
#pragma unroll
      for (int bj = 0; bj < 2; ++bj) {
        g[bj] = *(const uint4*)(G + row * 3072 + b * 1024 + col0 + bj * 128);
        pv[bj] = uint4{0, 0, 0, 0};
        if (b > 0) pv[bj] = *(const uint4*)(mrg + row * 1024 + col0 + bj * 128);
      }
    }
#pragma unroll
    for (int rr = 0; rr < 8; ++rr) {
      const int ai = rr >> 2, m = rr & 3;
      uint4 ng[2], npv[2];
      if (rr + 1 < 8) {
        const size_t row = (size_t)(row0 + ((rr + 1) >> 2) * 128 + ((rr + 1) & 3) * 16);
#pragma unroll
        for (int bj = 0; bj < 2; ++bj) {
          ng[bj] = *(const uint4*)(G + row * 3072 + b * 1024 + col0 + bj * 128);
          npv[bj] = uint4{0, 0, 0, 0};
          if (b > 0) npv[bj] = *(const uint4*)(mrg + row * 1024 + col0 + bj * 128);
        }
      }
      const size_t row = (size_t)(row0 + ai * 128 + m * 16);
#pragma unroll
      for (int bj = 0; bj < 2; ++bj) {
        const f32x4 a0 = acc[ai][bj][m][0], a1 = acc[ai][bj][m][1];
        uint4 o;
        o.x = cvtpk(bflo(pv[bj].x) + bflo(g[bj].x) * a0[0], bfhi(pv[bj].x) + bfhi(g[bj].x) * a0[1]);
        o.y = cvtpk(bflo(pv[bj].y) + bflo(g[bj].y) * a0[2], bfhi(pv[bj].y) + bfhi(g[bj].y) * a0[3]);
        o.z = cvtpk(bflo(pv[bj].z) + bflo(g[bj].z) * a1[0], bfhi(pv[bj].z) + bfhi(g[bj].z) * a1[1]);
        o.w = cvtpk(bflo(pv[bj].w) + bflo(g[bj].w) * a1[2], bfhi(pv[bj].w) + bfhi(g[bj].w) * a1[3]);
        *(uint4*)(mrg + row * 1024 + col0 + bj * 128) = o;
      }
      if (rr + 1 < 8) {
#pragma unroll
        for (int bj = 0; bj < 2; ++bj) { g[bj] = ng[bj]; pv[bj] = npv[bj]; }
      }
    }
  }
};

template <class Epi>
DI void run_gemm(u16* smem, const u16* A, const u16* Bt, int N, int K, const Epi& E, int tid, int bid) {
  pg8::Gemm g{A, Bt, TT, N, K};
  pg8::StaticOrder S;
  S.init(TT, N, (int)gridDim.x, bid);
  pg8::gemm_phase<Epi, pg8::StaticOrder, false>((lds_u8*)smem, g, S, E, nullptr, tid);
}

DI void phase_g1(const Params& p, int which, u16* smem, int tid, int bid) {
  EpiSwiglu E{ws_slab(p, 0)};
  run_gemm(smem, ws_h(p), ws_w(p) + (which ? W2IN : W1IN), 5632, 1024, E, tid, bid);
}
DI void phase_g2(const Params& p, int l, int which, bool first, u16* smem, int tid, int bid) {
  EpiResid E{p.k.in[0], p.k.in[1], p.out, ws_mods(p) + (size_t)(l * 9) * 9216 + (which ? 8 : 2) * 1024, 0.5f, first};
  run_gemm(smem, ws_slab(p, 0), ws_w(p) + (which ? W2OUT : W1OUT), 1024, DFF, E, tid, bid);
}
DI void phase_g3a(const Params& p, u16* smem, int tid, int bid) {
  EpiProjA E{p.ws + WS_SLAB};
  run_gemm(smem, ws_h(p), ws_w(p) + WIN, 2816, 1024, E, tid, bid);
}
DI void phase_g3b(const Params& p, u16* smem, int tid, int bid) {
  EpiProjB E{p.ws + WS_SLAB, (float*)(p.ws + WS_DAB), (u16*)(p.ws + WS_HALO)};
  run_gemm(smem, ws_h(p), ws_w(p) + WIN + (size_t)2816 * 1024, 1792, 1024, E, tid, bid);
}
DI void phase_g3c(const Params& p, u16* smem, int tid, int bid) {
  EpiProjDG E{ws_slab(p, 5)};
  run_gemm(smem, ws_h(p), ws_w(p) + WIN + (size_t)4608 * 1024, 512, 1024, E, tid, bid);
}
DI void phase_mg(const Params& p, u16* smem, int tid, int bid) {
  EpiMG E{ws_slab(p, 3)};
  run_gemm(smem, ws_h(p), ws_w(p) + WIN + (size_t)5120 * 1024, 3072, 1024, E, tid, bid);
}
DI void phase_br(const Params& p, int b, u16* smem, int tid, int bid) {
  EpiBR E{ws_slab(p, 3), ws_h(p), b};
  run_gemm(smem, ws_slab(p, b), ws_w(p) + WBR + (size_t)b * 524288, 1024, 512, E, tid, bid);
}
DI void phase_g5(const Params& p, int l, u16* smem, int tid, int bid) {
  EpiResid E{p.k.in[0], p.k.in[1], p.out, ws_mods(p) + (size_t)(l * 9) * 9216 + 5 * 1024, 1.0f, false};
  run_gemm(smem, ws_h(p), ws_w(p) + WOUT, 1024, 1024, E, tid, bid);
}

DI void phase_prep(const Params& p, int l, int tid, int bid, int nblk) {
  const int lane = tid & 63, hl = lane & 7;
  const int gw = bid * 8 + (tid >> 6), nw = nblk * 8;
  u16* AQ = ws_slab(p, 0); u16* RQ = ws_slab(p, 2); u16* RK = ws_slab(p, 3);
  const u16* KV = ws_slab(p, 6);
  u16* KC = ws_slab(p, 7);
  const float* ROPE = (const float*)(p.ws + WS_ROPE);
  float wq[8], wk[8];
#pragma unroll
  for (int e = 0; e < 8; ++e) { wq[e] = p.k.in[15][l * 64 + hl * 8 + e]; wk[e] = p.k.in[16][l * 64 + hl * 8 + e]; }
  const float sgn = (hl < 4) ? -1.f : 1.f;
  for (int t = gw; t < TT; t += nw) {
    const bool g2 = t >= TI;
    const int s = g2 ? 32 + ((t - TI) >> 12) : (t >> 8);
    const int tl = t - seq_base(s);
    const int S = g2 ? 4352 : 256;
    float cs[8], sn[8];
    if (g2) {
      const int i0 = (hl & 3) * 8;
      const int pos = (i0 < 16) ? (tl >> 6) : (tl & 63);
      const float* rp = ROPE + pos * 16 + (i0 & 15);
      float4 c0 = *(const float4*)rp, c1 = *(const float4*)(rp + 4), s0 = *(const float4*)(rp + 1024), s1 = *(const float4*)(rp + 1028);
      cs[0] = c0.x; cs[1] = c0.y; cs[2] = c0.z; cs[3] = c0.w; cs[4] = c1.x; cs[5] = c1.y; cs[6] = c1.z; cs[7] = c1.w;
      sn[0] = s0.x; sn[1] = s0.y; sn[2] = s0.z; sn[3] = s0.w; sn[4] = s1.x; sn[5] = s1.y; sn[6] = s1.z; sn[7] = s1.w;
    } else {
#pragma unroll
      for (int e = 0; e < 8; ++e) { cs[e] = 1.f; sn[e] = 0.f; }
    }
    const uint4 raw_aq = *(const uint4*)(AQ + (size_t)t * 512 + lane * 8);
    const uint4 raw_kv = (lane < 32) ? *(const uint4*)(KV + (size_t)t * 256 + lane * 8) : uint4{0, 0, 0, 0};
    const uint4 raw_rq = *(const uint4*)(RQ + (size_t)t * 512 + lane * 8);
    const uint4 raw_rk = g2 ? *(const uint4*)(RK + (size_t)t * 512 + lane * 8) : uint4{0, 0, 0, 0};
    {
      u16* pq = AQ + (size_t)t * 512 + lane * 8;
      uint4 raw = raw_aq;
      float x[8] = {bflo(raw.x), bfhi(raw.x), bflo(raw.y), bfhi(raw.y), bflo(raw.z), bfhi(raw.z), bflo(raw.w), bfhi(raw.w)};
      float ss = 0.f;
#pragma unroll
      for (int e = 0; e < 8; ++e) ss += x[e] * x[e];
      ss += __shfl_xor(ss, 1); ss += __shfl_xor(ss, 2); ss += __shfl_xor(ss, 4);
      const float rstd = rsqrtf(ss * (1.f / 64.f) + EPSF);
#pragma unroll
      for (int e = 0; e < 8; ++e) x[e] = x[e] * rstd * wq[e];
      if (g2) {
#pragma unroll
        for (int e = 0; e < 8; ++e) { float pr = __shfl_xor(x[e], 4); x[e] = x[e] * cs[e] + sgn * pr * sn[e]; }
      }
      *(uint4*)pq = uint4{cvtpk(x[0], x[1]), cvtpk(x[2], x[3]), cvtpk(x[4], x[5]), cvtpk(x[6], x[7])};
    }
    if (lane < 32) {
      const int kv = (lane >> 3) & 1;
      uint4 raw = raw_kv;
      float x[8] = {bflo(raw.x), bfhi(raw.x), bflo(raw.y), bfhi(raw.y), bflo(raw.z), bfhi(raw.z), bflo(raw.w), bfhi(raw.w)};
      if (lane < 16) {
        float ss = 0.f;
#pragma unroll
        for (int e = 0; e < 8; ++e) ss += x[e] * x[e];
        ss += __shfl_xor(ss, 1); ss += __shfl_xor(ss, 2); ss += __shfl_xor(ss, 4);
        const float rstd = rsqrtf(ss * (1.f / 64.f) + EPSF);
#pragma unroll
        for (int e = 0; e < 8; ++e) x[e] = x[e] * rstd * wk[e];
        if (!g2) {
          float* oc = p.out + OCK + ((((size_t)s * 2 + l) * 256 + tl) * 2 + kv) * 64 + hl * 8;
          *(float4*)oc = float4{x[0], x[1], x[2], x[3]};
          *(float4*)(oc + 4) = float4{x[4], x[5], x[6], x[7]};
        } else {
#pragma unroll
          for (int e = 0; e < 8; ++e) { float pr = __shfl_xor(x[e], 4); x[e] = x[e] * cs[e] + sgn * pr * sn[e]; }
        }
        *(uint4*)(KC + kv_base(s, kv) + (size_t)tl * 64 + hl * 8) = uint4{cvtpk(x[0], x[1]), cvtpk(x[2], x[3]), cvtpk(x[4], x[5]), cvtpk(x[6], x[7])};
      } else {
        if (!g2) {
          float* oc = p.out + OCV + ((((size_t)s * 2 + l) * 256 + tl) * 2 + kv) * 64 + hl * 8;
          *(float4*)oc = float4{x[0], x[1], x[2], x[3]};
          *(float4*)(oc + 4) = float4{x[4], x[5], x[6], x[7]};
        }
        u16* vt = KC + KC_VT_OFF + kv_base(s, kv) + (size_t)(hl * 8) * S + tl;
        unsigned ru[4] = {raw.x, raw.y, raw.z, raw.w};
#pragma unroll
        for (int e = 0; e < 4; ++e) { vt[(size_t)(2 * e) * S] = (u16)(ru[e] & 0xffffu); vt[(size_t)(2 * e + 1) * S] = (u16)(ru[e] >> 16); }
      }
    }
    {
      u16* pq = RQ + (size_t)t * 512 + lane * 8;
      uint4 raw = raw_rq;
      float x[8] = {bflo(raw.x), bfhi(raw.x), bflo(raw.y), bfhi(raw.y), bflo(raw.z), bfhi(raw.z), bflo(raw.w), bfhi(raw.w)};
      if (g2) {
#pragma unroll
        for (int e = 0; e < 8; ++e) { float pr = __shfl_xor(x[e], 4); x[e] = x[e] * cs[e] + sgn * pr * sn[e]; }
      }
      *(uint4*)pq = uint4{cvtpk(x[0] * 0.125f, x[1] * 0.125f), cvtpk(x[2] * 0.125f, x[3] * 0.125f), cvtpk(x[4] * 0.125f, x[5] * 0.125f), cvtpk(x[6] * 0.125f, x[7] * 0.125f)};
    }
    if (g2) {
      u16* pk = RK + (size_t)t * 512 + lane * 8;
      uint4 raw = raw_rk;
      float x[8] = {bflo(raw.x), bfhi(raw.x), bflo(raw.y), bfhi(raw.y), bflo(raw.z), bfhi(raw.z), bflo(raw.w), bfhi(raw.w)};
#pragma unroll
      for (int e = 0; e < 8; ++e) { float pr = __shfl_xor(x[e], 4); x[e] = x[e] * cs[e] + sgn * pr * sn[e]; }
      *(uint4*)pk = uint4{cvtpk(x[0], x[1]), cvtpk(x[2], x[3]), cvtpk(x[4], x[5]), cvtpk(x[6], x[7])};
    }
  }
  const int gt = bid * NTHREADS + tid, ngt = nblk * NTHREADS;
  for (int idx = gt; idx < 8 * 256 * 2 * 64; idx += ngt) {
    int d = idx & 63, kv = (idx >> 6) & 1, j = (idx >> 7) & 255, b = idx >> 15;
    size_t src = ((((size_t)b * 2 + l) * 256 + j) * 2 + kv) * 64 + d;
    KC[kv_base(32 + b, kv) + (size_t)(4096 + j) * 64 + d] = f2bf(p.k.in[2][src]);
    KC[KC_VT_OFF + kv_base(32 + b, kv) + (size_t)d * 4352 + 4096 + j] = f2bf(p.k.in[3][src]);
  }
}

DI void attn_qk(const u16* cK, const bf16x8 (&qf)[2][2], f32x4 (&st)[2][4], int r, int q) {
  zero_acc<2>(st);
#pragma unroll
  for (int ks = 0; ks < 2; ++ks)
#pragma unroll
    for (int t = 0; t < 4; ++t) {
      bf16x8 a = *(const bf16x8*)(cK + (t * 16 + r) * 72 + ks * 32 + q * 8);
#pragma unroll
      for (int m = 0; m < 2; ++m) st[m][t] = mfma16(a, qf[m][ks], st[m][t]);
    }
}

DI void attn_item(const Params& p, int s, int head, int qt, u16* smem, int tid) {
  const int lane = tid & 63, w = tid >> 6, r = lane & 15, q = lane >> 4;
  const int base = seq_base(s);
  const int S = s < 32 ? 256 : 4352;
  const int kvh = head >> 2;
  const u16* Kc = ws_slab(p, 7) + kv_base(s, kvh);
  const u16* Vt = ws_slab(p, 7) + KC_VT_OFF + kv_base(s, kvh);
  u16* Qb = ws_slab(p, 0);
  const int row0 = base + qt * 256 + w * 32;
  bf16x8 qf[2][2];
#pragma unroll
  for (int m = 0; m < 2; ++m)
#pragma unroll
    for (int ks = 0; ks < 2; ++ks) qf[m][ks] = *(const bf16x8*)(Qb + (size_t)(row0 + m * 16 + r) * 512 + head * 64 + ks * 32 + q * 8);
  f32x4 o[2][4];
  zero_acc<2>(o);
  float mx[2] = {-INFINITY, -INFINITY}, ls[2] = {0.f, 0.f};
  u16* sK = smem;
  u16* sV = smem + 2 * 64 * 72;
  const int nkt = S >> 6;
  const int lrow = tid >> 3, lseg = tid & 7;
  const float c = 0.125f * 1.4426950408889634f;
  const u16* kp = Kc + (size_t)lrow * 64 + lseg * 8;
  const u16* vp0 = Vt + (size_t)lrow * S + lseg * 8;
  const int lofs = lrow * 72 + lseg * 8;
  {
    uint4 k0 = *(const uint4*)kp, k1 = *(const uint4*)(kp + 4096), v0 = *(const uint4*)vp0;
    *(uint4*)(sK + lofs) = k0; *(uint4*)(sK + 4608 + lofs) = k1; *(uint4*)(sV + lofs) = v0;
  }
  uint4 rk = *(const uint4*)(kp + 2 * 4096);
  uint4 rv = *(const uint4*)(vp0 + 64);
  __syncthreads();
  f32x4 stn[2][4];
  attn_qk(sK, qf, stn, r, q);
  __syncthreads();
  for (int kt = 0; kt < nkt; ++kt) {
    if (kt + 2 < nkt) *(uint4*)(sK + (kt & 1) * 4608 + lofs) = rk;
    if (kt + 1 < nkt) *(uint4*)(sV + ((kt + 1) & 1) * 4608 + lofs) = rv;
    if (kt + 3 < nkt) rk = *(const uint4*)(kp + (size_t)(kt + 3) * 4096);
    if (kt + 2 < nkt) rv = *(const uint4*)(vp0 + (kt + 2) * 64);
    const u16* nK = sK + ((kt + 1) & 1) * 4608;
    const u16* cV = sV + (kt & 1) * 4608;
    f32x4 st[2][4];
#pragma unroll
    for (int m = 0; m < 2; ++m)
#pragma unroll
      for (int t = 0; t < 4; ++t) { st[m][t] = stn[m][t]; stn[m][t] = f32x4{0.f, 0.f, 0.f, 0.f}; }
#pragma unroll
    for (int ks = 0; ks < 2; ++ks) {
      bf16x8 kf[4];
#pragma unroll
      for (int t = 0; t < 4; ++t) kf[t] = *(const bf16x8*)(nK + (t * 16 + r) * 72 + ks * 32 + q * 8);
      __builtin_amdgcn_sched_barrier(0);
#pragma unroll
      for (int t = 0; t < 4; ++t)
#pragma unroll
        for (int m = 0; m < 2; ++m) stn[m][t] = mfma16(kf[t], qf[m][ks], stn[m][t]);
      __builtin_amdgcn_sched_barrier(0);
    }
#pragma unroll
    for (int m = 0; m < 2; ++m) {
      float rm = fmaxf(fmaxf(st[m][0][0], st[m][0][1]), fmaxf(st[m][0][2], st[m][0][3]));
#pragma unroll
      for (int t = 1; t < 4; ++t) { rm = fmaxf(fmaxf(rm, st[m][t][0]), st[m][t][1]); rm = fmaxf(fmaxf(rm, st[m][t][2]), st[m][t][3]); }
      rm = fmaxf(rm, __shfl_xor(rm, 16));
      rm = fmaxf(rm, __shfl_xor(rm, 32));
      const float mnew = fmaxf(mx[m], rm);
      const float alpha = __builtin_amdgcn_exp2f((mx[m] - mnew) * c);
      mx[m] = mnew;
      const f32x2_t c2 = {c, c}, mc2 = {mnew * c, mnew * c};
      f32x2_t ps2 = {0.f, 0.f};
#pragma unroll
      for (int t = 0; t < 4; ++t)
#pragma unroll
        for (int jp = 0; jp < 2; ++jp) {
          f32x2_t v = {st[m][t][2 * jp], st[m][t][2 * jp + 1]};
          v = v * c2 - mc2;
          v.x = __builtin_amdgcn_exp2f(v.x); v.y = __builtin_amdgcn_exp2f(v.y);
          ps2 += v;
          st[m][t][2 * jp] = v.x; st[m][t][2 * jp + 1] = v.y;
        }
      ls[m] = ls[m] * alpha + ps2.x + ps2.y;
#pragma unroll
      for (int dt = 0; dt < 4; ++dt) o[m][dt] = o[m][dt] * alpha;
    }
#pragma unroll
    for (int kb = 0; kb < 2; ++kb) {
      bf16x8 vf[4];
#pragma unroll
      for (int dt = 0; dt < 4; ++dt) {
        const u16* vp = cV + (dt * 16 + r) * 72 + kb * 32 + 4 * q;
        uint2 lo = *(const uint2*)vp, hi = *(const uint2*)(vp + 16);
        vf[dt] = __builtin_bit_cast(bf16x8, uint4{lo.x, lo.y, hi.x, hi.y});
      }
      bf16x8 pb[2];
#pragma unroll
      for (int m = 0; m < 2; ++m) {
        uint4 u = uint4{cvtpk(st[m][2 * kb][0], st[m][2 * kb][1]), cvtpk(st[m][2 * kb][2], st[m][2 * kb][3]),
                        cvtpk(st[m][2 * kb + 1][0], st[m][2 * kb + 1][1]), cvtpk(st[m][2 * kb + 1][2], st[m][2 * kb + 1][3])};
        pb[m] = __builtin_bit_cast(bf16x8, u);
      }
      __builtin_amdgcn_sched_barrier(0);
#pragma unroll
      for (int dt = 0; dt < 4; ++dt)
#pragma unroll
        for (int m = 0; m < 2; ++m) o[m][dt] = mfma16(vf[dt], pb[m], o[m][dt]);
      __builtin_amdgcn_sched_barrier(0);
    }
    __syncthreads();
  }
#pragma unroll
  for (int m = 0; m < 2; ++m) {
    float l = ls[m];
    l += __shfl_xor(l, 16);
    l += __shfl_xor(l, 32);
    const float inv = 1.f / l;
#pragma unroll
    for (int dt = 0; dt < 4; ++dt)
      *(uint2*)(Qb + (size_t)(row0 + m * 16 + r) * 512 + head * 64 + dt * 16 + 4 * q) =
          uint2{cvtpk(o[m][dt][0] * inv, o[m][dt][1] * inv), cvtpk(o[m][dt][2] * inv, o[m][dt][3] * inv)};
  }
}

DI void ret_stage(u16* Qs, u16* Ks, u16* Kdt, u16* Vt, int row, int seg, const uint4& qv, const uint4& kv, const uint4& vv, float kdec) {
  *(uint4*)(Qs + row * 72 + seg * 8) = qv;
  *(uint4*)(Ks + row * 72 + seg * 8) = kv;
  u16* kd = Kdt + (seg * 8) * 72 + row;
  u16* vt = Vt + (seg * 8) * 72 + row;
  kd[0 * 72] = f2bf(bflo(kv.x) * kdec); kd[1 * 72] = f2bf(bfhi(kv.x) * kdec);
  kd[2 * 72] = f2bf(bflo(kv.y) * kdec); kd[3 * 72] = f2bf(bfhi(kv.y) * kdec);
  kd[4 * 72] = f2bf(bflo(kv.z) * kdec); kd[5 * 72] = f2bf(bfhi(kv.z) * kdec);
  kd[6 * 72] = f2bf(bflo(kv.w) * kdec); kd[7 * 72] = f2bf(bfhi(kv.w) * kdec);
  vt[0 * 72] = (u16)(vv.x & 0xffffu); vt[1 * 72] = (u16)(vv.x >> 16);
  vt[2 * 72] = (u16)(vv.y & 0xffffu); vt[3 * 72] = (u16)(vv.y >> 16);
  vt[4 * 72] = (u16)(vv.z & 0xffffu); vt[5 * 72] = (u16)(vv.z >> 16);
  vt[6 * 72] = (u16)(vv.w & 0xffffu); vt[7 * 72] = (u16)(vv.w >> 16);
}

DI void ret_rowwise(const float* Os, u16* RO, int t, int h, int ct, bool fin, const uint4& f0, const uint4& f1, const uint4& f2, const uint4& f3, const float (&rw)[16]) {
  const int row = ct >> 2, c4 = ct & 3;
  float x[16];
#pragma unroll
  for (int e4 = 0; e4 < 4; ++e4) {
    float4 v = *(const float4*)(Os + row * 68 + c4 * 16 + e4 * 4);
    x[e4 * 4] = v.x; x[e4 * 4 + 1] = v.y; x[e4 * 4 + 2] = v.z; x[e4 * 4 + 3] = v.w;
  }
  u16* po = RO + (size_t)t * 512 + h * 64 + c4 * 16;
  if (fin) {
    const unsigned pu[8] = {f0.x, f0.y, f0.z, f0.w, f1.x, f1.y, f1.z, f1.w};
    const unsigned gu[8] = {f2.x, f2.y, f2.z, f2.w, f3.x, f3.y, f3.z, f3.w};
    float s1 = 0.f;
#pragma unroll
    for (int e = 0; e < 8; ++e) { x[2 * e] += bflo(pu[e]); x[2 * e + 1] += bfhi(pu[e]); s1 += x[2 * e] + x[2 * e + 1]; }
    s1 += __shfl_xor(s1, 1); s1 += __shfl_xor(s1, 2);
    const float mu = s1 * (1.f / 64.f);
    float s2 = 0.f;
#pragma unroll
    for (int e = 0; e < 16; ++e) { float d = x[e] - mu; s2 += d * d; }
    s2 += __shfl_xor(s2, 1); s2 += __shfl_xor(s2, 2);
    const float rs = rsqrtf(s2 * (1.f / 64.f) + EPSF);
#pragma unroll
    for (int e = 0; e < 8; ++e) {
      x[2 * e] = (x[2 * e] - mu) * rs * rw[2 * e] * silu_f(bflo(gu[e]));
      x[2 * e + 1] = (x[2 * e + 1] - mu) * rs * rw[2 * e + 1] * silu_f(bfhi(gu[e]));
    }
  }
  *(uint4*)po = uint4{cvtpk(x[0], x[1]), cvtpk(x[2], x[3]), cvtpk(x[4], x[5]), cvtpk(x[6], x[7])};
  *(uint4*)(po + 8) = uint4{cvtpk(x[8], x[9]), cvtpk(x[10], x[11]), cvtpk(x[12], x[13]), cvtpk(x[14], x[15])};
}

DI void ret_item(const Params& p, int l, int s, int h, u16* smem, int tid) {
  const int lane = tid & 63, r = lane & 15, q = lane >> 4;
  const int dir = tid >> 8, ct = tid & 255, wv = (tid >> 6) & 3;
  const int base = seq_base(s), len = seq_len(s), N = len >> 6;
  const bool g2 = s >= 32;
  const float lg = log1pf(-exp2f(-(dir ? 5.5f : 5.0f) - (float)h));
  u16* cs = smem + dir * 36352;
  u16* Qs = cs; u16* Ks = cs + 4608; u16* Vt = cs + 2 * 4608; u16* Kdt = cs + 3 * 4608; u16* Ps = cs + 4 * 4608; u16* St = cs + 5 * 4608;
  float* Os = (float*)(cs + 6 * 4608);
  const u16* RQ = ws_slab(p, 2); const u16* RK = ws_slab(p, 3); const u16* RV = ws_slab(p, 4); const u16* RG = ws_slab(p, 5);
  u16* RO = ws_slab(p, 1);
  f32x4 accS[4];
#pragma unroll
  for (int n = 0; n < 4; ++n)
#pragma unroll
    for (int j = 0; j < 4; ++j) {
      float v0 = 0.f;
      if (g2) v0 = p.k.in[4][(((((size_t)(s - 32) * 2 + l) * 2 + dir) * 8 + h) * 64 + (n * 16 + r)) * 64 + (wv * 16 + q * 4 + j)];
      accS[n][j] = v0;
      St[(wv * 16 + q * 4 + j) * 72 + n * 16 + r] = f2bf(v0);
    }
  const float cdec = __expf(lg * 64.f);
  float rw[16];
  {
    const float* rnw = p.k.in[17] + l * 512 + h * 64 + (ct & 3) * 16;
#pragma unroll
    for (int e = 0; e < 16; ++e) rw[e] = rnw[e];
  }
  float rowf[4], colf[4], qdf[4];
#pragma unroll
  for (int j = 0; j < 4; ++j) {
    rowf[j] = __expf(lg * (float)(wv * 16 + q * 4 + j)); colf[j] = __expf(-lg * (float)(j * 16 + r));
    qdf[j] = __expf(lg * (float)(wv * 16 + q * 4 + j + 1));
  }
  uint4 pq0, pq1, pk0, pk1, pv0, pv1;
  {
    const int t = base + (dir ? len - 1 - lane : lane);
    const size_t off0 = (size_t)t * 512 + h * 64 + wv * 8, off1 = off0 + 32;
    pq0 = *(const uint4*)(RQ + off0); pk0 = *(const uint4*)(RK + off0); pv0 = *(const uint4*)(RV + off0);
    pq1 = *(const uint4*)(RQ + off1); pk1 = *(const uint4*)(RK + off1); pv1 = *(const uint4*)(RV + off1);
  }
  const float kdec = __expf(lg * (float)(63 - lane));
  uint4 f0 = uint4{0, 0, 0, 0}, f1 = f0, f2 = f0, f3 = f0;
  const int erow = ct >> 2;
  for (int n = 0; n < N; ++n) {
    if (n > 0) {
      const int pp = (n - 1) * 64 + erow;
      ret_rowwise(Os, RO, base + (dir ? len - 1 - pp : pp), h, ct, (n - 1) >= (N >> 1), f0, f1, f2, f3, rw);
    }
    ret_stage(Qs, Ks, Kdt, Vt, lane, wv, pq0, pk0, pv0, kdec);
    ret_stage(Qs, Ks, Kdt, Vt, lane, wv + 4, pq1, pk1, pv1, kdec);
    if (n + 1 < N) {
      const int pp = (n + 1) * 64 + lane;
      const int t = base + (dir ? len - 1 - pp : pp);
      const size_t off0 = (size_t)t * 512 + h * 64 + wv * 8, off1 = off0 + 32;
      pq0 = *(const uint4*)(RQ + off0); pk0 = *(const uint4*)(RK + off0); pv0 = *(const uint4*)(RV + off0);
      pq1 = *(const uint4*)(RQ + off1); pk1 = *(const uint4*)(RK + off1); pv1 = *(const uint4*)(RV + off1);
    }
    if (n == (N >> 1)) __syncthreads(); else lds_barrier();
    if (n >= (N >> 1)) {
      const int pp = n * 64 + erow;
      const int t = base + (dir ? len - 1 - pp : pp);
      const size_t off = (size_t)t * 512 + h * 64 + (ct & 3) * 16;
      f0 = *(const uint4*)(RO + off); f1 = *(const uint4*)(RO + off + 8);
      f2 = *(const uint4*)(RG + off); f3 = *(const uint4*)(RG + off + 8);
    }
    f32x4 sa[4];
#pragma unroll
    for (int nn = 0; nn < 4; ++nn) sa[nn] = f32x4{0.f, 0.f, 0.f, 0.f};
    wave_mma<4, 2>(Qs, 72, wv * 16, Ks, 72, 0, sa, lane);
#pragma unroll
    for (int nn = 0; nn < 4; ++nn)
#pragma unroll
      for (int j = 0; j < 4; ++j) {
        int i = wv * 16 + q * 4 + j, jj = nn * 16 + r;
        float pv = (i >= jj) ? sa[nn][j] * (rowf[j] * colf[nn]) : 0.f;
        Ps[i * 72 + jj] = f2bf(pv);
      }
    f32x4 a1[4], a2[4];
#pragma unroll
    for (int nn = 0; nn < 4; ++nn) { a1[nn] = f32x4{0.f, 0.f, 0.f, 0.f}; a2[nn] = f32x4{0.f, 0.f, 0.f, 0.f}; }
    wave_mma<4, 2>(Ps, 72, wv * 16, Vt, 72, 0, a1, lane);
    wave_mma<4, 2>(Qs, 72, wv * 16, St, 72, 0, a2, lane);
#pragma unroll
    for (int j = 0; j < 4; ++j)
#pragma unroll
      for (int nn = 0; nn < 4; ++nn) Os[(wv * 16 + q * 4 + j) * 68 + nn * 16 + r] = a1[nn][j] + qdf[j] * a2[nn][j];
#pragma unroll
    for (int nn = 0; nn < 4; ++nn)
#pragma unroll
      for (int j = 0; j < 4; ++j) accS[nn][j] *= cdec;
    wave_mma<4, 2>(Vt, 72, wv * 16, Kdt, 72, 0, accS, lane);
    lds_barrier();
#pragma unroll
    for (int nn = 0; nn < 4; ++nn)
#pragma unroll
      for (int j = 0; j < 4; ++j) St[(wv * 16 + q * 4 + j) * 72 + nn * 16 + r] = f2bf(accS[nn][j]);
  }
  {
    const int pp = (N - 1) * 64 + erow;
    ret_rowwise(Os, RO, base + (dir ? len - 1 - pp : pp), h, ct, true, f0, f1, f2, f3, rw);
  }
  if (!g2) {
#pragma unroll
    for (int nn = 0; nn < 4; ++nn)
#pragma unroll
      for (int j = 0; j < 4; ++j)
        p.out[OSR + (((((size_t)s * 2 + l) * 2 + dir) * 8 + h) * 64 + (nn * 16 + r)) * 64 + (wv * 16 + q * 4 + j)] = accS[nn][j];
  }
  __syncthreads();
}

constexpr int ATT_X1 = 320;
DI void phase_mix1(const Params& p, int l, u16* smem, int* s_item, int tid) {
  int* ctr = (int*)(p.ws + WS_CTR) + l * 4;
  while (true) {
    if (tid == 0) *s_item = atomicAdd(ctr, 1);
    __syncthreads();
    const int it = *s_item;
    __syncthreads();
    if (it >= 64 + ATT_X1 + 512) break;
    int kind, s, h, qt = 0;
    if (it < 64) { kind = 0; s = 32 + (it >> 3); h = it & 7; }
    else if (it < 64 + ATT_X1) { int a = it - 64; kind = 1; s = 32 + (a >> 7); h = (a >> 4) & 7; qt = a & 15; }
    else if (it < 64 + ATT_X1 + 256) { int a = it - 64 - ATT_X1; kind = 0; s = a >> 3; h = a & 7; }
    else { int a = it - 64 - ATT_X1 - 256; kind = 1; s = a >> 3; h = a & 7; }
#ifdef PROBE_MAX
    unsigned long long tb_ = wall_clock64();
#endif
    if (kind == 0) ret_item(p, l, s, h, smem, tid);
    else attn_item(p, s, h, qt, smem, tid);
#ifdef PROBE_MAX
    if (tid == 0 && kind == (PROBE_MAX)) atomicMax((int*)(p.ws + WS_CTR) + 32 + l, (int)(wall_clock64() - tb_));
#endif
  }
}

DI void dn_pre_item(const Params& p, int l, int cgk, int h, u16* smem, int tid) {
  const int lane = tid & 63, w = tid >> 6, r = lane & 15, q = lane >> 4;
  u16* Ks = smem;
  float* sKK = (float*)(smem + 64 * 136);
  float* sA = sKK + 64 * 65;
  float* sX = sA + 2 * 4096;
  float* sg = sX + 2 * 64 * 68;
  float* sb = sg + 128;
  float* sG = sb + 128;
  const int t0 = cgk * 64;
  const int s = t0 < TI ? (t0 >> 8) : 32 + ((t0 - TI) >> 12);
  const int base = seq_base(s), len = seq_len(s);
  const u16* HALO = (const u16*)(p.ws + WS_HALO);
  float pre_da = 0.f, pre_db = 0.f;
  if (tid < 128) {
    const int dir_ = tid >> 6, i_ = tid & 63;
    const int t_ = t0 + (dir_ ? 63 - i_ : i_);
    const float* DAB_ = (const float*)(p.ws + WS_DAB);
    pre_da = DAB_[(size_t)t_ * 16 + dir_ * 4 + h]; pre_db = DAB_[(size_t)t_ * 16 + 8 + dir_ * 4 + h];
  }
  {
    const int rr = tid >> 3, cseg = tid & 7;
    const int t = t0 + rr;
    const int col0 = h * 128 + cseg * 16;
    unsigned res[3][8];
#pragma unroll
    for (int xi = 0; xi < 3; ++xi) {
      const u16* X = ws_slab(p, 2 + xi);
      uint4 c0 = *(const uint4*)(X + (size_t)t * 512 + col0), c1 = *(const uint4*)(X + (size_t)t * 512 + col0 + 8);
      uint4 p0 = uint4{0, 0, 0, 0}, p1 = p0, n0 = p0, n1 = p0;
      if (t > base) {
        const u16* src = (rr > 0) ? X + (size_t)(t - 1) * 512 + col0 : HALO + ((size_t)(cgk - 1) * 2 + 1) * 1536 + xi * 512 + col0;
        p0 = *(const uint4*)src; p1 = *(const uint4*)(src + 8);
      }
      if (t + 1 < base + len) {
        const u16* src = (rr < 63) ? X + (size_t)(t + 1) * 512 + col0 : HALO + ((size_t)(cgk + 1) * 2 + 0) * 1536 + xi * 512 + col0;
        n0 = *(const uint4*)src; n1 = *(const uint4*)(src + 8);
      }
      const float* cw = p.k.in[18] + (size_t)l * 3 * 1536 + xi * 512 + col0;
      unsigned cu[8] = {c0.x, c0.y, c0.z, c0.w, c1.x, c1.y, c1.z, c1.w};
      unsigned pu[8] = {p0.x, p0.y, p0.z, p0.w, p1.x, p1.y, p1.z, p1.w};
      unsigned nu[8] = {n0.x, n0.y, n0.z, n0.w, n1.x, n1.y, n1.z, n1.w};
      float y[16];
      float ss = 0.f;
#pragma unroll
      for (int e = 0; e < 8; ++e) {
        float a0 = cw[2 * e] * bflo(pu[e]) + cw[1536 + 2 * e] * bflo(cu[e]) + cw[3072 + 2 * e] * bflo(nu[e]);
        float a1 = cw[2 * e + 1] * bfhi(pu[e]) + cw[1536 + 2 * e + 1] * bfhi(cu[e]) + cw[3072 + 2 * e + 1] * bfhi(nu[e]);
        a0 = silu_f(a0); a1 = silu_f(a1);
        y[2 * e] = a0; y[2 * e + 1] = a1;
        ss += a0 * a0 + a1 * a1;
      }
      if (xi < 2) {
        ss += __shfl_xor(ss, 1); ss += __shfl_xor(ss, 2); ss += __shfl_xor(ss, 4);
        float rn = rsqrtf(ss + EPSF) * (xi == 0 ? 0.08838834764831845f : 1.f);
#pragma unroll
        for (int e = 0; e < 16; ++e) y[e] *= rn;
      }
#pragma unroll
      for (int e = 0; e < 8; ++e) res[xi][e] = cvtpk(y[2 * e], y[2 * e + 1]);
    }
    *(uint4*)(Ks + rr * 136 + cseg * 16) = uint4{res[1][0], res[1][1], res[1][2], res[1][3]};
    *(uint4*)(Ks + rr * 136 + cseg * 16 + 8) = uint4{res[1][4], res[1][5], res[1][6], res[1][7]};
    __syncthreads();
#pragma unroll
    for (int xi = 0; xi < 3; ++xi) {
      u16* X = ws_slab(p, 2 + xi);
      *(uint4*)(X + (size_t)t * 512 + col0) = uint4{res[xi][0], res[xi][1], res[xi][2], res[xi][3]};
      *(uint4*)(X + (size_t)t * 512 + col0 + 8) = uint4{res[xi][4], res[xi][5], res[xi][6], res[xi][7]};
    }
  }
  const float* DAB = (const float*)(p.ws + WS_DAB);
  float* GBG = (float*)(p.ws + WS_GBG);
  float* GBB = (float*)(p.ws + WS_GBB);
  if (tid < 128) {
    int dir = tid >> 6, i = tid & 63;
    int t = t0 + (dir ? 63 - i : i);
    float da = pre_da, db = pre_db;
    float x = da + p.k.in[20][l * 8 + dir * 4 + h];
    float sp = (x > 20.f) ? x : log1pf(expf(x));
    sg[tid] = -expf(p.k.in[19][l * 8 + dir * 4 + h]) * sp;
    sb[tid] = 1.f / (1.f + expf(-db));
  }
  lds_barrier();
  if (tid < 128) {
    float x = sg[tid];
#pragma unroll
    for (int o = 1; o < 64; o <<= 1) { float y = __shfl_up(x, o); if ((tid & 63) >= o) x += y; }
    sG[tid] = x;
  }
  {
    f32x4 kk[2];
    kk[0] = f32x4{0.f, 0.f, 0.f, 0.f}; kk[1] = kk[0];
    wave_mma<2, 4>(Ks, 136, (w >> 1) * 16, Ks, 136, (w & 1) * 32, kk, lane);
#pragma unroll
    for (int nn = 0; nn < 2; ++nn)
#pragma unroll
      for (int j = 0; j < 4; ++j) sKK[((w >> 1) * 16 + q * 4 + j) * 65 + (w & 1) * 32 + nn * 16 + r] = kk[nn][j];
  }
  lds_barrier();
  if (tid < 128) {
    int dir = tid >> 6, i = tid & 63;
    int t = t0 + (dir ? 63 - i : i);
    GBG[(size_t)t * 8 + dir * 4 + h] = sG[tid];
    GBB[(size_t)t * 8 + dir * 4 + h] = sb[tid];
  }
  for (int idx = tid; idx < 2 * 4096; idx += NTHREADS) {
    int dir = idx >> 12, i = (idx >> 6) & 63, j = idx & 63;
    int ri = dir ? 63 - i : i, rj = dir ? 63 - j : j;
    float a = 0.f;
    if (i > j) a = sb[dir * 64 + i] * sKK[ri * 65 + rj] * __expf(sG[dir * 64 + i] - sG[dir * 64 + j]);
    sA[idx] = a;
  }
  lds_barrier();
  {
    const int dir = tid >> 8, c = (tid >> 2) & 63, sl = tid & 3;
    const float* ar = sA + dir * 4096 + sl * 16;
    float x[16];
#pragma unroll
    for (int jj = 0; jj < 16; ++jj) x[jj] = (sl * 16 + jj == c) ? 1.f : 0.f;
    float4 an[4];
#pragma unroll
    for (int k = 0; k < 4; ++k) an[k] = *(const float4*)(ar + 64 + 4 * k);
    int ro = 64;
#pragma unroll
    for (int i = 1; i < 64; ++i) {
      float4 a4[4];
#pragma unroll
      for (int k = 0; k < 4; ++k) a4[k] = an[k];
      if (i + 1 < 64) {
        ro += 64;
        asm volatile("" : "+v"(ro));
#pragma unroll
        for (int k = 0; k < 4; ++k) an[k] = *(const float4*)(ar + ro + 4 * k);
      }
      __builtin_amdgcn_sched_barrier(0);
      float s0 = 0.f, s1 = 0.f;
#pragma unroll
      for (int k = 0; k < 4; ++k) {
        s0 += a4[k].x * x[4 * k] + a4[k].z * x[4 * k + 2];
        s1 += a4[k].y * x[4 * k + 1] + a4[k].w * x[4 * k + 3];
      }
      float tot = s0 + s1;
      tot += __builtin_bit_cast(float, __builtin_amdgcn_update_dpp(0, __builtin_bit_cast(int, tot), 0xB1, 0xF, 0xF, false));
      tot += __builtin_bit_cast(float, __builtin_amdgcn_update_dpp(0, __builtin_bit_cast(int, tot), 0x4E, 0xF, 0xF, false));
      x[i & 15] = (sl == (i >> 4)) ? x[i & 15] - tot : x[i & 15];
      __builtin_amdgcn_sched_barrier(0);
    }
    u16* TM = ws_slab(p, 5) + (((size_t)cgk * 4 + h) * 2 + dir) * 4096 + (size_t)(sl * 16) * 64 + c;
#pragma unroll
    for (int jj = 0; jj < 16; ++jj) TM[jj * 64] = f2bf(x[jj]);
  }
  lds_barrier();
}

DI void phase_dn_pre(const Params& p, int l, u16* smem, int tid, int bid, int nblk) {
  for (int it = bid; it < 640 * 4; it += nblk) dn_pre_item(p, l, it >> 2, it & 3, smem, tid);
}

DI void dn_scan_item(const Params& p, int l, int s, int h, int dir, u16* smem, int tid) {
  const int lane = tid & 63, w = tid >> 6, r = lane & 15, q = lane >> 4;
  u16* Qs = smem;
  u16* Ks = Qs + 8704;
  u16* Kdt = Ks + 8704;
  u16* Rt = Kdt + 9216;
  u16* Vnt = Rt + 9216;
  u16* St = Vnt + 9216;
  u16* Tms = St + 17408;
  u16* Atm = Tms + 4608;
  float* sG = (float*)(Atm + 4608);
  float* sB = sG + 64;
  float* sEG = sB + 64;
  u16* Os = (u16*)(sEG + 64);
  const int base = seq_base(s), len = seq_len(s), N = len >> 6;
  const bool g2 = s >= 32;
  const u16* DQ = ws_slab(p, 2); const u16* DK = ws_slab(p, 3); const u16* DV = ws_slab(p, 4);
  const u16* TM = ws_slab(p, 5);
  u16* OUT = ws_slab(p, dir ? 8 : 6);
  const float* GBG = (const float*)(p.ws + WS_GBG);
  const float* GBB = (const float*)(p.ws + WS_GBB);
  const int mP = w >> 1, nP0 = (w & 1) * 4;
  f32x4 ST[8];
#pragma unroll
  for (int n = 0; n < 8; ++n)
#pragma unroll
    for (int j = 0; j < 4; ++j) {
      float v0 = 0.f;
      if (g2) v0 = p.k.in[5][(((((size_t)(s - 32) * 2 + l) * 2 + dir) * 4 + h) * 128 + (n * 16 + r)) * 128 + (w * 16 + q * 4 + j)];
      ST[n][j] = v0;
      St[(w * 16 + q * 4 + j) * 136 + n * 16 + r] = f2bf(v0);
    }
  uint4 pq0, pq1, pk0, pk1, pv0, pv1, ptm;
  float pgrow, pglast, pbeta;
  {
    const int cg0 = (base >> 6) + (dir ? N - 1 : 0);
    const int t = base + (dir ? len - 1 - lane : lane);
    const int tlast = base + (dir ? len - 1 - 63 : 63);
    const size_t off = (size_t)t * 512 + h * 128 + w * 16;
    pq0 = *(const uint4*)(DQ + off); pq1 = *(const uint4*)(DQ + off + 8);
    pk0 = *(const uint4*)(DK + off); pk1 = *(const uint4*)(DK + off + 8);
    pv0 = *(const uint4*)(DV + off); pv1 = *(const uint4*)(DV + off + 8);
    ptm = *(const uint4*)(TM + (((size_t)cg0 * 4 + h) * 2 + dir) * 4096 + lane * 64 + w * 8);
    pgrow = GBG[(size_t)t * 8 + dir * 4 + h]; pglast = GBG[(size_t)tlast * 8 + dir * 4 + h]; pbeta = GBB[(size_t)t * 8 + dir * 4 + h];
  }
  const int orow = tid >> 3, oseg = tid & 7;
  for (int n = 0; n < N; ++n) {
    if (n > 0) {
      const int pp = (n - 1) * 64 + orow;
      const int t = base + (dir ? len - 1 - pp : pp);
      const uint4 o0 = *(const uint4*)(Os + orow * 136 + oseg * 16), o1 = *(const uint4*)(Os + orow * 136 + oseg * 16 + 8);
      *(uint4*)(OUT + (size_t)t * 512 + h * 128 + oseg * 16) = o0;
      *(uint4*)(OUT + (size_t)t * 512 + h * 128 + oseg * 16 + 8) = o1;
    }
    {
      const int row = lane, seg = w;
      *(uint4*)(Qs + row * 136 + seg * 16) = pq0; *(uint4*)(Qs + row * 136 + seg * 16 + 8) = pq1;
      *(uint4*)(Ks + row * 136 + seg * 16) = pk0; *(uint4*)(Ks + row * 136 + seg * 16 + 8) = pk1;
      const float kd = __expf(pglast - pgrow);
      unsigned ku[8] = {pk0.x, pk0.y, pk0.z, pk0.w, pk1.x, pk1.y, pk1.z, pk1.w};
      unsigned vu[8] = {pv0.x, pv0.y, pv0.z, pv0.w, pv1.x, pv1.y, pv1.z, pv1.w};
#pragma unroll
      for (int e = 0; e < 8; ++e) {
        Kdt[(seg * 16 + 2 * e) * 72 + row] = f2bf(bflo(ku[e]) * kd);
        Kdt[(seg * 16 + 2 * e + 1) * 72 + row] = f2bf(bfhi(ku[e]) * kd);
        Rt[(seg * 16 + 2 * e) * 72 + row] = (u16)(vu[e] & 0xffffu);
        Rt[(seg * 16 + 2 * e + 1) * 72 + row] = (u16)(vu[e] >> 16);
      }
      *(uint4*)(Tms + row * 72 + seg * 8) = ptm;
      if (w == 0) { sG[lane] = pgrow; sEG[lane] = __expf(pgrow); sB[lane] = pbeta; }
      if (n + 1 < N) {
        const int cgn = (base >> 6) + (dir ? N - 2 - n : n + 1);
        const int pp = (n + 1) * 64 + lane;
        const int t = base + (dir ? len - 1 - pp : pp);
        const int tlast = base + (dir ? len - 1 - ((n + 1) * 64 + 63) : (n + 1) * 64 + 63);
        const size_t off = (size_t)t * 512 + h * 128 + w * 16;
        pq0 = *(const uint4*)(DQ + off); pq1 = *(const uint4*)(DQ + off + 8);
        pk0 = *(const uint4*)(DK + off); pk1 = *(const uint4*)(DK + off + 8);
        pv0 = *(const uint4*)(DV + off); pv1 = *(const uint4*)(DV + off + 8);
        ptm = *(const uint4*)(TM + (((size_t)cgn * 4 + h) * 2 + dir) * 4096 + lane * 64 + w * 8);
        pgrow = GBG[(size_t)t * 8 + dir * 4 + h]; pglast = GBG[(size_t)tlast * 8 + dir * 4 + h]; pbeta = GBB[(size_t)t * 8 + dir * 4 + h];
      }
    }
    lds_barrier();
    f32x4 p1[4], qs[4], at[2];
#pragma unroll
    for (int nn = 0; nn < 4; ++nn) { p1[nn] = f32x4{0.f, 0.f, 0.f, 0.f}; qs[nn] = p1[nn]; }
    at[0] = f32x4{0.f, 0.f, 0.f, 0.f}; at[1] = at[0];
    wave_mma<4, 4>(Ks, 136, mP * 16, St, 136, nP0 * 16, p1, lane);
    wave_mma<4, 4>(Qs, 136, mP * 16, St, 136, nP0 * 16, qs, lane);
    wave_mma<2, 4>(Qs, 136, mP * 16, Ks, 136, (w & 1) * 32, at, lane);
    const int i0 = mP * 16 + q * 4;
    float bi[4], egi[4], gi[4];
#pragma unroll
    for (int j = 0; j < 4; ++j) { bi[j] = sB[i0 + j]; egi[j] = sEG[i0 + j]; gi[j] = sG[i0 + j]; }
#pragma unroll
    for (int nn = 0; nn < 4; ++nn) {
      const int v = (nP0 + nn) * 16 + r;
      uint2 raw = *(const uint2*)(Rt + v * 72 + i0);
      float f0 = bi[0] * (bflo(raw.x) - egi[0] * p1[nn][0]);
      float f1 = bi[1] * (bfhi(raw.x) - egi[1] * p1[nn][1]);
      float f2 = bi[2] * (bflo(raw.y) - egi[2] * p1[nn][2]);
      float f3 = bi[3] * (bfhi(raw.y) - egi[3] * p1[nn][3]);
      *(uint2*)(Rt + v * 72 + i0) = uint2{cvtpk(f0, f1), cvtpk(f2, f3)};
    }
#pragma unroll
    for (int nn = 0; nn < 2; ++nn) {
      const int jj = (w & 1) * 32 + nn * 16 + r;
      const float gj = sG[jj];
#pragma unroll
      for (int j = 0; j < 4; ++j) {
        int i = i0 + j;
        float val = (i >= jj) ? at[nn][j] * __expf(gi[j] - gj) : 0.f;
        Atm[i * 72 + jj] = f2bf(val);
      }
    }
    lds_barrier();
    f32x4 vn[4];
#pragma unroll
    for (int nn = 0; nn < 4; ++nn) vn[nn] = f32x4{0.f, 0.f, 0.f, 0.f};
    wave_mma<4, 2>(Tms, 72, mP * 16, Rt, 72, nP0 * 16, vn, lane);
#pragma unroll
    for (int nn = 0; nn < 4; ++nn) {
      const int v = (nP0 + nn) * 16 + r;
      *(uint2*)(Vnt + v * 72 + i0) = uint2{cvtpk(vn[nn][0], vn[nn][1]), cvtpk(vn[nn][2], vn[nn][3])};
    }
    lds_barrier();
#pragma unroll
    for (int nn = 0; nn < 4; ++nn)
#pragma unroll
      for (int j = 0; j < 4; ++j) qs[nn][j] *= egi[j];
    wave_mma<4, 2>(Atm, 72, mP * 16, Vnt, 72, nP0 * 16, qs, lane);
#pragma unroll
    for (int j = 0; j < 4; ++j)
#pragma unroll
      for (int nn = 0; nn < 4; ++nn) Os[(i0 + j) * 136 + (nP0 + nn) * 16 + r] = f2bf(qs[nn][j]);
    const float egl = sEG[63];
#pragma unroll
    for (int n8 = 0; n8 < 8; ++n8)
#pragma unroll
      for (int j = 0; j < 4; ++j) ST[n8][j] *= egl;
    wave_mma<8, 2>(Vnt, 72, w * 16, Kdt, 72, 0, ST, lane);
#pragma unroll
    for (int n8 = 0; n8 < 8; ++n8)
#pragma unroll
      for (int j = 0; j < 4; ++j) St[(w * 16 + q * 4 + j) * 136 + n8 * 16 + r] = f2bf(ST[n8][j]);
    lds_barrier();
  }
  {
    const int pp = (N - 1) * 64 + orow;
    const int t = base + (dir ? len - 1 - pp : pp);
    const uint4 o0 = *(const uint4*)(Os + orow * 136 + oseg * 16), o1 = *(const uint4*)(Os + orow * 136 + oseg * 16 + 8);
    *(uint4*)(OUT + (size_t)t * 512 + h * 128 + oseg * 16) = o0;
    *(uint4*)(OUT + (size_t)t * 512 + h * 128 + oseg * 16 + 8) = o1;
  }
  if (!g2) {
#pragma unroll
    for (int n8 = 0; n8 < 8; ++n8)
#pragma unroll
      for (int j = 0; j < 4; ++j)
        p.out[OSD + (((((size_t)s * 2 + l) * 2 + dir) * 4 + h) * 128 + (n8 * 16 + r)) * 128 + (w * 16 + q * 4 + j)] = ST[n8][j];
  }
  __syncthreads();
}

DI void phase_mix2(const Params& p, int l, u16* smem, int* s_item, int tid) {
  int* ctr = (int*)(p.ws + WS_CTR) + l * 4 + 1;
  constexpr int NA2 = 1024 - ATT_X1;
  while (true) {
    if (tid == 0) *s_item = atomicAdd(ctr, 1);
    __syncthreads();
    const int it = *s_item;
    __syncthreads();
    if (it >= 64 + NA2 + 256) break;
    if (it >= 64 && it < 64 + NA2) {
      const int a = it - 64 + ATT_X1;
#ifdef PROBE_MAX
      unsigned long long tb_ = wall_clock64();
#endif
      attn_item(p, 32 + (a >> 7), (a >> 4) & 7, a & 15, smem, tid);
#ifdef PROBE_MAX
      if (tid == 0 && (PROBE_MAX) == 3) atomicMax((int*)(p.ws + WS_CTR) + 32 + l, (int)(wall_clock64() - tb_));
#endif
    } else {
      const int a = (it < 64) ? it : it - 64 - NA2;
#ifdef PROBE_MAX
      unsigned long long tb_ = wall_clock64();
#endif
      dn_scan_item(p, l, (it < 64 ? 32 : 0) + (a >> 3), (a >> 1) & 3, a & 1, smem, tid);
#ifdef PROBE_MAX
      if (tid == 0 && (PROBE_MAX) == 2) atomicMax((int*)(p.ws + WS_CTR) + 32 + l, (int)(wall_clock64() - tb_));
#endif
    }
  }
}

DI void phase_dn_post(const Params& p, int l, int tid, int bid, int nblk) {
  const int lane = tid & 63;
  const int gw = bid * 8 + (tid >> 6), nw = nblk * 8;
  const u16* OF = ws_slab(p, 6); const u16* OB = ws_slab(p, 8); const u16* DG = ws_slab(p, 5); u16* DO = ws_slab(p, 2);
  const float* nwp = p.k.in[21] + l * 128 + (lane & 15) * 8;
  float nwv[8];
#pragma unroll
  for (int e = 0; e < 8; ++e) nwv[e] = nwp[e];
  for (int t0 = gw; t0 < TT; t0 += 4 * nw) {
    uint4 a[4], b[4], g[4];
#pragma unroll
    for (int u = 0; u < 4; ++u) {
      const int t = (t0 + u * nw < TT) ? t0 + u * nw : t0;
      const size_t off = (size_t)t * 512 + lane * 8;
      a[u] = *(const uint4*)(OF + off); b[u] = *(const uint4*)(OB + off); g[u] = *(const uint4*)(DG + off);
    }
#pragma unroll
    for (int u = 0; u < 4; ++u) {
      const int t = t0 + u * nw;
      if (t >= TT) break;
      const unsigned au[4] = {a[u].x, a[u].y, a[u].z, a[u].w}, bu[4] = {b[u].x, b[u].y, b[u].z, b[u].w}, gu[4] = {g[u].x, g[u].y, g[u].z, g[u].w};
      float y[8];
      float ss = 0.f;
#pragma unroll
      for (int e = 0; e < 4; ++e) {
        y[2 * e] = bflo(au[e]) + bflo(bu[e]); y[2 * e + 1] = bfhi(au[e]) + bfhi(bu[e]);
        ss += y[2 * e] * y[2 * e] + y[2 * e + 1] * y[2 * e + 1];
      }
      const float rn = rsqrtf(sum16(ss) * (1.f / 128.f) + EPSF);
      unsigned o[4];
#pragma unroll
      for (int e = 0; e < 4; ++e) {
        float y0 = y[2 * e] * rn * nwv[2 * e] * silu_f(bflo(gu[e]));
        float y1 = y[2 * e + 1] * rn * nwv[2 * e + 1] * silu_f(bfhi(gu[e]));
        o[e] = cvtpk(y0, y1);
      }
      *(uint4*)(DO + (size_t)t * 512 + lane * 8) = uint4{o[0], o[1], o[2], o[3]};
    }
  }
}

DI void fast_grid_sync(unsigned* bar, unsigned target) {
  __syncthreads();
  if (threadIdx.x == 0) {
    __threadfence();
    __hip_atomic_fetch_add(bar, 1u, __ATOMIC_RELAXED, __HIP_MEMORY_SCOPE_AGENT);
    while (__hip_atomic_load(bar, __ATOMIC_RELAXED, __HIP_MEMORY_SCOPE_AGENT) < target) __builtin_amdgcn_s_sleep(1);
    __threadfence();
    asm volatile("s_waitcnt vmcnt(0)" ::: "memory");
  }
  __syncthreads();
}

#define PHASE_BEGIN int t_ = tid, b_ = bid, l_ = l; size_t z_ = 0; \
  asm volatile("" : "+v"(t_)); asm volatile("" : "+s"(b_)); asm volatile("" : "+s"(l_)); asm volatile("" : "+s"(z_)); \
  unsigned char* w_ = kp.ws + z_; float* o_ = kp.out + z_; \
  Params q{kp, o_, w_};

__global__ void __launch_bounds__(NTHREADS) trunk_megakernel(KParams kp) {
  extern __shared__ __attribute__((aligned(16))) unsigned char dyn_lds[];
  u16* smem = (u16*)dyn_lds;
  int* s_item_p = (int*)(dyn_lds + LDS_WORK);
#ifdef PROBE_SEG
  if (threadIdx.x == 0) *(unsigned long long*)(dyn_lds + 147456 + 8) = 0ull;
  __syncthreads();
#endif
#ifdef PROBE_ITEM
  if (threadIdx.x == 0) *(unsigned long long*)(s_item_p + 2) = 0ull;
  __syncthreads();
#endif
  cg::grid_group grid = cg::this_grid();
  const int tid = threadIdx.x, bid = blockIdx.x, nblk = gridDim.x;
#ifdef TMASK
  unsigned long long tacc = 0, tprev = wall_clock64();
#endif
  { const int l = 0; PHASE_BEGIN phase_mods(q, smem, t_, b_, nblk); }
  grid.sync();
#pragma unroll 1
  for (int l = 0; l < 2; ++l) {
    if (PH(0)) { PHASE_BEGIN phase_convert(q, l_, smem, t_, b_, nblk); }
#ifdef TMASK
    { unsigned long long tn = wall_clock64(); if ((TMASK >> 0) & 1u) tacc += tn - tprev; tprev = tn; }
#endif
    if (PH(1)) { PHASE_BEGIN phase_norm(q, l_, 0, l_ == 0, t_, b_, nblk); }
    fast_grid_sync((unsigned*)(kp.ws + WS_BAR), (unsigned)(l * 18 + 1) * (unsigned)nblk);
#ifdef TMASK
    { unsigned long long tn = wall_clock64(); if ((TMASK >> 1) & 1u) tacc += tn - tprev; tprev = tn; }
#endif
    if (PH(2)) { PHASE_BEGIN phase_g1(q, 0, smem, t_, b_); }
    fast_grid_sync((unsigned*)(kp.ws + WS_BAR), (unsigned)(l * 18 + 2) * (unsigned)nblk);
    if (PH(3)) { PHASE_BEGIN phase_g2(q, l_, 0, l_ == 0, smem, t_, b_); }
    fast_grid_sync((unsigned*)(kp.ws + WS_BAR), (unsigned)(l * 18 + 3) * (unsigned)nblk);
#ifdef TMASK
    { unsigned long long tn = wall_clock64(); if ((TMASK >> 3) & 1u) tacc += tn - tprev; tprev = tn; }
#endif
    if (PH(4)) { PHASE_BEGIN phase_norm(q, l_, 1, false, t_, b_, nblk); }
    fast_grid_sync((unsigned*)(kp.ws + WS_BAR), (unsigned)(l * 18 + 4) * (unsigned)nblk);
#ifdef TMASK
    { unsigned long long tn = wall_clock64(); if ((TMASK >> 4) & 1u) tacc += tn - tprev; tprev = tn; }
#endif
    if (PH(5)) { PHASE_BEGIN phase_g3a(q, smem, t_, b_); }
    fast_grid_sync((unsigned*)(kp.ws + WS_BAR), (unsigned)(l * 18 + 5) * (unsigned)nblk);
#ifdef TMASK
    { unsigned long long tn = wall_clock64(); if ((TMASK >> 5) & 1u) tacc += tn - tprev; tprev = tn; }
#endif
    if (PH(6)) { PHASE_BEGIN phase_prep(q, l_, t_, b_, nblk); }
    fast_grid_sync((unsigned*)(kp.ws + WS_BAR), (unsigned)(l * 18 + 6) * (unsigned)nblk);
#ifdef TMASK
    { unsigned long long tn = wall_clock64(); if ((TMASK >> 6) & 1u) tacc += tn - tprev; tprev = tn; }
#endif
    if (PH(7)) { PHASE_BEGIN phase_mix1(q, l_, smem, s_item_p, t_); }
    fast_grid_sync((unsigned*)(kp.ws + WS_BAR), (unsigned)(l * 18 + 7) * (unsigned)nblk);
#ifdef TMASK
    { unsigned long long tn = wall_clock64(); if ((TMASK >> 7) & 1u) tacc += tn - tprev; tprev = tn; }
#endif
    if (PH(8)) { PHASE_BEGIN phase_g3b(q, smem, t_, b_); }
    fast_grid_sync((unsigned*)(kp.ws + WS_BAR), (unsigned)(l * 18 + 8) * (unsigned)nblk);
#ifdef TMASK
    { unsigned long long tn = wall_clock64(); if ((TMASK >> 8) & 1u) tacc += tn - tprev; tprev = tn; }
#endif
    if (PH(9)) { PHASE_BEGIN phase_dn_pre(q, l_, smem, t_, b_, nblk); }
    fast_grid_sync((unsigned*)(kp.ws + WS_BAR), (unsigned)(l * 18 + 9) * (unsigned)nblk);
#ifdef TMASK
    { unsigned long long tn = wall_clock64(); if ((TMASK >> 9) & 1u) tacc += tn - tprev; tprev = tn; }
#endif
    if (PH(10)) { PHASE_BEGIN phase_mix2(q, l_, smem, s_item_p, t_); }
    fast_grid_sync((unsigned*)(kp.ws + WS_BAR), (unsigned)(l * 18 + 10) * (unsigned)nblk);
#ifdef TMASK
    { unsigned long long tn = wall_clock64(); if ((TMASK >> 10) & 1u) tacc += tn - tprev; tprev = tn; }
#endif
    if (PH(18)) { PHASE_BEGIN phase_g3c(q, smem, t_, b_); }
    fast_grid_sync((unsigned*)(kp.ws + WS_BAR), (unsigned)(l * 18 + 11) * (unsigned)nblk);
#ifdef TMASK
    { unsigned long long tn = wall_clock64(); if ((TMASK >> 18) & 1u) tacc += tn - tprev; tprev = tn; }
#endif
    if (PH(11)) { PHASE_BEGIN phase_dn_post(q, l_, t_, b_, nblk); }
    fast_grid_sync((unsigned*)(kp.ws + WS_BAR), (unsigned)(l * 18 + 12) * (unsigned)nblk);
#ifdef TMASK
    { unsigned long long tn = wall_clock64(); if ((TMASK >> 11) & 1u) tacc += tn - tprev; tprev = tn; }
#endif
    if (PH(12)) { PHASE_BEGIN phase_mg(q, smem, t_, b_); }
    fast_grid_sync((unsigned*)(kp.ws + WS_BAR), (unsigned)(l * 18 + 13) * (unsigned)nblk);
    if (PH(12)) { PHASE_BEGIN
#pragma unroll 1
      for (int b = 0; b < 3; ++b) { int bb = b; asm volatile("" : "+s"(bb)); phase_br(q, bb, smem, t_, b_); } }
    fast_grid_sync((unsigned*)(kp.ws + WS_BAR), (unsigned)(l * 18 + 14) * (unsigned)nblk);
#ifdef TMASK
    { unsigned long long tn = wall_clock64(); if ((TMASK >> 12) & 1u) tacc += tn - tprev; tprev = tn; }
#endif
    if (PH(13)) { PHASE_BEGIN phase_g5(q, l_, smem, t_, b_); }
    fast_grid_sync((unsigned*)(kp.ws + WS_BAR), (unsigned)(l * 18 + 15) * (unsigned)nblk);
#ifdef TMASK
    { unsigned long long tn = wall_clock64(); if ((TMASK >> 13) & 1u) tacc += tn - tprev; tprev = tn; }
#endif
    if (PH(14)) { PHASE_BEGIN phase_norm(q, l_, 2, false, t_, b_, nblk); }
    fast_grid_sync((unsigned*)(kp.ws + WS_BAR), (unsigned)(l * 18 + 16) * (unsigned)nblk);
#ifdef TMASK
    { unsigned long long tn = wall_clock64(); if ((TMASK >> 14) & 1u) tacc += tn - tprev; tprev = tn; }
#endif
    if (PH(15)) { PHASE_BEGIN phase_g1(q, 1, smem, t_, b_); }
    fast_grid_sync((unsigned*)(kp.ws + WS_BAR), (unsigned)(l * 18 + 17) * (unsigned)nblk);
#ifdef TMASK
    { unsigned long long tn = wall_clock64(); if ((TMASK >> 15) & 1u) tacc += tn - tprev; tprev = tn; }
#endif
    if (PH(16)) { PHASE_BEGIN phase_g2(q, l_, 1, false, smem, t_, b_); }
    fast_grid_sync((unsigned*)(kp.ws + WS_BAR), (unsigned)(l * 18 + 18) * (unsigned)nblk);
#ifdef TMASK
    { unsigned long long tn = wall_clock64(); if ((TMASK >> 16) & 1u) tacc += tn - tprev; tprev = tn; }
#endif
  }
  if (PH(17)) { Params q{kp, kp.out, kp.ws}; phase_final_norm(q, tid, bid, nblk); }
#ifdef PROBE_MAX
  if (bid == 0 && tid == 0) { int* c_ = (int*)(kp.ws + WS_CTR) + 32; unsigned long long ta = (unsigned long long)(__hip_atomic_load(c_, __ATOMIC_RELAXED, __HIP_MEMORY_SCOPE_AGENT) + __hip_atomic_load(c_ + 1, __ATOMIC_RELAXED, __HIP_MEMORY_SCOPE_AGENT)); unsigned long long te = wall_clock64(); while (wall_clock64() - te < ta) { __builtin_amdgcn_s_sleep(8); } }
#endif
#ifdef PROBE_SEG
  if (tid == 0) { unsigned long long ta = *(unsigned long long*)(dyn_lds + 147456 + 8); unsigned long long te = wall_clock64(); while (wall_clock64() - te < ta) { __builtin_amdgcn_s_sleep(8); } }
#endif
#ifdef PROBE_ITEM
  if (bid == nblk - 1 && tid == 0) { unsigned long long ta = *(unsigned long long*)(s_item_p + 2); unsigned long long te = wall_clock64(); while (wall_clock64() - te < ta) { __builtin_amdgcn_s_sleep(8); } }
#endif
#ifdef TMASK
  if (bid == 0) { unsigned long long te = wall_clock64(); while (wall_clock64() - te < tacc) { __builtin_amdgcn_s_sleep(8); } }
#endif
}

extern "C" void kernel_launch(void* const* d_in, const int* in_sizes, int n_in, void* d_out, int out_size, void* d_ws, size_t ws_size,
                              hipStream_t stream) {
  static int grid_blocks = 0;
  if (!grid_blocks) {
    int dev = 0, cus = 0, per_cu = 0;
    hipGetDevice(&dev);
    hipDeviceGetAttribute(&cus, hipDeviceAttributeMultiprocessorCount, dev);
    hipFuncSetAttribute((const void*)trunk_megakernel, hipFuncAttributeMaxDynamicSharedMemorySize, LDS_DYN);
    hipOccupancyMaxActiveBlocksPerMultiprocessor(&per_cu, trunk_megakernel, NTHREADS, LDS_DYN);
    if (per_cu < 1) per_cu = 1;
    grid_blocks = cus * per_cu;
  }
  if (ws_size < WS_END) { fprintf(stderr, "workspace too small: %zu < %zu\n", ws_size, (size_t)WS_END); return; }
  KParams p{};
  for (int i = 0; i < 30; ++i) p.in[i] = (const float*)d_in[i];
  p.out = (float*)d_out;
  p.ws = (unsigned char*)d_ws;
  hipMemsetAsync((unsigned char*)d_ws + WS_BAR, 0, 256, stream);
  void* args[] = {&p};
  hipError_t e = hipLaunchCooperativeKernel((void*)trunk_megakernel, dim3(grid_blocks), dim3(NTHREADS), args, LDS_DYN, stream);
  if (e != hipSuccess) fprintf(stderr, "cooperative launch failed: %s (grid %d)\n", hipGetErrorString(e), grid_blocks);
}
```

```cpp
#include <hip/hip_runtime.h>
#include <hip/hip_cooperative_groups.h>
#include <cstdio>
namespace cg = cooperative_groups;

typedef unsigned short u16;
using bf16x8 = __attribute__((ext_vector_type(8))) short;
using f32x4 = __attribute__((ext_vector_type(4))) float;
#define DI __device__ __forceinline__

constexpr int TT = 40960;
constexpr int TI = 8192;
constexpr int DM = 1024;
constexpr int DFF = 2816;
constexpr float EPSF = 1e-6f;
constexpr int NTHREADS = 512;
constexpr int LDS_WORK = 161536;
constexpr int LDS_DYN = LDS_WORK + 32;
#ifndef PHMASK
#define PHMASK 0xffffffffu
#endif
#define PH(i) ((PHMASK >> (i)) & 1u)

constexpr size_t OCK = 41943040, OCV = 44040192, OSR = 46137344, OSD = 50331648;

constexpr size_t W1IN = 0, W1OUT = 5767168, WIN = 8650752, WBR = 17039360, WOUT = 18612224, W2IN = 19660800, W2OUT = 25427968, WTOTAL = 28311552;
constexpr size_t WS_W = 0;
constexpr size_t WS_H = WTOTAL * 2;
constexpr size_t SLABB = (size_t)TT * 512 * 2;
constexpr size_t WS_SLAB = WS_H + (size_t)TT * 1024 * 2;
constexpr size_t WS_MODS = WS_SLAB + 9 * SLABB;
constexpr size_t WS_DAB = WS_MODS + 2 * 9 * 9216 * 4;
constexpr size_t WS_GBG = WS_DAB + (size_t)TT * 16 * 4;
constexpr size_t WS_GBB = WS_GBG + (size_t)TT * 8 * 4;
constexpr size_t WS_HALO = WS_GBB + (size_t)TT * 8 * 4;
constexpr size_t WS_CTR = WS_HALO + (size_t)640 * 2 * 1536 * 2;
constexpr size_t WS_ROPE = WS_CTR + 256;
constexpr size_t WS_BAR = WS_ROPE + 2 * 1024 * 4;
constexpr size_t WS_END = WS_BAR + 256;
constexpr size_t KC_VT_OFF = 5505024;

struct KParams {
  const float* in[30];
  float* out;
  unsigned char* ws;
};
struct Params {
  const KParams& k;
  float* out;
  unsigned char* ws;
};

typedef __bf16 bf16v2_t __attribute__((ext_vector_type(2)));
typedef float f32v2_t __attribute__((ext_vector_type(2)));
typedef float f32x2_t __attribute__((ext_vector_type(2)));
DI unsigned cvtpk(float lo, float hi) { f32v2_t v = {lo, hi}; bf16v2_t b = __builtin_convertvector(v, bf16v2_t); return __builtin_bit_cast(unsigned, b); }
DI u16 f2bf(float x) { return (u16)(cvtpk(x, 0.f) & 0xffffu); }
DI float bf2f(u16 h) { return __uint_as_float(((unsigned)h) << 16); }
DI float bflo(unsigned u) { return __uint_as_float(u << 16); }
DI float bfhi(unsigned u) { return __uint_as_float(u & 0xffff0000u); }
DI f32x4 mfma16(bf16x8 a, bf16x8 b, f32x4 c) { return __builtin_amdgcn_mfma_f32_16x16x32_bf16(a, b, c, 0, 0, 0); }
DI float silu_f(float x) { return x / (1.f + __expf(-x)); }
DI float sigmoid_f(float x) { return 1.f / (1.f + __expf(-x)); }
DI float wave_sum(float x) {
#pragma unroll
  for (int o = 32; o >= 1; o >>= 1) x += __shfl_xor(x, o);
  return x;
}
DI float sum16(float x) {
  x += __shfl_xor(x, 1); x += __shfl_xor(x, 2); x += __shfl_xor(x, 4); x += __shfl_xor(x, 8);
  return x;
}
DI float max16(float x) {
  x = fmaxf(x, __shfl_xor(x, 1)); x = fmaxf(x, __shfl_xor(x, 2)); x = fmaxf(x, __shfl_xor(x, 4)); x = fmaxf(x, __shfl_xor(x, 8));
  return x;
}
DI void lds_barrier() { asm volatile("s_waitcnt lgkmcnt(0)" ::: "memory"); __builtin_amdgcn_s_barrier(); asm volatile("" ::: "memory"); }
DI int seq_base(int s) { return s < 32 ? s * 256 : TI + (s - 32) * 4096; }
DI int seq_len(int s) { return s < 32 ? 256 : 4096; }
DI int modrow_of(int t) { return t < TI ? 0 : 1 + ((t - TI) >> 12); }
DI const float* xin_row(const Params& p, int t) { return t < TI ? p.k.in[0] + (size_t)t * DM : p.k.in[1] + (size_t)(t - TI) * DM; }
DI size_t kv_base(int s, int kvh) { return s < 32 ? (size_t)(s * 2 + kvh) * (256 * 64) : (size_t)1048576 + (size_t)((s - 32) * 2 + kvh) * (4352 * 64); }

DI u16* ws_w(const Params& p) { return (u16*)(p.ws + WS_W); }
DI u16* ws_h(const Params& p) { return (u16*)(p.ws + WS_H); }
DI u16* ws_slab(const Params& p, int i) { return (u16*)(p.ws + WS_SLAB + (size_t)i * SLABB); }
DI float* ws_mods(const Params& p) { return (float*)(p.ws + WS_MODS); }

template <int NT, int KS>
DI void wave_mma(const u16* A, int lda, int arow0, const u16* B, int ldb, int brow0, f32x4 (&acc)[NT], int lane) {
  const int r = lane & 15, q = lane >> 4;
#pragma unroll
  for (int ks = 0; ks < KS; ++ks) {
    bf16x8 a = *(const bf16x8*)(A + (arow0 + r) * lda + ks * 32 + q * 8);
#pragma unroll
    for (int n = 0; n < NT; ++n) {
      bf16x8 b = *(const bf16x8*)(B + (brow0 + n * 16 + r) * ldb + ks * 32 + q * 8);
      acc[n] = mfma16(a, b, acc[n]);
    }
  }
}

namespace pg8 {
#define PG8_LAS __attribute__((address_space(3)))
typedef unsigned short bf16_t;
typedef short bf16x8 __attribute__((ext_vector_type(8)));
typedef float f32x4 __attribute__((ext_vector_type(4)));
typedef unsigned u32x4 __attribute__((ext_vector_type(4)));
constexpr int BM = 256, BK = 64, HALF = 128, HTB = HALF * BK * 2  , STAGE_BYTES = 8 * HTB, NXCD = 8, WGM = 8;

__host__ __device__ __forceinline__ int lds_byte(int r, int c) { const int st = (r >> 4) * 2 + (c >> 5), rr = r & 15, cc = c & 31, ob = rr * 64 + cc * 2; return st * 1024 + (ob ^ (((ob >> 9) & 1) << 5)); }
__host__ __device__ __forceinline__ void stage_rc(int b, int& R, int& C) { const int st = b / 1024, sb = b % 1024, swz = sb ^ (((sb >> 9) & 1) << 5); R = (st >> 1) * 16 + swz / 64; C = (st & 1) * 32 + (swz % 64) / 2; }
__host__ __device__ __forceinline__ int perm32(int rho) { const int n = rho >> 4, i = rho & 15; return 8 * (i >> 2) + 4 * n + (i & 3); }

struct Unit { int pm, pn; };
struct Gemm { const bf16_t* A; const bf16_t* Bt; int M, N, K; };

struct StaticOrder {
    int nM, nN, nwg, G, c;
    __host__ __device__ void init(int M, int N, int G_, int c_) { nM = M / BM; nN = N / BM; nwg = nM * nN; G = G_; c = c_; }
    __host__ __device__ bool next(int i, Unit& u) const {
        const long L = (long)i * G + c; if (L >= nwg) return false;
        int wgid = (int)L; { const int q = nwg / NXCD, r = nwg % NXCD, xcd = wgid % NXCD, off = wgid / NXCD; wgid = (xcd < r ? xcd * (q + 1) : r * (q + 1) + (xcd - r) * q) + off; }
        const int nig = WGM * nN, gid = wgid / nig, fm = gid * WGM, gsz = (nM - fm) < WGM ? (nM - fm) : WGM;
        u.pm = fm + ((wgid % nig) % gsz); u.pn = (wgid % nig) / gsz; return true;
    }
    __device__ __forceinline__ void a_ready(const Unit&) const {}
    __device__ __forceinline__ void done(const Unit&) const {}
};
template <class Epi, class Sched, bool STAMP = false>
__device__ __forceinline__ void gemm_phase(PG8_LAS unsigned char* lds, const Gemm g, const Sched& S, const Epi& E, unsigned long long* stamps, int tid_in) {
    const int tid = tid_in, wid = __builtin_amdgcn_readfirstlane(tid >> 6), lane = tid & 63, wr = wid >> 2, wc = wid & 3, fr = lane & 15, fq = lane >> 4;
    const int K = g.K, nt = K / BK;
    float zf_ = 0.f; asm volatile("" : "+v"(zf_));
    int ts_lo = 0, ts_hi = 0, nts = 0; const unsigned long long rt_entry = STAMP ? (unsigned long long)wall_clock64() : 0ull;
#define PG8_STAMP() do { if (STAMP && wid == 0 && nts < 64) { const unsigned long long _c = (unsigned long long)clock64(); \
        ts_lo = (lane == nts) ? (int)(unsigned)_c : ts_lo; ts_hi = (lane == nts) ? (int)(unsigned)(_c >> 32) : ts_hi; ++nts; } } while (0)
    PG8_STAMP();
    unsigned voffA[2], voffB[2];
#pragma unroll
    for (int i = 0; i < 2; ++i) { int R, C; stage_rc(tid * 16 + i * 8192, R, C); const int Rb = Epi::PERM ? ((R & ~31) + perm32(R & 31)) : R;
        voffA[i] = (unsigned)(R * K + C) * 2u; voffB[i] = (unsigned)(Rb * K + C) * 2u; }
    const size_t kstep = (size_t)(BK * 2);
    const size_t hstep = (size_t)HALF * K * 2;
    const size_t tstep = 2 * hstep;
    const unsigned ldsw = (unsigned)wid * 1024u;
    const int aoff = lds_byte(wr * 64 + fr, fq * 8), boff = lds_byte(wc * 32 + fr, fq * 8);
#define PG8_SA(b, h) (((b) * 2 + (h)) * HTB)
#define PG8_SB(b, h) ((4 + (b) * 2 + (h)) * HTB)
#define PG8_STAGE(bufoff, gbase, voff) do { _Pragma("unroll") for (int _i = 0; _i < 2; ++_i) \
        __builtin_amdgcn_global_load_lds((const unsigned*)((const char*)(gbase) + (voff)[_i]), (PG8_LAS unsigned*)(lds + (bufoff) + ldsw + _i * 8192), 16, 0, 0); } while (0)
#define PG8_LDA(dst, b, h) do { _Pragma("unroll") for (int m = 0; m < 4; ++m) _Pragma("unroll") for (int k = 0; k < 2; ++k) dst[m][k] = *(const PG8_LAS bf16x8*)(lds + PG8_SA(b, h) + aoff + m * 2048 + k * 1024); } while (0)
#define PG8_LDB(dst, b, h) do { _Pragma("unroll") for (int n = 0; n < 2; ++n) _Pragma("unroll") for (int k = 0; k < 2; ++k) dst[n][k] = *(const PG8_LAS bf16x8*)(lds + PG8_SB(b, h) + boff + n * 2048 + k * 1024); } while (0)
#define PG8_MMA(ai, bj, At, Bt) do { __builtin_amdgcn_s_setprio(1); _Pragma("unroll") for (int m = 0; m < 4; ++m) _Pragma("unroll") for (int n = 0; n < 2; ++n) _Pragma("unroll") for (int k = 0; k < 2; ++k) \
        acc[ai][bj][m][n] = __builtin_amdgcn_mfma_f32_16x16x32_bf16(Bt[n][k], At[m][k], acc[ai][bj][m][n], 0, 0, 0); __builtin_amdgcn_s_setprio(0); } while (0)
#define PG8_WAIT_V(n) asm volatile("s_waitcnt vmcnt(" #n ")" ::: "memory")
#define PG8_WAIT_L(n) asm volatile("s_waitcnt lgkmcnt(" #n ")" ::: "memory")
#define PG8_BAR __builtin_amdgcn_s_barrier()
#define PG8_SCHED __builtin_amdgcn_sched_barrier(0)
    Unit cur, nxt; int ui = 0;
    if (!S.next(0, cur)) return;
    f32x4 acc[2][2][4][2];
#pragma unroll
    for (int a = 0; a < 2; ++a)
#pragma unroll
        for (int b = 0; b < 2; ++b)
#pragma unroll
            for (int m = 0; m < 4; ++m)
#pragma unroll
                for (int n = 0; n < 2; ++n) acc[a][b][m][n] = (f32x4){zf_, zf_, zf_, zf_};
    bf16x8 At[4][2], B0[2][2], B1[2][2];
    const char* cA = (const char*)g.A + (size_t)cur.pm * tstep; const char* cB = (const char*)g.Bt + (size_t)cur.pn * tstep;
    S.a_ready(cur);
    PG8_STAGE(PG8_SB(0, 0), cB, voffB); PG8_STAGE(PG8_SA(0, 0), cA, voffA); PG8_STAGE(PG8_SB(0, 1), cB + hstep, voffB); PG8_STAGE(PG8_SA(0, 1), cA + hstep, voffA);
    if (wr == 1) PG8_BAR;
    PG8_WAIT_V(4); PG8_BAR;
    PG8_STAGE(PG8_SB(1, 0), cB + kstep, voffB); PG8_STAGE(PG8_SA(1, 0), cA + kstep, voffA); PG8_STAGE(PG8_SB(1, 1), cB + hstep + kstep, voffB);
    PG8_WAIT_V(6); PG8_BAR;
    PG8_STAMP();
    for (;;) {
        const bool has_next = S.next(ui + 1, nxt);
        const char* nA = has_next ? (const char*)g.A + (size_t)nxt.pm * tstep : cA; const char* nB = has_next ? (const char*)g.Bt + (size_t)nxt.pn * tstep : cB;
        for (int t = 0; t < nt; t += 2) {
            const bool last = (t == nt - 2);
            const char* a1 = cA + (size_t)(t + 1) * kstep;
            const char* a2 = last ? nA : cA + (size_t)(t + 2) * kstep; const char* b2 = last ? nB : cB + (size_t)(t + 2) * kstep;
            const char* a3 = a2 + kstep; const char* b3 = b2 + kstep;
            if (last && has_next) S.a_ready(nxt);
            PG8_LDB(B0, 0, 0); PG8_SCHED; PG8_LDA(At, 0, 0); PG8_STAGE(PG8_SA(1, 1), a1 + hstep, voffA);
            PG8_WAIT_L(8); PG8_BAR; PG8_WAIT_L(0); PG8_MMA(0, 0, At, B0); PG8_BAR; PG8_SCHED;
            PG8_LDB(B1, 0, 1); PG8_STAGE(PG8_SB(0, 0), b2, voffB);
            PG8_BAR; PG8_WAIT_L(0); PG8_MMA(0, 1, At, B1); PG8_BAR;
            PG8_LDA(At, 0, 1); PG8_STAGE(PG8_SA(0, 0), a2, voffA);
            PG8_BAR; PG8_WAIT_L(0); PG8_MMA(1, 0, At, B0); PG8_BAR; PG8_SCHED;
            PG8_STAGE(PG8_SB(0, 1), b2 + hstep, voffB);
            PG8_WAIT_V(6); PG8_BAR; PG8_MMA(1, 1, At, B1); PG8_BAR;
            PG8_LDB(B0, 1, 0); PG8_SCHED; PG8_LDA(At, 1, 0); PG8_STAGE(PG8_SA(0, 1), a2 + hstep, voffA);
            PG8_WAIT_L(8); PG8_BAR; PG8_WAIT_L(0); PG8_MMA(0, 0, At, B0); PG8_BAR; PG8_SCHED;
            PG8_LDB(B1, 1, 1); PG8_STAGE(PG8_SB(1, 0), b3, voffB);
            PG8_BAR; PG8_WAIT_L(0); PG8_MMA(0, 1, At, B1); PG8_BAR;
            PG8_LDA(At, 1, 1); PG8_STAGE(PG8_SA(1, 0), a3, voffA);
            PG8_BAR; PG8_WAIT_L(0); PG8_MMA(1, 0, At, B0); PG8_BAR; PG8_SCHED;
            PG8_STAGE(PG8_SB(1, 1), b3 + hstep, voffB);
            PG8_WAIT_V(6); PG8_BAR; PG8_MMA(1, 1, At, B1); PG8_BAR;
        }
        PG8_STAMP();
        if constexpr (!Epi::AFTER_DRAIN) { E(acc, cur, wr, wc, fr, fq); S.done(cur); }
        PG8_STAMP();
        if (!has_next) break;
#pragma unroll
        for (int a = 0; a < 2; ++a)
#pragma unroll
            for (int b = 0; b < 2; ++b)
#pragma unroll
                for (int m = 0; m < 4; ++m)
#pragma unroll
                    for (int n = 0; n < 2; ++n) acc[a][b][m][n] = (f32x4){zf_, zf_, zf_, zf_};
        cur = nxt; cA = nA; cB = nB; ++ui;
    }
    PG8_WAIT_V(0);
    if (wr == 0) PG8_BAR;
    PG8_BAR;
    if constexpr (Epi::AFTER_DRAIN) { E.fused(acc, cur, wr, wc, fr, fq, lds, wid, lane); S.done(cur); }
    PG8_STAMP();
    if (STAMP && wid == 0) { stamps[lane] = lane < nts ? (((unsigned long long)(unsigned)ts_hi << 32) | (unsigned)ts_lo) : 0ull;
        if (lane == 62) stamps[62] = rt_entry; if (lane == 63) stamps[63] = (unsigned long long)wall_clock64(); }
#undef PG8_STAMP
#undef PG8_SA
#undef PG8_SB
#undef PG8_STAGE
#undef PG8_LDA
#undef PG8_LDB
#undef PG8_MMA
#undef PG8_WAIT_V
#undef PG8_WAIT_L
#undef PG8_BAR
#undef PG8_SCHED
}
}

template <int MT>
DI void zero_acc(f32x4 (&acc)[MT][4]) {
#pragma unroll
  for (int m = 0; m < MT; ++m)
#pragma unroll
    for (int n = 0; n < 4; ++n) acc[m][n] = f32x4{0.f, 0.f, 0.f, 0.f};
}

DI int map_row(int type, int col) {
  if (type == 0) return col;
  if (type == 1) { if (col < DFF) return 256 * (col >> 7) + (col & 127); int c = col - DFF; return 256 * (c >> 7) + 128 + (c & 127); }
  if (col < 4352) return col;
  if (col < 4368) return 2816 + 1536 + (col - 4352);
  if (col < 4880) return 2816 + 1792 + (col - 4368);
  return 5120 + (col - 4880);
}

DI void conv_tile(const float* __restrict__ src, int ld, int ncols, int k0, int c0, u16* __restrict__ dst, int K, int type, u16* sm, int tid) {
  {
    const int n = tid & 63, kk = tid >> 6;
    const bool ok = (c0 + n) < ncols;
#pragma unroll
    for (int i = 0; i < 8; ++i) {
      int k = kk + 8 * i;
      float v = ok ? src[(size_t)(k0 + k) * ld + c0 + n] : 0.f;
      sm[n * 72 + k] = f2bf(v);
    }
  }
  lds_barrier();
  {
    const int n2 = tid >> 3, seg = tid & 7;
    const int col = c0 + n2;
    if (col < ncols) {
      int row = map_row(type, col);
      *(uint4*)(dst + (size_t)row * K + k0 + seg * 8) = *(const uint4*)(sm + n2 * 72 + seg * 8);
    }
  }
  lds_barrier();
}

DI void phase_convert(const Params& p, int l, u16* smem, int tid, int bid, int nblk) {
  u16* W = ws_w(p);
  const int NJ = 9;
  const int cum[NJ + 1] = {0, 1408, 2112, 4112, 4240, 4368, 4496, 4752, 6160, 6864};
  const int nconv = 6864;
  const int nmod = 0;
  const int total = nconv + 1 + nmod;
  for (int it = bid; it < total; it += nblk) {
    if (it < nconv) {
      int j = 0;
#pragma unroll
      for (int jj = 1; jj < NJ; ++jj) if (it >= cum[jj]) j = jj;
      int t = it - cum[j];
      const float* src; int ld, ncols, K, type = 0, nct; u16* dst;
      switch (j) {
        case 0: src = p.k.in[11] + (size_t)l * 1024 * 5632; ld = 5632; ncols = 5632; K = 1024; type = 1; nct = 88; dst = W + W1IN; break;
        case 1: src = p.k.in[12] + (size_t)l * 2816 * 1024; ld = 1024; ncols = 1024; K = 2816; nct = 16; dst = W + W1OUT; break;
        case 2: src = p.k.in[14] + (size_t)l * 1024 * 7952; ld = 7952; ncols = 7952; K = 1024; type = 2; nct = 125; dst = W + WIN; break;
        case 3: src = p.k.in[22] + (size_t)l * 512 * 1024; ld = 1024; ncols = 1024; K = 512; nct = 16; dst = W + WBR; break;
        case 4: src = p.k.in[23] + (size_t)l * 512 * 1024; ld = 1024; ncols = 1024; K = 512; nct = 16; dst = W + WBR + 524288; break;
        case 5: src = p.k.in[24] + (size_t)l * 512 * 1024; ld = 1024; ncols = 1024; K = 512; nct = 16; dst = W + WBR + 2 * 524288; break;
        case 6: src = p.k.in[25] + (size_t)l * 1024 * 1024; ld = 1024; ncols = 1024; K = 1024; nct = 16; dst = W + WOUT; break;
        case 7: src = p.k.in[27] + (size_t)l * 1024 * 5632; ld = 5632; ncols = 5632; K = 1024; type = 1; nct = 88; dst = W + W2IN; break;
        default: src = p.k.in[28] + (size_t)l * 2816 * 1024; ld = 1024; ncols = 1024; K = 2816; nct = 16; dst = W + W2OUT; break;
      }
      int kt = t / nct, ct = t % nct;
      conv_tile(src, ld, ncols, kt * 64, ct * 64, dst, K, type, smem, tid);
    } else if (it == nconv) {
      u16* z = W + WIN + (size_t)(2816 + 1552) * 1024;
      unsigned zu = 0u; asm volatile("" : "+v"(zu));
      for (int i = tid; i < 240 * 1024 / 8; i += NTHREADS) *(uint4*)(z + i * 8) = uint4{zu, zu, zu, zu};
    }
  }
}

DI void phase_mods(const Params& p, u16* smem, int tid, int bid, int nblk) {
  if (bid == 0 && tid < 64) ((int*)(p.ws + WS_CTR))[tid] = 0;
  if (bid == 1) {
    float* ROPE = (float*)(p.ws + WS_ROPE);
    for (int i = tid; i < 1024; i += NTHREADS) {
      float inv = exp2f(-(float)(i & 15) * (13.287712379549449f / 16.f));
      float sn, cs;
      sincosf((float)(i >> 4) * inv, &sn, &cs);
      ROPE[i] = cs; ROPE[1024 + i] = sn;
    }
  }
  const int nconv = -1;
  for (int it = bid; it < 288; it += nblk) {
    {
      int mi = it - nconv - 1;
      int ml = mi / 144, cb = mi % 144;
      float* sc = (float*)smem;
      float* red = sc + 9 * 1024;
      for (int i = tid; i < 9 * 1024; i += NTHREADS) {
        int r = i >> 10, k = i & 1023;
        float c = (r == 0) ? p.k.in[7][k] : p.k.in[6][(r - 1) * 1024 + k];
        sc[i] = silu_f(c);
      }
      __syncthreads();
      const int n = tid & 63, kg = tid >> 6;
      const float* Wm = p.k.in[8] + (size_t)ml * 1024 * 9216 + cb * 64 + n;
      float a[9];
#pragma unroll
      for (int r = 0; r < 9; ++r) a[r] = 0.f;
#pragma unroll 8
      for (int k = kg * 128; k < kg * 128 + 128; ++k) {
        float wv = Wm[(size_t)k * 9216];
#pragma unroll
        for (int r = 0; r < 9; ++r) a[r] += sc[r * 1024 + k] * wv;
      }
#pragma unroll
      for (int r = 0; r < 9; ++r) red[(kg * 9 + r) * 64 + n] = a[r];
      __syncthreads();
      for (int i = tid; i < 576; i += NTHREADS) {
        int r = i >> 6, nn = i & 63;
        float s = p.k.in[9][(size_t)ml * 9216 + cb * 64 + nn];
#pragma unroll
        for (int g = 0; g < 8; ++g) s += red[(g * 9 + r) * 64 + nn];
        ws_mods(p)[(size_t)(ml * 9 + r) * 9216 + cb * 64 + nn] = s;
      }
      __syncthreads();
    }
  }
}

DI void phase_norm(const Params& p, int l, int which, bool first, int tid, int bid, int nblk) {
  const int lane = tid & 63;
  const int gw = bid * 8 + (tid >> 6), nw = nblk * 8;
  const float* nwp = p.k.in[which == 0 ? 10 : (which == 1 ? 13 : 26)] + l * 1024;
  u16* H = ws_h(p);
  for (int t0 = gw; t0 < TT; t0 += 2 * nw) {
    const int t1 = t0 + nw;
    const bool has1 = t1 < TT;
    const float* xr0 = first ? xin_row(p, t0) : p.out + (size_t)t0 * DM;
    const float* xr1 = has1 ? (first ? xin_row(p, t1) : p.out + (size_t)t1 * DM) : xr0;
    float4 v[2][4];
#pragma unroll
    for (int i = 0; i < 4; ++i) { v[0][i] = *(const float4*)(xr0 + i * 256 + lane * 4); v[1][i] = *(const float4*)(xr1 + i * 256 + lane * 4); }
#pragma unroll
    for (int rr = 0; rr < 2; ++rr) {
      if (rr == 1 && !has1) break;
      const int t = rr ? t1 : t0;
      float ss = 0.f;
#pragma unroll
      for (int i = 0; i < 4; ++i) ss += v[rr][i].x * v[rr][i].x + v[rr][i].y * v[rr][i].y + v[rr][i].z * v[rr][i].z + v[rr][i].w * v[rr][i].w;
      ss = wave_sum(ss);
      const float rstd = rsqrtf(ss * (1.f / 1024.f) + EPSF);
      const float* mod = ws_mods(p) + (size_t)(l * 9 + modrow_of(t)) * 9216;
      const float* sh = mod + (3 * which) * 1024;
      const float* sc = mod + (3 * which + 1) * 1024;
#pragma unroll
      for (int i = 0; i < 4; ++i) {
        int c = i * 256 + lane * 4;
        float4 wv = *(const float4*)(nwp + c), s4 = *(const float4*)(sc + c), h4 = *(const float4*)(sh + c);
        float y0 = v[rr][i].x * rstd * wv.x * (1.f + s4.x) + h4.x;
        float y1 = v[rr][i].y * rstd * wv.y * (1.f + s4.y) + h4.y;
        float y2 = v[rr][i].z * rstd * wv.z * (1.f + s4.z) + h4.z;
        float y3 = v[rr][i].w * rstd * wv.w * (1.f + s4.w) + h4.w;
        *(uint2*)(H + (size_t)t * 1024 + c) = uint2{cvtpk(y0, y1), cvtpk(y2, y3)};
      }
    }
  }
}

DI void phase_final_norm(const Params& p, int tid, int bid, int nblk) {
  const int lane = tid & 63;
  const int gw = bid * 8 + (tid >> 6), nw = nblk * 8;
  const float* nwp = p.k.in[29];
  for (int t0 = gw; t0 < TT; t0 += 2 * nw) {
    const int t1 = t0 + nw;
    const bool has1 = t1 < TT;
    float* xr0 = p.out + (size_t)t0 * DM;
    float* xr1 = has1 ? p.out + (size_t)t1 * DM : xr0;
    float4 v[2][4];
#pragma unroll
    for (int i = 0; i < 4; ++i) { v[0][i] = *(const float4*)(xr0 + i * 256 + lane * 4); v[1][i] = *(const float4*)(xr1 + i * 256 + lane * 4); }
#pragma unroll
    for (int rr = 0; rr < 2; ++rr) {
      if (rr == 1 && !has1) break;
      float* xr = rr ? xr1 : xr0;
      float ss = 0.f;
#pragma unroll
      for (int i = 0; i < 4; ++i) ss += v[rr][i].x * v[rr][i].x + v[rr][i].y * v[rr][i].y + v[rr][i].z * v[rr][i].z + v[rr][i].w * v[rr][i].w;
      ss = wave_sum(ss);
      const float rstd = rsqrtf(ss * (1.f / 1024.f) + EPSF);
#pragma unroll
      for (int i = 0; i < 4; ++i) {
        int c = i * 256 + lane * 4;
        float4 wv = *(const float4*)(nwp + c);
        *(float4*)(xr + c) = float4{v[rr][i].x * rstd * wv.x, v[rr][i].y * rstd * wv.y, v[rr][i].z * rstd * wv.z, v[rr][i].w * rstd * wv.w};
      }
    }
  }
}

typedef __attribute__((address_space(3))) unsigned char lds_u8;

struct EpiSwiglu {
  static constexpr bool PERM = true, AFTER_DRAIN = false;
  u16* hid;
  DI void operator()(const f32x4 (&acc)[2][2][4][2], const pg8::Unit& u, int wr, int wc, int fr, int fq) const {
    const int row0 = u.pm * 256 + wr * 64 + fr, col0 = u.pn * 128 + wc * 32 + fq * 8;
#pragma unroll
    for (int ai = 0; ai < 2; ++ai)
#pragma unroll
      for (int m = 0; m < 4; ++m) {
        const f32x4 g0 = acc[ai][0][m][0], g1 = acc[ai][0][m][1], u0 = acc[ai][1][m][0], u1 = acc[ai][1][m][1];
        uint4 o;
        o.x = cvtpk(silu_f(g0[0]) * u0[0], silu_f(g0[1]) * u0[1]);
        o.y = cvtpk(silu_f(g0[2]) * u0[2], silu_f(g0[3]) * u0[3]);
        o.z = cvtpk(silu_f(g1[0]) * u1[0], silu_f(g1[1]) * u1[1]);
        o.w = cvtpk(silu_f(g1[2]) * u1[2], silu_f(g1[3]) * u1[3]);
        *(uint4*)(hid + (size_t)(row0 + ai * 128 + m * 16) * DFF + col0) = o;
      }
  }
};

struct EpiResid {
  static constexpr bool PERM = false, AFTER_DRAIN = false;
  const float* x0; const float* x1; float* out; const float* gm_base; float scale; bool first;
  DI const float* src_row(int row) const { return first ? (row < TI ? x0 + (size_t)row * DM : x1 + (size_t)(row - TI) * DM) : out + (size_t)row * DM; }
  DI void operator()(const f32x4 (&acc)[2][2][4][2], const pg8::Unit& u, int wr, int wc, int fr, int fq) const {
    const float* gm = gm_base + (size_t)modrow_of(u.pm * 256) * 9216;
    const int row0 = u.pm * 256 + wr * 64 + fr, col0 = u.pn * 256 + wc * 32 + 4 * fq;
    f32x4 gv[2][2];
#pragma unroll
    for (int bj = 0; bj < 2; ++bj)
#pragma unroll
      for (int n = 0; n < 2; ++n) gv[bj][n] = *(const f32x4*)(gm + col0 + bj * 128 + n * 16) * scale;
    f32x4 xa[2][2], xb[2][2];
    {
      const float* __restrict__ xr = src_row(row0) + col0;
      const float* __restrict__ xs = src_row(row0 + 16) + col0;
#pragma unroll
      for (int bj = 0; bj < 2; ++bj)
#pragma unroll
        for (int n = 0; n < 2; ++n) { xa[bj][n] = *(const f32x4*)(xr + bj * 128 + n * 16); xb[bj][n] = *(const f32x4*)(xs + bj * 128 + n * 16); }
    }
#pragma unroll
    for (int rr = 0; rr < 8; ++rr) {
      const int ai = rr >> 2, m = rr & 3;
      f32x4 nx[2][2];
      if (rr + 2 < 8) {
        const float* __restrict__ xr = src_row(row0 + ((rr + 2) >> 2) * 128 + ((rr + 2) & 3) * 16) + col0;
#pragma unroll
        for (int bj = 0; bj < 2; ++bj)
#pragma unroll
          for (int n = 0; n < 2; ++n) nx[bj][n] = *(const f32x4*)(xr + bj * 128 + n * 16);
      }
      float* __restrict__ xo = out + (size_t)(row0 + ai * 128 + m * 16) * DM + col0;
#pragma unroll
      for (int bj = 0; bj < 2; ++bj)
#pragma unroll
        for (int n = 0; n < 2; ++n) *(f32x4*)(xo + bj * 128 + n * 16) = xa[bj][n] + gv[bj][n] * acc[ai][bj][m][n];
#pragma unroll
      for (int bj = 0; bj < 2; ++bj)
#pragma unroll
        for (int n = 0; n < 2; ++n) { xa[bj][n] = xb[bj][n]; if (rr + 2 < 8) xb[bj][n] = nx[bj][n]; }
    }
  }
};

DI uint4 pack8(const f32x4& a, const f32x4& b) { return uint4{cvtpk(a[0], a[1]), cvtpk(a[2], a[3]), cvtpk(b[0], b[1]), cvtpk(b[2], b[3])}; }

struct EpiProjA {
  static constexpr bool PERM = true, AFTER_DRAIN = false;
  unsigned char* slab0;
  DI void operator()(const f32x4 (&acc)[2][2][4][2], const pg8::Unit& u, int wr, int wc, int fr, int fq) const {
    u16* dst; int ldd, c0;
    if (u.pn < 2) { dst = (u16*)slab0; ldd = 512; c0 = u.pn * 256; }
    else if (u.pn == 2) { dst = (u16*)(slab0 + 6 * SLABB); ldd = 256; c0 = 0; }
    else { dst = (u16*)(slab0 + (size_t)(2 + ((u.pn - 3) >> 1)) * SLABB); ldd = 512; c0 = ((u.pn - 3) & 1) * 256; }
    const int row0 = u.pm * 256 + wr * 64 + fr, col0 = c0 + wc * 32 + fq * 8;
#pragma unroll
    for (int ai = 0; ai < 2; ++ai)
#pragma unroll
      for (int m = 0; m < 4; ++m)
#pragma unroll
        for (int bj = 0; bj < 2; ++bj)
          *(uint4*)(dst + (size_t)(row0 + ai * 128 + m * 16) * ldd + col0 + bj * 128) = pack8(acc[ai][bj][m][0], acc[ai][bj][m][1]);
  }
};

struct EpiProjB {
  static constexpr bool PERM = true, AFTER_DRAIN = false;
  unsigned char* slab0; float* dab; u16* halo;
  DI void operator()(const f32x4 (&acc)[2][2][4][2], const pg8::Unit& u, int wr, int wc, int fr, int fq) const {
    const int row0 = u.pm * 256 + wr * 64 + fr;
    if (u.pn < 6) {
      u16* dst = (u16*)(slab0 + (size_t)(2 + (u.pn >> 1)) * SLABB);
      const int col0 = (u.pn & 1) * 256 + wc * 32 + fq * 8;
      const int hcol0 = u.pn * 256 + wc * 32 + fq * 8;
#pragma unroll
      for (int ai = 0; ai < 2; ++ai)
#pragma unroll
        for (int m = 0; m < 4; ++m)
#pragma unroll
          for (int bj = 0; bj < 2; ++bj) {
            const int row = row0 + ai * 128 + m * 16;
            const uint4 v = pack8(acc[ai][bj][m][0], acc[ai][bj][m][1]);
            *(uint4*)(dst + (size_t)row * 512 + col0 + bj * 128) = v;
            if (m == 0 && fr == 0) *(uint4*)(halo + ((size_t)(row >> 6) * 2 + 0) * 1536 + hcol0 + bj * 128) = v;
            if (m == 3 && fr == 15) *(uint4*)(halo + ((size_t)(row >> 6) * 2 + 1) * 1536 + hcol0 + bj * 128) = v;
          }
    } else {
      if (wc == 0 && fq < 2) {
#pragma unroll
        for (int ai = 0; ai < 2; ++ai)
#pragma unroll
          for (int m = 0; m < 4; ++m)
#pragma unroll
            for (int n = 0; n < 2; ++n)
              *(f32x4*)(dab + (size_t)(row0 + ai * 128 + m * 16) * 16 + 8 * fq + 4 * n) = acc[ai][0][m][n];
      }
    }
  }
};

struct EpiProjDG {
  static constexpr bool PERM = true, AFTER_DRAIN = false;
  u16* dst;
  DI void operator()(const f32x4 (&acc)[2][2][4][2], const pg8::Unit& u, int wr, int wc, int fr, int fq) const {
    const int row0 = u.pm * 256 + wr * 64 + fr, col0 = u.pn * 256 + wc * 32 + fq * 8;
#pragma unroll
    for (int ai = 0; ai < 2; ++ai)
#pragma unroll
      for (int m = 0; m < 4; ++m)
#pragma unroll
        for (int bj = 0; bj < 2; ++bj)
          *(uint4*)(dst + (size_t)(row0 + ai * 128 + m * 16) * 512 + col0 + bj * 128) = pack8(acc[ai][bj][m][0], acc[ai][bj][m][1]);
  }
};

DI f32x4 sig4(const f32x4& a) { return f32x4{sigmoid_f(a[0]), sigmoid_f(a[1]), sigmoid_f(a[2]), sigmoid_f(a[3])}; }

struct EpiMG {
  static constexpr bool PERM = true, AFTER_DRAIN = false;
  u16* G;
  DI void operator()(const f32x4 (&acc)[2][2][4][2], const pg8::Unit& u, int wr, int wc, int fr, int fq) const {
    const int row0 = u.pm * 256 + wr * 64 + fr, col0 = u.pn * 256 + wc * 32 + fq * 8;
#pragma unroll
    for (int ai = 0; ai < 2; ++ai)
#pragma unroll
      for (int m = 0; m < 4; ++m)
#pragma unroll
        for (int bj = 0; bj < 2; ++bj)
          *(uint4*)(G + (size_t)(row0 + ai * 128 + m * 16) * 3072 + col0 + bj * 128) = pack8(sig4(acc[ai][bj][m][0]), sig4(acc[ai][bj][m][1]));
  }
};

struct EpiBR {
  static constexpr bool PERM = true, AFTER_DRAIN = false;
  const u16* G; u16* mrg; int b;
  DI void operator()(const f32x4 (&acc)[2][2][4][2], const pg8::Unit& u, int wr, int wc, int fr, int fq) const {
    const int row0 = u.pm * 256 + wr * 64 + fr, col0 = u.pn * 256 + wc * 32 + fq * 8;
    uint4 g[2], pv[2];
    {
      const size_t row = (size_t)row0;
#pragma unroll
      for (int bj = 0; bj < 2; ++bj) {
        g[bj] = *(const uint4*)(G + row * 3072 + b * 1024 + col0 + bj * 128);
        pv[bj] = uint4{0, 0, 0, 0};
        if (b > 0) pv[bj] = *(const uint4*)(mrg + row * 1024 + col0 + bj * 128);
      }
    }
#pragma unroll
    for (int rr = 0; rr < 8; ++rr) {
      const int ai = rr >> 2, m = rr & 3;
      uint4 ng[2], npv[2];
      if (rr + 1 < 8) {
        const size_t row = (size_t)(row0 + ((rr + 1) >> 2) * 128 + ((rr + 1) & 3) * 16);
#pragma unroll
        for (int bj = 0; bj < 2; ++bj) {
          ng[bj] = *(const uint4*)(G + row * 3072 + b * 1024 + col0 + bj * 128);
          npv[bj] = uint4{0, 0, 0, 0};
          if (b > 0) npv[bj] = *(const uint4*)(mrg + row * 1024 + col0 + bj * 128);
        }
      }
      const size_t row = (size_t)(row0 + ai * 128 + m * 16);
#pragma unroll
      for (int bj = 0; bj < 2; ++bj) {
        const f32x4 a0 = acc[ai][bj][m][0], a1 = acc[ai][bj][m][1];
        uint4 o;
        o.x = cvtpk(bflo(pv[bj].x) + bflo(g[bj].x) * a0[0], bfhi(pv[bj].x) + bfhi(g[bj].x) * a0[1]);
        o.y = cvtpk(bflo(pv[bj].y) + bflo(g[bj].y) * a0[2], bfhi(pv[bj].y) + bfhi(g[bj].y) * a0[3]);
        o.z = cvtpk(bflo(pv[bj].z) + bflo(g[bj].z) * a1[0], bfhi(pv[bj].z) + bfhi(g[bj].z) * a1[1]);
        o.w = cvtpk(bflo(pv[bj].w) + bflo(g[bj].w) * a1[2], bfhi(pv[bj].w) + bfhi(g[bj].w) * a1[3]);
        *(uint4*)(mrg + row * 1024 + col0 + bj * 128) = o;
      }
      if (rr + 1 < 8) {
#pragma unroll
        for (int bj = 0; bj < 2; ++bj) { g[bj] = ng[bj]; pv[bj] = npv[bj]; }
      }
    }
  }
};

template <class Epi>
DI void run_gemm(u16* smem, const u16* A, const u16* Bt, int N, int K, const Epi& E, int tid, int bid) {
  pg8::Gemm g{A, Bt, TT, N, K};
  pg8::StaticOrder S;
  S.init(TT, N, (int)gridDim.x, bid);
  pg8::gemm_phase<Epi, pg8::StaticOrder, false>((lds_u8*)smem, g, S, E, nullptr, tid);
}

DI void phase_g1(const Params& p, int which, u16* smem, int tid, int bid) {
  EpiSwiglu E{ws_slab(p, 0)};
  run_gemm(smem, ws_h(p), ws_w(p) + (which ? W2IN : W1IN), 5632, 1024, E, tid, bid);
}
DI void phase_g2(const Params& p, int l, int which, bool first, u16* smem, int tid, int bid) {
  EpiResid E{p.k.in[0], p.k.in[1], p.out, ws_mods(p) + (size_t)(l * 9) * 9216 + (which ? 8 : 2) * 1024, 0.5f, first};
  run_gemm(smem, ws_slab(p, 0), ws_w(p) + (which ? W2OUT : W1OUT), 1024, DFF, E, tid, bid);
}
DI void phase_g3a(const Params& p, u16* smem, int tid, int bid) {
  EpiProjA E{p.ws + WS_SLAB};
  run_gemm(smem, ws_h(p), ws_w(p) + WIN, 2816, 1024, E, tid, bid);
}
DI void phase_g3b(const Params& p, u16* smem, int tid, int bid) {
  EpiProjB E{p.ws + WS_SLAB, (float*)(p.ws + WS_DAB), (u16*)(p.ws + WS_HALO)};
  run_gemm(smem, ws_h(p), ws_w(p) + WIN + (size_t)2816 * 1024, 1792, 1024, E, tid, bid);
}
DI void phase_g3c(const Params& p, u16* smem, int tid, int bid) {
  EpiProjDG E{ws_slab(p, 5)};
  run_gemm(smem, ws_h(p), ws_w(p) + WIN + (size_t)4608 * 1024, 512, 1024, E, tid, bid);
}
DI void phase_mg(const Params& p, u16* smem, int tid, int bid) {
  EpiMG E{ws_slab(p, 3)};
  run_gemm(smem, ws_h(p), ws_w(p) + WIN + (size_t)5120 * 1024, 3072, 1024, E, tid, bid);
}
DI void phase_br(const Params& p, int b, u16* smem, int tid, int bid) {
  EpiBR E{ws_slab(p, 3), ws_h(p), b};
  run_gemm(smem, ws_slab(p, b), ws_w(p) + WBR + (size_t)b * 524288, 1024, 512, E, tid, bid);
}
DI void phase_g5(const Params& p, int l, u16* smem, int tid, int bid) {
  EpiResid E{p.k.in[0], p.k.in[1], p.out, ws_mods(p) + (size_t)(l * 9) * 9216 + 5 * 1024, 1.0f, false};
  run_gemm(smem, ws_h(p), ws_w(p) + WOUT, 1024, 1024, E, tid, bid);
}

DI void phase_prep(const Params& p, int l, int tid, int bid, int nblk) {
  const int lane = tid & 63, hl = lane & 7;
  const int gw = bid * 8 + (tid >> 6), nw = nblk * 8;
  u16* AQ = ws_slab(p, 0); u16* RQ = ws_slab(p, 2); u16* RK = ws_slab(p, 3);
  const u16* KV = ws_slab(p, 6);
  u16* KC = ws_slab(p, 7);
  const float* ROPE = (const float*)(p.ws + WS_ROPE);
  float wq[8], wk[8];
#pragma unroll
  for (int e = 0; e < 8; ++e) { wq[e] = p.k.in[15][l * 64 + hl * 8 + e]; wk[e] = p.k.in[16][l * 64 + hl * 8 + e]; }
  const float sgn = (hl < 4) ? -1.f : 1.f;
  for (int t = gw; t < TT; t += nw) {
    const bool g2 = t >= TI;
    const int s = g2 ? 32 + ((t - TI) >> 12) : (t >> 8);
    const int tl = t - seq_base(s);
    const int S = g2 ? 4352 : 256;
    float cs[8], sn[8];
    if (g2) {
      const int i0 = (hl & 3) * 8;
      const int pos = (i0 < 16) ? (tl >> 6) : (tl & 63);
      const float* rp = ROPE + pos * 16 + (i0 & 15);
      float4 c0 = *(const float4*)rp, c1 = *(const float4*)(rp + 4), s0 = *(const float4*)(rp + 1024), s1 = *(const float4*)(rp + 1028);
      cs[0] = c0.x; cs[1] = c0.y; cs[2] = c0.z; cs[3] = c0.w; cs[4] = c1.x; cs[5] = c1.y; cs[6] = c1.z; cs[7] = c1.w;
      sn[0] = s0.x; sn[1] = s0.y; sn[2] = s0.z; sn[3] = s0.w; sn[4] = s1.x; sn[5] = s1.y; sn[6] = s1.z; sn[7] = s1.w;
    } else {
#pragma unroll
      for (int e = 0; e < 8; ++e) { cs[e] = 1.f; sn[e] = 0.f; }
    }
    const uint4 raw_aq = *(const uint4*)(AQ + (size_t)t * 512 + lane * 8);
    const uint4 raw_kv = (lane < 32) ? *(const uint4*)(KV + (size_t)t * 256 + lane * 8) : uint4{0, 0, 0, 0};
    const uint4 raw_rq = *(const uint4*)(RQ + (size_t)t * 512 + lane * 8);
    const uint4 raw_rk = g2 ? *(const uint4*)(RK + (size_t)t * 512 + lane * 8) : uint4{0, 0, 0, 0};
    {
      u16* pq = AQ + (size_t)t * 512 + lane * 8;
      uint4 raw = raw_aq;
      float x[8] = {bflo(raw.x), bfhi(raw.x), bflo(raw.y), bfhi(raw.y), bflo(raw.z), bfhi(raw.z), bflo(raw.w), bfhi(raw.w)};
      float ss = 0.f;
#pragma unroll
      for (int e = 0; e < 8; ++e) ss += x[e] * x[e];
      ss += __shfl_xor(ss, 1); ss += __shfl_xor(ss, 2); ss += __shfl_xor(ss, 4);
      const float rstd = rsqrtf(ss * (1.f / 64.f) + EPSF);
#pragma unroll
      for (int e = 0; e < 8; ++e) x[e] = x[e] * rstd * wq[e];
      if (g2) {
#pragma unroll
        for (int e = 0; e < 8; ++e) { float pr = __shfl_xor(x[e], 4); x[e] = x[e] * cs[e] + sgn * pr * sn[e]; }
      }
      *(uint4*)pq = uint4{cvtpk(x[0], x[1]), cvtpk(x[2], x[3]), cvtpk(x[4], x[5]), cvtpk(x[6], x[7])};
    }
    if (lane < 32) {
      const int kv = (lane >> 3) & 1;
      uint4 raw = raw_kv;
      float x[8] = {bflo(raw.x), bfhi(raw.x), bflo(raw.y), bfhi(raw.y), bflo(raw.z), bfhi(raw.z), bflo(raw.w), bfhi(raw.w)};
      if (lane < 16) {
        float ss = 0.f;
#pragma unroll
        for (int e = 0; e < 8; ++e) ss += x[e] * x[e];
        ss += __shfl_xor(ss, 1); ss += __shfl_xor(ss, 2); ss += __shfl_xor(ss, 4);
        const float rstd = rsqrtf(ss * (1.f / 64.f) + EPSF);
#pragma unroll
        for (int e = 0; e < 8; ++e) x[e] = x[e] * rstd * wk[e];
        if (!g2) {
          float* oc = p.out + OCK + ((((size_t)s * 2 + l) * 256 + tl) * 2 + kv) * 64 + hl * 8;
          *(float4*)oc = float4{x[0], x[1], x[2], x[3]};
          *(float4*)(oc + 4) = float4{x[4], x[5], x[6], x[7]};
        } else {
#pragma unroll
          for (int e = 0; e < 8; ++e) { float pr = __shfl_xor(x[e], 4); x[e] = x[e] * cs[e] + sgn * pr * sn[e]; }
        }
        *(uint4*)(KC + kv_base(s, kv) + (size_t)tl * 64 + hl * 8) = uint4{cvtpk(x[0], x[1]), cvtpk(x[2], x[3]), cvtpk(x[4], x[5]), cvtpk(x[6], x[7])};
      } else {
        if (!g2) {
          float* oc = p.out + OCV + ((((size_t)s * 2 + l) * 256 + tl) * 2 + kv) * 64 + hl * 8;
          *(float4*)oc = float4{x[0], x[1], x[2], x[3]};
          *(float4*)(oc + 4) = float4{x[4], x[5], x[6], x[7]};
        }
        u16* vt = KC + KC_VT_OFF + kv_base(s, kv) + (size_t)(hl * 8) * S + tl;
        unsigned ru[4] = {raw.x, raw.y, raw.z, raw.w};
#pragma unroll
        for (int e = 0; e < 4; ++e) { vt[(size_t)(2 * e) * S] = (u16)(ru[e] & 0xffffu); vt[(size_t)(2 * e + 1) * S] = (u16)(ru[e] >> 16); }
      }
    }
    {
      u16* pq = RQ + (size_t)t * 512 + lane * 8;
      uint4 raw = raw_rq;
      float x[8] = {bflo(raw.x), bfhi(raw.x), bflo(raw.y), bfhi(raw.y), bflo(raw.z), bfhi(raw.z), bflo(raw.w), bfhi(raw.w)};
      if (g2) {
#pragma unroll
        for (int e = 0; e < 8; ++e) { float pr = __shfl_xor(x[e], 4); x[e] = x[e] * cs[e] + sgn * pr * sn[e]; }
      }
      *(uint4*)pq = uint4{cvtpk(x[0] * 0.125f, x[1] * 0.125f), cvtpk(x[2] * 0.125f, x[3] * 0.125f), cvtpk(x[4] * 0.125f, x[5] * 0.125f), cvtpk(x[6] * 0.125f, x[7] * 0.125f)};
    }
    if (g2) {
      u16* pk = RK + (size_t)t * 512 + lane * 8;
      uint4 raw = raw_rk;
      float x[8] = {bflo(raw.x), bfhi(raw.x), bflo(raw.y), bfhi(raw.y), bflo(raw.z), bfhi(raw.z), bflo(raw.w), bfhi(raw.w)};
#pragma unroll
      for (int e = 0; e < 8; ++e) { float pr = __shfl_xor(x[e], 4); x[e] = x[e] * cs[e] + sgn * pr * sn[e]; }
      *(uint4*)pk = uint4{cvtpk(x[0], x[1]), cvtpk(x[2], x[3]), cvtpk(x[4], x[5]), cvtpk(x[6], x[7])};
    }
  }
  const int gt = bid * NTHREADS + tid, ngt = nblk * NTHREADS;
  for (int idx = gt; idx < 8 * 256 * 2 * 64; idx += ngt) {
    int d = idx & 63, kv = (idx >> 6) & 1, j = (idx >> 7) & 255, b = idx >> 15;
    size_t src = ((((size_t)b * 2 + l) * 256 + j) * 2 + kv) * 64 + d;
    KC[kv_base(32 + b, kv) + (size_t)(4096 + j) * 64 + d] = f2bf(p.k.in[2][src]);
    KC[KC_VT_OFF + kv_base(32 + b, kv) + (size_t)d * 4352 + 4096 + j] = f2bf(p.k.in[3][src]);
  }
}

DI void attn_qk(const u16* cK, const bf16x8 (&qf)[2][2], f32x4 (&st)[2][4], int r, int q) {
  zero_acc<2>(st);
#pragma unroll
  for (int ks = 0; ks < 2; ++ks)
#pragma unroll
    for (int t = 0; t < 4; ++t) {
      bf16x8 a = *(const bf16x8*)(cK + (t * 16 + r) * 72 + ks * 32 + q * 8);
#pragma unroll
      for (int m = 0; m < 2; ++m) st[m][t] = mfma16(a, qf[m][ks], st[m][t]);
    }
}

DI void attn_item(const Params& p, int s, int head, int qt, u16* smem, int tid) {
  const int lane = tid & 63, w = tid >> 6, r = lane & 15, q = lane >> 4;
  const int base = seq_base(s);
  const int S = s < 32 ? 256 : 4352;
  const int kvh = head >> 2;
  const u16* Kc = ws_slab(p, 7) + kv_base(s, kvh);
  const u16* Vt = ws_slab(p, 7) + KC_VT_OFF + kv_base(s, kvh);
  u16* Qb = ws_slab(p, 0);
  const int row0 = base + qt * 256 + w * 32;
  bf16x8 qf[2][2];
#pragma unroll
  for (int m = 0; m < 2; ++m)
#pragma unroll
    for (int ks = 0; ks < 2; ++ks) qf[m][ks] = *(const bf16x8*)(Qb + (size_t)(row0 + m * 16 + r) * 512 + head * 64 + ks * 32 + q * 8);
  f32x4 o[2][4];
  zero_acc<2>(o);
  float mx[2] = {-INFINITY, -INFINITY}, ls[2] = {0.f, 0.f};
  u16* sK = smem;
  u16* sV = smem + 2 * 64 * 72;
  const int nkt = S >> 6;
  const int lrow = tid >> 3, lseg = tid & 7;
  const float c = 0.125f * 1.4426950408889634f;
  const u16* kp = Kc + (size_t)lrow * 64 + lseg * 8;
  const u16* vp0 = Vt + (size_t)lrow * S + lseg * 8;
  const int lofs = lrow * 72 + lseg * 8;
  {
    uint4 k0 = *(const uint4*)kp, k1 = *(const uint4*)(kp + 4096), v0 = *(const uint4*)vp0;
    *(uint4*)(sK + lofs) = k0; *(uint4*)(sK + 4608 + lofs) = k1; *(uint4*)(sV + lofs) = v0;
  }
  uint4 rk = *(const uint4*)(kp + 2 * 4096);
  uint4 rv = *(const uint4*)(vp0 + 64);
  __syncthreads();
  f32x4 stn[2][4];
  attn_qk(sK, qf, stn, r, q);
  __syncthreads();
  for (int kt = 0; kt < nkt; ++kt) {
    if (kt + 2 < nkt) *(uint4*)(sK + (kt & 1) * 4608 + lofs) = rk;
    if (kt + 1 < nkt) *(uint4*)(sV + ((kt + 1) & 1) * 4608 + lofs) = rv;
    if (kt + 3 < nkt) rk = *(const uint4*)(kp + (size_t)(kt + 3) * 4096);
    if (kt + 2 < nkt) rv = *(const uint4*)(vp0 + (kt + 2) * 64);
    const u16* nK = sK + ((kt + 1) & 1) * 4608;
    const u16* cV = sV + (kt & 1) * 4608;
    f32x4 st[2][4];
#pragma unroll
    for (int m = 0; m < 2; ++m)
#pragma unroll
      for (int t = 0; t < 4; ++t) { st[m][t] = stn[m][t]; stn[m][t] = f32x4{0.f, 0.f, 0.f, 0.f}; }
#pragma unroll
    for (int ks = 0; ks < 2; ++ks) {
      bf16x8 kf[4];
#pragma unroll
      for (int t = 0; t < 4; ++t) kf[t] = *(const bf16x8*)(nK + (t * 16 + r) * 72 + ks * 32 + q * 8);
      __builtin_amdgcn_sched_barrier(0);
#pragma unroll
      for (int t = 0; t < 4; ++t)
#pragma unroll
        for (int m = 0; m < 2; ++m) stn[m][t] = mfma16(kf[t], qf[m][ks], stn[m][t]);
      __builtin_amdgcn_sched_barrier(0);
    }
#pragma unroll
    for (int m = 0; m < 2; ++m) {
      float rm = fmaxf(fmaxf(st[m][0][0], st[m][0][1]), fmaxf(st[m][0][2], st[m][0][3]));
#pragma unroll
      for (int t = 1; t < 4; ++t) { rm = fmaxf(fmaxf(rm, st[m][t][0]), st[m][t][1]); rm = fmaxf(fmaxf(rm, st[m][t][2]), st[m][t][3]); }
      rm = fmaxf(rm, __shfl_xor(rm, 16));
      rm = fmaxf(rm, __shfl_xor(rm, 32));
      const float mnew = fmaxf(mx[m], rm);
      const float alpha = __builtin_amdgcn_exp2f((mx[m] - mnew) * c);
      mx[m] = mnew;
      const f32x2_t c2 = {c, c}, mc2 = {mnew * c, mnew * c};
      f32x2_t ps2 = {0.f, 0.f};
#pragma unroll
      for (int t = 0; t < 4; ++t)
#pragma unroll
        for (int jp = 0; jp < 2; ++jp) {
          f32x2_t v = {st[m][t][2 * jp], st[m][t][2 * jp + 1]};
          v = v * c2 - mc2;
          v.x = __builtin_amdgcn_exp2f(v.x); v.y = __builtin_amdgcn_exp2f(v.y);
          ps2 += v;
          st[m][t][2 * jp] = v.x; st[m][t][2 * jp + 1] = v.y;
        }
      ls[m] = ls[m] * alpha + ps2.x + ps2.y;
#pragma unroll
      for (int dt = 0; dt < 4; ++dt) o[m][dt] = o[m][dt] * alpha;
    }
#pragma unroll
    for (int kb = 0; kb < 2; ++kb) {
      bf16x8 vf[4];
#pragma unroll
      for (int dt = 0; dt < 4; ++dt) {
        const u16* vp = cV + (dt * 16 + r) * 72 + kb * 32 + 4 * q;
        uint2 lo = *(const uint2*)vp, hi = *(const uint2*)(vp + 16);
        vf[dt] = __builtin_bit_cast(bf16x8, uint4{lo.x, lo.y, hi.x, hi.y});
      }
      bf16x8 pb[2];
#pragma unroll
      for (int m = 0; m < 2; ++m) {
        uint4 u = uint4{cvtpk(st[m][2 * kb][0], st[m][2 * kb][1]), cvtpk(st[m][2 * kb][2], st[m][2 * kb][3]),
                        cvtpk(st[m][2 * kb + 1][0], st[m][2 * kb + 1][1]), cvtpk(st[m][2 * kb + 1][2], st[m][2 * kb + 1][3])};
        pb[m] = __builtin_bit_cast(bf16x8, u);
      }
      __builtin_amdgcn_sched_barrier(0);
#pragma unroll
      for (int dt = 0; dt < 4; ++dt)
#pragma unroll
        for (int m = 0; m < 2; ++m) o[m][dt] = mfma16(vf[dt], pb[m], o[m][dt]);
      __builtin_amdgcn_sched_barrier(0);
    }
    __syncthreads();
  }
#pragma unroll
  for (int m = 0; m < 2; ++m) {
    float l = ls[m];
    l += __shfl_xor(l, 16);
    l += __shfl_xor(l, 32);
    const float inv = 1.f / l;
#pragma unroll
    for (int dt = 0; dt < 4; ++dt)
      *(uint2*)(Qb + (size_t)(row0 + m * 16 + r) * 512 + head * 64 + dt * 16 + 4 * q) =
          uint2{cvtpk(o[m][dt][0] * inv, o[m][dt][1] * inv), cvtpk(o[m][dt][2] * inv, o[m][dt][3] * inv)};
  }
}

DI void ret_stage(u16* Qs, u16* Ks, u16* Kdt, u16* Vt, int row, int seg, const uint4& qv, const uint4& kv, const uint4& vv, float kdec) {
  *(uint4*)(Qs + row * 72 + seg * 8) = qv;
  *(uint4*)(Ks + row * 72 + seg * 8) = kv;
  u16* kd = Kdt + (seg * 8) * 72 + row;
  u16* vt = Vt + (seg * 8) * 72 + row;
  kd[0 * 72] = f2bf(bflo(kv.x) * kdec); kd[1 * 72] = f2bf(bfhi(kv.x) * kdec);
  kd[2 * 72] = f2bf(bflo(kv.y) * kdec); kd[3 * 72] = f2bf(bfhi(kv.y) * kdec);
  kd[4 * 72] = f2bf(bflo(kv.z) * kdec); kd[5 * 72] = f2bf(bfhi(kv.z) * kdec);
  kd[6 * 72] = f2bf(bflo(kv.w) * kdec); kd[7 * 72] = f2bf(bfhi(kv.w) * kdec);
  vt[0 * 72] = (u16)(vv.x & 0xffffu); vt[1 * 72] = (u16)(vv.x >> 16);
  vt[2 * 72] = (u16)(vv.y & 0xffffu); vt[3 * 72] = (u16)(vv.y >> 16);
  vt[4 * 72] = (u16)(vv.z & 0xffffu); vt[5 * 72] = (u16)(vv.z >> 16);
  vt[6 * 72] = (u16)(vv.w & 0xffffu); vt[7 * 72] = (u16)(vv.w >> 16);
}

DI void ret_rowwise(const float* Os, u16* RO, int t, int h, int ct, bool fin, const uint4& f0, const uint4& f1, const uint4& f2, const uint4& f3, const float (&rw)[16]) {
  const int row = ct >> 2, c4 = ct & 3;
  float x[16];
#pragma unroll
  for (int e4 = 0; e4 < 4; ++e4) {
    float4 v = *(const float4*)(Os + row * 68 + c4 * 16 + e4 * 4);
    x[e4 * 4] = v.x; x[e4 * 4 + 1] = v.y; x[e4 * 4 + 2] = v.z; x[e4 * 4 + 3] = v.w;
  }
  u16* po = RO + (size_t)t * 512 + h * 64 + c4 * 16;
  if (fin) {
    const unsigned pu[8] = {f0.x, f0.y, f0.z, f0.w, f1.x, f1.y, f1.z, f1.w};
    const unsigned gu[8] = {f2.x, f2.y, f2.z, f2.w, f3.x, f3.y, f3.z, f3.w};
    float s1 = 0.f;
#pragma unroll
    for (int e = 0; e < 8; ++e) { x[2 * e] += bflo(pu[e]); x[2 * e + 1] += bfhi(pu[e]); s1 += x[2 * e] + x[2 * e + 1]; }
    s1 += __shfl_xor(s1, 1); s1 += __shfl_xor(s1, 2);
    const float mu = s1 * (1.f / 64.f);
    float s2 = 0.f;
#pragma unroll
    for (int e = 0; e < 16; ++e) { float d = x[e] - mu; s2 += d * d; }
    s2 += __shfl_xor(s2, 1); s2 += __shfl_xor(s2, 2);
    const float rs = rsqrtf(s2 * (1.f / 64.f) + EPSF);
#pragma unroll
    for (int e = 0; e < 8; ++e) {
      x[2 * e] = (x[2 * e] - mu) * rs * rw[2 * e] * silu_f(bflo(gu[e]));
      x[2 * e + 1] = (x[2 * e + 1] - mu) * rs * rw[2 * e + 1] * silu_f(bfhi(gu[e]));
    }
  }
  *(uint4*)po = uint4{cvtpk(x[0], x[1]), cvtpk(x[2], x[3]), cvtpk(x[4], x[5]), cvtpk(x[6], x[7])};
  *(uint4*)(po + 8) = uint4{cvtpk(x[8], x[9]), cvtpk(x[10], x[11]), cvtpk(x[12], x[13]), cvtpk(x[14], x[15])};
}

DI void ret_item(const Params& p, int l, int s, int h, u16* smem, int tid) {
  const int lane = tid & 63, r = lane & 15, q = lane >> 4;
  const int dir = tid >> 8, ct = tid & 255, wv = (tid >> 6) & 3;
  const int base = seq_base(s), len = seq_len(s), N = len >> 6;
  const bool g2 = s >= 32;
  const float lg = log1pf(-exp2f(-(dir ? 5.5f : 5.0f) - (float)h));
  u16* cs = smem + dir * 36352;
  u16* Qs = cs; u16* Ks = cs + 4608; u16* Vt = cs + 2 * 4608; u16* Kdt = cs + 3 * 4608; u16* Ps = cs + 4 * 4608; u16* St = cs + 5 * 4608;
  float* Os = (float*)(cs + 6 * 4608);
  const u16* RQ = ws_slab(p, 2); const u16* RK = ws_slab(p, 3); const u16* RV = ws_slab(p, 4); const u16* RG = ws_slab(p, 5);
  u16* RO = ws_slab(p, 1);
  f32x4 accS[4];
#pragma unroll
  for (int n = 0; n < 4; ++n)
#pragma unroll
    for (int j = 0; j < 4; ++j) {
      float v0 = 0.f;
      if (g2) v0 = p.k.in[4][(((((size_t)(s - 32) * 2 + l) * 2 + dir) * 8 + h) * 64 + (n * 16 + r)) * 64 + (wv * 16 + q * 4 + j)];
      accS[n][j] = v0;
      St[(wv * 16 + q * 4 + j) * 72 + n * 16 + r] = f2bf(v0);
    }
  const float cdec = __expf(lg * 64.f);
  float rw[16];
  {
    const float* rnw = p.k.in[17] + l * 512 + h * 64 + (ct & 3) * 16;
#pragma unroll
    for (int e = 0; e < 16; ++e) rw[e] = rnw[e];
  }
  float rowf[4], colf[4], qdf[4];
#pragma unroll
  for (int j = 0; j < 4; ++j) {
    rowf[j] = __expf(lg * (float)(wv * 16 + q * 4 + j)); colf[j] = __expf(-lg * (float)(j * 16 + r));
    qdf[j] = __expf(lg * (float)(wv * 16 + q * 4 + j + 1));
  }
  uint4 pq0, pq1, pk0, pk1, pv0, pv1;
  {
    const int t = base + (dir ? len - 1 - lane : lane);
    const size_t off0 = (size_t)t * 512 + h * 64 + wv * 8, off1 = off0 + 32;
    pq0 = *(const uint4*)(RQ + off0); pk0 = *(const uint4*)(RK + off0); pv0 = *(const uint4*)(RV + off0);
    pq1 = *(const uint4*)(RQ + off1); pk1 = *(const uint4*)(RK + off1); pv1 = *(const uint4*)(RV + off1);
  }
  const float kdec = __expf(lg * (float)(63 - lane));
  uint4 f0 = uint4{0, 0, 0, 0}, f1 = f0, f2 = f0, f3 = f0;
  const int erow = ct >> 2;
  for (int n = 0; n < N; ++n) {
    if (n > 0) {
      const int pp = (n - 1) * 64 + erow;
      ret_rowwise(Os, RO, base + (dir ? len - 1 - pp : pp), h, ct, (n - 1) >= (N >> 1), f0, f1, f2, f3, rw);
    }
    ret_stage(Qs, Ks, Kdt, Vt, lane, wv, pq0, pk0, pv0, kdec);
    ret_stage(Qs, Ks, Kdt, Vt, lane, wv + 4, pq1, pk1, pv1, kdec);
    if (n + 1 < N) {
      const int pp = (n + 1) * 64 + lane;
      const int t = base + (dir ? len - 1 - pp : pp);
      const size_t off0 = (size_t)t * 512 + h * 64 + wv * 8, off1 = off0 + 32;
      pq0 = *(const uint4*)(RQ + off0); pk0 = *(const uint4*)(RK + off0); pv0 = *(const uint4*)(RV + off0);
      pq1 = *(const uint4*)(RQ + off1); pk1 = *(const uint4*)(RK + off1); pv1 = *(const uint4*)(RV + off1);
    }
    if (n == (N >> 1)) __syncthreads(); else lds_barrier();
    if (n >= (N >> 1)) {
      const int pp = n * 64 + erow;
      const int t = base + (dir ? len - 1 - pp : pp);
      const size_t off = (size_t)t * 512 + h * 64 + (ct & 3) * 16;
      f0 = *(const uint4*)(RO + off); f1 = *(const uint4*)(RO + off + 8);
      f2 = *(const uint4*)(RG + off); f3 = *(const uint4*)(RG + off + 8);
    }
    f32x4 sa[4];
#pragma unroll
    for (int nn = 0; nn < 4; ++nn) sa[nn] = f32x4{0.f, 0.f, 0.f, 0.f};
    wave_mma<4, 2>(Qs, 72, wv * 16, Ks, 72, 0, sa, lane);
#pragma unroll
    for (int nn = 0; nn < 4; ++nn)
#pragma unroll
      for (int j = 0; j < 4; ++j) {
        int i = wv * 16 + q * 4 + j, jj = nn * 16 + r;
        float pv = (i >= jj) ? sa[nn][j] * (rowf[j] * colf[nn]) : 0.f;
        Ps[i * 72 + jj] = f2bf(pv);
      }
    f32x4 a1[4], a2[4];
#pragma unroll
    for (int nn = 0; nn < 4; ++nn) { a1[nn] = f32x4{0.f, 0.f, 0.f, 0.f}; a2[nn] = f32x4{0.f, 0.f, 0.f, 0.f}; }
    wave_mma<4, 2>(Ps, 72, wv * 16, Vt, 72, 0, a1, lane);
    wave_mma<4, 2>(Qs, 72, wv * 16, St, 72, 0, a2, lane);
#pragma unroll
    for (int j = 0; j < 4; ++j)
#pragma unroll
      for (int nn = 0; nn < 4; ++nn) Os[(wv * 16 + q * 4 + j) * 68 + nn * 16 + r] = a1[nn][j] + qdf[j] * a2[nn][j];
#pragma unroll
    for (int nn = 0; nn < 4; ++nn)
#pragma unroll
      for (int j = 0; j < 4; ++j) accS[nn][j] *= cdec;
    wave_mma<4, 2>(Vt, 72, wv * 16, Kdt, 72, 0, accS, lane);
    lds_barrier();
#pragma unroll
    for (int nn = 0; nn < 4; ++nn)
#pragma unroll
      for (int j = 0; j < 4; ++j) St[(wv * 16 + q * 4 + j) * 72 + nn * 16 + r] = f2bf(accS[nn][j]);
  }
  {
    const int pp = (N - 1) * 64 + erow;
    ret_rowwise(Os, RO, base + (dir ? len - 1 - pp : pp), h, ct, true, f0, f1, f2, f3, rw);
  }
  if (!g2) {
#pragma unroll
    for (int nn = 0; nn < 4; ++nn)
#pragma unroll
      for (int j = 0; j < 4; ++j)
        p.out[OSR + (((((size_t)s * 2 + l) * 2 + dir) * 8 + h) * 64 + (nn * 16 + r)) * 64 + (wv * 16 + q * 4 + j)] = accS[nn][j];
  }
  __syncthreads();
}

constexpr int ATT_X1 = 320;
DI void phase_mix1(const Params& p, int l, u16* smem, int* s_item, int tid) {
  int* ctr = (int*)(p.ws + WS_CTR) + l * 4;
  while (true) {
    if (tid == 0) *s_item = atomicAdd(ctr, 1);
    __syncthreads();
    const int it = *s_item;
    __syncthreads();
    if (it >= 64 + ATT_X1 + 512) break;
    int kind, s, h, qt = 0;
    if (it < 64) { kind = 0; s = 32 + (it >> 3); h = it & 7; }
    else if (it < 64 + ATT_X1) { int a = it - 64; kind = 1; s = 32 + (a >> 7); h = (a >> 4) & 7; qt = a & 15; }
    else if (it < 64 + ATT_X1 + 256) { int a = it - 64 - ATT_X1; kind = 0; s = a >> 3; h = a & 7; }
    else { int a = it - 64 - ATT_X1 - 256; kind = 1; s = a >> 3; h = a & 7; }
#ifdef PROBE_MAX
    unsigned long long tb_ = wall_clock64();
#endif
    if (kind == 0) ret_item(p, l, s, h, smem, tid);
    else attn_item(p, s, h, qt, smem, tid);
#ifdef PROBE_MAX
    if (tid == 0 && kind == (PROBE_MAX)) atomicMax((int*)(p.ws + WS_CTR) + 32 + l, (int)(wall_clock64() - tb_));
#endif
  }
}

DI void dn_pre_item(const Params& p, int l, int cgk, int h, u16* smem, int tid) {
  const int lane = tid & 63, w = tid >> 6, r = lane & 15, q = lane >> 4;
  u16* Ks = smem;
  float* sKK = (float*)(smem + 64 * 136);
  float* sA = sKK + 64 * 65;
  float* sX = sA + 2 * 4096;
  float* sg = sX + 2 * 64 * 68;
  float* sb = sg + 128;
  float* sG = sb + 128;
  const int t0 = cgk * 64;
  const int s = t0 < TI ? (t0 >> 8) : 32 + ((t0 - TI) >> 12);
  const int base = seq_base(s), len = seq_len(s);
  const u16* HALO = (const u16*)(p.ws + WS_HALO);
  float pre_da = 0.f, pre_db = 0.f;
  if (tid < 128) {
    const int dir_ = tid >> 6, i_ = tid & 63;
    const int t_ = t0 + (dir_ ? 63 - i_ : i_);
    const float* DAB_ = (const float*)(p.ws + WS_DAB);
    pre_da = DAB_[(size_t)t_ * 16 + dir_ * 4 + h]; pre_db = DAB_[(size_t)t_ * 16 + 8 + dir_ * 4 + h];
  }
  {
    const int rr = tid >> 3, cseg = tid & 7;
    const int t = t0 + rr;
    const int col0 = h * 128 + cseg * 16;
    unsigned res[3][8];
#pragma unroll
    for (int xi = 0; xi < 3; ++xi) {
      const u16* X = ws_slab(p, 2 + xi);
      uint4 c0 = *(const uint4*)(X + (size_t)t * 512 + col0), c1 = *(const uint4*)(X + (size_t)t * 512 + col0 + 8);
      uint4 p0 = uint4{0, 0, 0, 0}, p1 = p0, n0 = p0, n1 = p0;
      if (t > base) {
        const u16* src = (rr > 0) ? X + (size_t)(t - 1) * 512 + col0 : HALO + ((size_t)(cgk - 1) * 2 + 1) * 1536 + xi * 512 + col0;
        p0 = *(const uint4*)src; p1 = *(const uint4*)(src + 8);
      }
      if (t + 1 < base + len) {
        const u16* src = (rr < 63) ? X + (size_t)(t + 1) * 512 + col0 : HALO + ((size_t)(cgk + 1) * 2 + 0) * 1536 + xi * 512 + col0;
        n0 = *(const uint4*)src; n1 = *(const uint4*)(src + 8);
      }
      const float* cw = p.k.in[18] + (size_t)l * 3 * 1536 + xi * 512 + col0;
      unsigned cu[8] = {c0.x, c0.y, c0.z, c0.w, c1.x, c1.y, c1.z, c1.w};
      unsigned pu[8] = {p0.x, p0.y, p0.z, p0.w, p1.x, p1.y, p1.z, p1.w};
      unsigned nu[8] = {n0.x, n0.y, n0.z, n0.w, n1.x, n1.y, n1.z, n1.w};
      float y[16];
      float ss = 0.f;
#pragma unroll
      for (int e = 0; e < 8; ++e) {
        float a0 = cw[2 * e] * bflo(pu[e]) + cw[1536 + 2 * e] * bflo(cu[e]) + cw[3072 + 2 * e] * bflo(nu[e]);
        float a1 = cw[2 * e + 1] * bfhi(pu[e]) + cw[1536 + 2 * e + 1] * bfhi(cu[e]) + cw[3072 + 2 * e + 1] * bfhi(nu[e]);
        a0 = silu_f(a0); a1 = silu_f(a1);
        y[2 * e] = a0; y[2 * e + 1] = a1;
        ss += a0 * a0 + a1 * a1;
      }
      if (xi < 2) {
        ss += __shfl_xor(ss, 1); ss += __shfl_xor(ss, 2); ss += __shfl_xor(ss, 4);
        float rn = rsqrtf(ss + EPSF) * (xi == 0 ? 0.08838834764831845f : 1.f);
#pragma unroll
        for (int e = 0; e < 16; ++e) y[e] *= rn;
      }
#pragma unroll
      for (int e = 0; e < 8; ++e) res[xi][e] = cvtpk(y[2 * e], y[2 * e + 1]);
    }
    *(uint4*)(Ks + rr * 136 + cseg * 16) = uint4{res[1][0], res[1][1], res[1][2], res[1][3]};
    *(uint4*)(Ks + rr * 136 + cseg * 16 + 8) = uint4{res[1][4], res[1][5], res[1][6], res[1][7]};
    __syncthreads();
#pragma unroll
    for (int xi = 0; xi < 3; ++xi) {
      u16* X = ws_slab(p, 2 + xi);
      *(uint4*)(X + (size_t)t * 512 + col0) = uint4{res[xi][0], res[xi][1], res[xi][2], res[xi][3]};
      *(uint4*)(X + (size_t)t * 512 + col0 + 8) = uint4{res[xi][4], res[xi][5], res[xi][6], res[xi][7]};
    }
  }
  const float* DAB = (const float*)(p.ws + WS_DAB);
  float* GBG = (float*)(p.ws + WS_GBG);
  float* GBB = (float*)(p.ws + WS_GBB);
  if (tid < 128) {
    int dir = tid >> 6, i = tid & 63;
    int t = t0 + (dir ? 63 - i : i);
    float da = pre_da, db = pre_db;
    float x = da + p.k.in[20][l * 8 + dir * 4 + h];
    float sp = (x > 20.f) ? x : log1pf(expf(x));
    sg[tid] = -expf(p.k.in[19][l * 8 + dir * 4 + h]) * sp;
    sb[tid] = 1.f / (1.f + expf(-db));
  }
  lds_barrier();
  if (tid < 128) {
    float x = sg[tid];
#pragma unroll
    for (int o = 1; o < 64; o <<= 1) { float y = __shfl_up(x, o); if ((tid & 63) >= o) x += y; }
    sG[tid] = x;
  }
  {
    f32x4 kk[2];
    kk[0] = f32x4{0.f, 0.f, 0.f, 0.f}; kk[1] = kk[0];
    wave_mma<2, 4>(Ks, 136, (w >> 1) * 16, Ks, 136, (w & 1) * 32, kk, lane);
#pragma unroll
    for (int nn = 0; nn < 2; ++nn)
#pragma unroll
      for (int j = 0; j < 4; ++j) sKK[((w >> 1) * 16 + q * 4 + j) * 65 + (w & 1) * 32 + nn * 16 + r] = kk[nn][j];
  }
  lds_barrier();
  if (tid < 128) {
    int dir = tid >> 6, i = tid & 63;
    int t = t0 + (dir ? 63 - i : i);
    GBG[(size_t)t * 8 + dir * 4 + h] = sG[tid];
    GBB[(size_t)t * 8 + dir * 4 + h] = sb[tid];
  }
  for (int idx = tid; idx < 2 * 4096; idx += NTHREADS) {
    int dir = idx >> 12, i = (idx >> 6) & 63, j = idx & 63;
    int ri = dir ? 63 - i : i, rj = dir ? 63 - j : j;
    float a = 0.f;
    if (i > j) a = sb[dir * 64 + i] * sKK[ri * 65 + rj] * __expf(sG[dir * 64 + i] - sG[dir * 64 + j]);
    sA[idx] = a;
  }
  lds_barrier();
  {
    const int dir = tid >> 8, c = (tid >> 2) & 63, sl = tid & 3;
    const float* ar = sA + dir * 4096 + sl * 16;
    float x[16];
#pragma unroll
    for (int jj = 0; jj < 16; ++jj) x[jj] = (sl * 16 + jj == c) ? 1.f : 0.f;
    float4 an[4];
#pragma unroll
    for (int k = 0; k < 4; ++k) an[k] = *(const float4*)(ar + 64 + 4 * k);
    int ro = 64;
#pragma unroll
    for (int i = 1; i < 64; ++i) {
      float4 a4[4];
#pragma unroll
      for (int k = 0; k < 4; ++k) a4[k] = an[k];
      if (i + 1 < 64) {
        ro += 64;
        asm volatile("" : "+v"(ro));
#pragma unroll
        for (int k = 0; k < 4; ++k) an[k] = *(const float4*)(ar + ro + 4 * k);
      }
      __builtin_amdgcn_sched_barrier(0);
      float s0 = 0.f, s1 = 0.f;
#pragma unroll
      for (int k = 0; k < 4; ++k) {
        s0 += a4[k].x * x[4 * k] + a4[k].z * x[4 * k + 2];
        s1 += a4[k].y * x[4 * k + 1] + a4[k].w * x[4 * k + 3];
      }
      float tot = s0 + s1;
      tot += __builtin_bit_cast(float, __builtin_amdgcn_update_dpp(0, __builtin_bit_cast(int, tot), 0xB1, 0xF, 0xF, false));
      tot += __builtin_bit_cast(float, __builtin_amdgcn_update_dpp(0, __builtin_bit_cast(int, tot), 0x4E, 0xF, 0xF, false));
      x[i & 15] = (sl == (i >> 4)) ? x[i & 15] - tot : x[i & 15];
      __builtin_amdgcn_sched_barrier(0);
    }
    u16* TM = ws_slab(p, 5) + (((size_t)cgk * 4 + h) * 2 + dir) * 4096 + (size_t)(sl * 16) * 64 + c;
#pragma unroll
    for (int jj = 0; jj < 16; ++jj) TM[jj * 64] = f2bf(x[jj]);
  }
  lds_barrier();
}

DI void phase_dn_pre(const Params& p, int l, u16* smem, int tid, int bid, int nblk) {
  for (int it = bid; it < 640 * 4; it += nblk) dn_pre_item(p, l, it >> 2, it & 3, smem, tid);
}

DI void dn_scan_item(const Params& p, int l, int s, int h, int dir, u16* smem, int tid) {
  const int lane = tid & 63, w = tid >> 6, r = lane & 15, q = lane >> 4;
  u16* Qs = smem;
  u16* Ks = Qs + 8704;
  u16* Kdt = Ks + 8704;
  u16* Rt = Kdt + 9216;
  u16* Vnt = Rt + 9216;
  u16* St = Vnt + 9216;
  u16* Tms = St + 17408;
  u16* Atm = Tms + 4608;
  float* sG = (float*)(Atm + 4608);
  float* sB = sG + 64;
  float* sEG = sB + 64;
  u16* Os = (u16*)(sEG + 64);
  const int base = seq_base(s), len = seq_len(s), N = len >> 6;
  const bool g2 = s >= 32;
  const u16* DQ = ws_slab(p, 2); const u16* DK = ws_slab(p, 3); const u16* DV = ws_slab(p, 4);
  const u16* TM = ws_slab(p, 5);
  u16* OUT = ws_slab(p, dir ? 8 : 6);
  const float* GBG = (const float*)(p.ws + WS_GBG);
  const float* GBB = (const float*)(p.ws + WS_GBB);
  const int mP = w >> 1, nP0 = (w & 1) * 4;
  f32x4 ST[8];
#pragma unroll
  for (int n = 0; n < 8; ++n)
#pragma unroll
    for (int j = 0; j < 4; ++j) {
      float v0 = 0.f;
      if (g2) v0 = p.k.in[5][(((((size_t)(s - 32) * 2 + l) * 2 + dir) * 4 + h) * 128 + (n * 16 + r)) * 128 + (w * 16 + q * 4 + j)];
      ST[n][j] = v0;
      St[(w * 16 + q * 4 + j) * 136 + n * 16 + r] = f2bf(v0);
    }
  uint4 pq0, pq1, pk0, pk1, pv0, pv1, ptm;
  float pgrow, pglast, pbeta;
  {
    const int cg0 = (base >> 6) + (dir ? N - 1 : 0);
    const int t = base + (dir ? len - 1 - lane : lane);
    const int tlast = base + (dir ? len - 1 - 63 : 63);
    const size_t off = (size_t)t * 512 + h * 128 + w * 16;
    pq0 = *(const uint4*)(DQ + off); pq1 = *(const uint4*)(DQ + off + 8);
    pk0 = *(const uint4*)(DK + off); pk1 = *(const uint4*)(DK + off + 8);
    pv0 = *(const uint4*)(DV + off); pv1 = *(const uint4*)(DV + off + 8);
    ptm = *(const uint4*)(TM + (((size_t)cg0 * 4 + h) * 2 + dir) * 4096 + lane * 64 + w * 8);
    pgrow = GBG[(size_t)t * 8 + dir * 4 + h]; pglast = GBG[(size_t)tlast * 8 + dir * 4 + h]; pbeta = GBB[(size_t)t * 8 + dir * 4 + h];
  }
  const int orow = tid >> 3, oseg = tid & 7;
  for (int n = 0; n < N; ++n) {
    if (n > 0) {
      const int pp = (n - 1) * 64 + orow;
      const int t = base + (dir ? len - 1 - pp : pp);
      const uint4 o0 = *(const uint4*)(Os + orow * 136 + oseg * 16), o1 = *(const uint4*)(Os + orow * 136 + oseg * 16 + 8);
      *(uint4*)(OUT + (size_t)t * 512 + h * 128 + oseg * 16) = o0;
      *(uint4*)(OUT + (size_t)t * 512 + h * 128 + oseg * 16 + 8) = o1;
    }
    {
      const int row = lane, seg = w;
      *(uint4*)(Qs + row * 136 + seg * 16) = pq0; *(uint4*)(Qs + row * 136 + seg * 16 + 8) = pq1;
      *(uint4*)(Ks + row * 136 + seg * 16) = pk0; *(uint4*)(Ks + row * 136 + seg * 16 + 8) = pk1;
      const float kd = __expf(pglast - pgrow);
      unsigned ku[8] = {pk0.x, pk0.y, pk0.z, pk0.w, pk1.x, pk1.y, pk1.z, pk1.w};
      unsigned vu[8] = {pv0.x, pv0.y, pv0.z, pv0.w, pv1.x, pv1.y, pv1.z, pv1.w};
#pragma unroll
      for (int e = 0; e < 8; ++e) {
        Kdt[(seg * 16 + 2 * e) * 72 + row] = f2bf(bflo(ku[e]) * kd);
        Kdt[(seg * 16 + 2 * e + 1) * 72 + row] = f2bf(bfhi(ku[e]) * kd);
        Rt[(seg * 16 + 2 * e) * 72 + row] = (u16)(vu[e] & 0xffffu);
        Rt[(seg * 16 + 2 * e + 1) * 72 + row] = (u16)(vu[e] >> 16);
      }
      *(uint4*)(Tms + row * 72 + seg * 8) = ptm;
      if (w == 0) { sG[lane] = pgrow; sEG[lane] = __expf(pgrow); sB[lane] = pbeta; }
      if (n + 1 < N) {
        const int cgn = (base >> 6) + (dir ? N - 2 - n : n + 1);
        const int pp = (n + 1) * 64 + lane;
        const int t = base + (dir ? len - 1 - pp : pp);
        const int tlast = base + (dir ? len - 1 - ((n + 1) * 64 + 63) : (n + 1) * 64 + 63);
        const size_t off = (size_t)t * 512 + h * 128 + w * 16;
        pq0 = *(const uint4*)(DQ + off); pq1 = *(const uint4*)(DQ + off + 8);
        pk0 = *(const uint4*)(DK + off); pk1 = *(const uint4*)(DK + off + 8);
        pv0 = *(const uint4*)(DV + off); pv1 = *(const uint4*)(DV + off + 8);
        ptm = *(const uint4*)(TM + (((size_t)cgn * 4 + h) * 2 + dir) * 4096 + lane * 64 + w * 8);
        pgrow = GBG[(size_t)t * 8 + dir * 4 + h]; pglast = GBG[(size_t)tlast * 8 + dir * 4 + h]; pbeta = GBB[(size_t)t * 8 + dir * 4 + h];
      }
    }
    lds_barrier();
    f32x4 p1[4], qs[4], at[2];
#pragma unroll
    for (int nn = 0; nn < 4; ++nn) { p1[nn] = f32x4{0.f, 0.f, 0.f, 0.f}; qs[nn] = p1[nn]; }
    at[0] = f32x4{0.f, 0.f, 0.f, 0.f}; at[1] = at[0];
    wave_mma<4, 4>(Ks, 136, mP * 16, St, 136, nP0 * 16, p1, lane);
    wave_mma<4, 4>(Qs, 136, mP * 16, St, 136, nP0 * 16, qs, lane);
    wave_mma<2, 4>(Qs, 136, mP * 16, Ks, 136, (w & 1) * 32, at, lane);
    const int i0 = mP * 16 + q * 4;
    float bi[4], egi[4], gi[4];
#pragma unroll
    for (int j = 0; j < 4; ++j) { bi[j] = sB[i0 + j]; egi[j] = sEG[i0 + j]; gi[j] = sG[i0 + j]; }
#pragma unroll
    for (int nn = 0; nn < 4; ++nn) {
      const int v = (nP0 + nn) * 16 + r;
      uint2 raw = *(const uint2*)(Rt + v * 72 + i0);
      float f0 = bi[0] * (bflo(raw.x) - egi[0] * p1[nn][0]);
      float f1 = bi[1] * (bfhi(raw.x) - egi[1] * p1[nn][1]);
      float f2 = bi[2] * (bflo(raw.y) - egi[2] * p1[nn][2]);
      float f3 = bi[3] * (bfhi(raw.y) - egi[3] * p1[nn][3]);
      *(uint2*)(Rt + v * 72 + i0) = uint2{cvtpk(f0, f1), cvtpk(f2, f3)};
    }
#pragma unroll
    for (int nn = 0; nn < 2; ++nn) {
      const int jj = (w & 1) * 32 + nn * 16 + r;
      const float gj = sG[jj];
#pragma unroll
      for (int j = 0; j < 4; ++j) {
        int i = i0 + j;
        float val = (i >= jj) ? at[nn][j] * __expf(gi[j] - gj) : 0.f;
        Atm[i * 72 + jj] = f2bf(val);
      }
    }
    lds_barrier();
    f32x4 vn[4];
#pragma unroll
    for (int nn = 0; nn < 4; ++nn) vn[nn] = f32x4{0.f, 0.f, 0.f, 0.f};
    wave_mma<4, 2>(Tms, 72, mP * 16, Rt, 72, nP0 * 16, vn, lane);
#pragma unroll
    for (int nn = 0; nn < 4; ++nn) {
      const int v = (nP0 + nn) * 16 + r;
      *(uint2*)(Vnt + v * 72 + i0) = uint2{cvtpk(vn[nn][0], vn[nn][1]), cvtpk(vn[nn][2], vn[nn][3])};
    }
    lds_barrier();
#pragma unroll
    for (int nn = 0; nn < 4; ++nn)
#pragma unroll
      for (int j = 0; j < 4; ++j) qs[nn][j] *= egi[j];
    wave_mma<4, 2>(Atm, 72, mP * 16, Vnt, 72, nP0 * 16, qs, lane);
#pragma unroll
    for (int j = 0; j < 4; ++j)
#pragma unroll
      for (int nn = 0; nn < 4; ++nn) Os[(i0 + j) * 136 + (nP0 + nn) * 16 + r] = f2bf(qs[nn][j]);
    const float egl = sEG[63];
#pragma unroll
    for (int n8 = 0; n8 < 8; ++n8)
#pragma unroll
      for (int j = 0; j < 4; ++j) ST[n8][j] *= egl;
    wave_mma<8, 2>(Vnt, 72, w * 16, Kdt, 72, 0, ST, lane);
#pragma unroll
    for (int n8 = 0; n8 < 8; ++n8)
#pragma unroll
      for (int j = 0; j < 4; ++j) St[(w * 16 + q * 4 + j) * 136 + n8 * 16 + r] = f2bf(ST[n8][j]);
    lds_barrier();
  }
  {
    const int pp = (N - 1) * 64 + orow;
    const int t = base + (dir ? len - 1 - pp : pp);
    const uint4 o0 = *(const uint4*)(Os + orow * 136 + oseg * 16), o1 = *(const uint4*)(Os + orow * 136 + oseg * 16 + 8);
    *(uint4*)(OUT + (size_t)t * 512 + h * 128 + oseg * 16) = o0;
    *(uint4*)(OUT + (size_t)t * 512 + h * 128 + oseg * 16 + 8) = o1;
  }
  if (!g2) {
#pragma unroll
    for (int n8 = 0; n8 < 8; ++n8)
#pragma unroll
      for (int j = 0; j < 4; ++j)
        p.out[OSD + (((((size_t)s * 2 + l) * 2 + dir) * 4 + h) * 128 + (n8 * 16 + r)) * 128 + (w * 16 + q * 4 + j)] = ST[n8][j];
  }
  __syncthreads();
}

DI void phase_mix2(const Params& p, int l, u16* smem, int* s_item, int tid) {
  int* ctr = (int*)(p.ws + WS_CTR) + l * 4 + 1;
  constexpr int NA2 = 1024 - ATT_X1;
  while (true) {
    if (tid == 0) *s_item = atomicAdd(ctr, 1);
    __syncthreads();
    const int it = *s_item;
    __syncthreads();
    if (it >= 64 + NA2 + 256) break;
    if (it >= 64 && it < 64 + NA2) {
      const int a = it - 64 + ATT_X1;
#ifdef PROBE_MAX
      unsigned long long tb_ = wall_clock64();
#endif
      attn_item(p, 32 + (a >> 7), (a >> 4) & 7, a & 15, smem, tid);
#ifdef PROBE_MAX
      if (tid == 0 && (PROBE_MAX) == 3) atomicMax((int*)(p.ws + WS_CTR) + 32 + l, (int)(wall_clock64() - tb_));
#endif
    } else {
      const int a = (it < 64) ? it : it - 64 - NA2;
#ifdef PROBE_MAX
      unsigned long long tb_ = wall_clock64();
#endif
      dn_scan_item(p, l, (it < 64 ? 32 : 0) + (a >> 3), (a >> 1) & 3, a & 1, smem, tid);
#ifdef PROBE_MAX
      if (tid == 0 && (PROBE_MAX) == 2) atomicMax((int*)(p.ws + WS_CTR) + 32 + l, (int)(wall_clock64() - tb_));
#endif
    }
  }
}

DI void phase_dn_post(const Params& p, int l, int tid, int bid, int nblk) {
  const int lane = tid & 63;
  const int gw = bid * 8 + (tid >> 6), nw = nblk * 8;
  const u16* OF = ws_slab(p, 6); const u16* OB = ws_slab(p, 8); const u16* DG = ws_slab(p, 5); u16* DO = ws_slab(p, 2);
  const float* nwp = p.k.in[21] + l * 128 + (lane & 15) * 8;
  float nwv[8];
#pragma unroll
  for (int e = 0; e < 8; ++e) nwv[e] = nwp[e];
  for (int t0 = gw; t0 < TT; t0 += 4 * nw) {
    uint4 a[4], b[4], g[4];
#pragma unroll
    for (int u = 0; u < 4; ++u) {
      const int t = (t0 + u * nw < TT) ? t0 + u * nw : t0;
      const size_t off = (size_t)t * 512 + lane * 8;
      a[u] = *(const uint4*)(OF + off); b[u] = *(const uint4*)(OB + off); g[u] = *(const uint4*)(DG + off);
    }
#pragma unroll
    for (int u = 0; u < 4; ++u) {
      const int t = t0 + u * nw;
      if (t >= TT) break;
      const unsigned au[4] = {a[u].x, a[u].y, a[u].z, a[u].w}, bu[4] = {b[u].x, b[u].y, b[u].z, b[u].w}, gu[4] = {g[u].x, g[u].y, g[u].z, g[u].w};
      float y[8];
      float ss = 0.f;
#pragma unroll
      for (int e = 0; e < 4; ++e) {
        y[2 * e] = bflo(au[e]) + bflo(bu[e]); y[2 * e + 1] = bfhi(au[e]) + bfhi(bu[e]);
        ss += y[2 * e] * y[2 * e] + y[2 * e + 1] * y[2 * e + 1];
      }
      const float rn = rsqrtf(sum16(ss) * (1.f / 128.f) + EPSF);
      unsigned o[4];
#pragma unroll
      for (int e = 0; e < 4; ++e) {
        float y0 = y[2 * e] * rn * nwv[2 * e] * silu_f(bflo(gu[e]));
        float y1 = y[2 * e + 1] * rn * nwv[2 * e + 1] * silu_f(bfhi(gu[e]));
        o[e] = cvtpk(y0, y1);
      }
      *(uint4*)(DO + (size_t)t * 512 + lane * 8) = uint4{o[0], o[1], o[2], o[3]};
    }
  }
}

DI void fast_grid_sync(unsigned* bar, unsigned target) {
  __syncthreads();
  if (threadIdx.x == 0) {
    __builtin_amdgcn_fence(__ATOMIC_RELEASE, "agent");
    asm volatile("s_waitcnt vmcnt(0)" ::: "memory");
    __hip_atomic_fetch_add(bar, 1u, __ATOMIC_RELAXED, __HIP_MEMORY_SCOPE_AGENT);
    while (__hip_atomic_load(bar, __ATOMIC_RELAXED, __HIP_MEMORY_SCOPE_AGENT) < target) __builtin_amdgcn_s_sleep(1);
    __builtin_amdgcn_fence(__ATOMIC_ACQUIRE, "agent");
    asm volatile("s_waitcnt vmcnt(0)" ::: "memory");
  }
  __syncthreads();
}

#define PHASE_BEGIN int t_ = tid, b_ = bid, l_ = l; size_t z_ = 0; \
  asm volatile("" : "+v"(t_)); asm volatile("" : "+s"(b_)); asm volatile("" : "+s"(l_)); asm volatile("" : "+s"(z_)); \
  unsigned char* w_ = kp.ws + z_; float* o_ = kp.out + z_; \
  Params q{kp, o_, w_};

__global__ void __launch_bounds__(NTHREADS) trunk_megakernel(KParams kp) {
  extern __shared__ __attribute__((aligned(16))) unsigned char dyn_lds[];
  u16* smem = (u16*)dyn_lds;
  int* s_item_p = (int*)(dyn_lds + LDS_WORK);
#ifdef PROBE_SEG
  if (threadIdx.x == 0) *(unsigned long long*)(dyn_lds + 147456 + 8) = 0ull;
  __syncthreads();
#endif
#ifdef PROBE_ITEM
  if (threadIdx.x == 0) *(unsigned long long*)(s_item_p + 2) = 0ull;
  __syncthreads();
#endif
  cg::grid_group grid = cg::this_grid();
  const int tid = threadIdx.x, bid = blockIdx.x, nblk = gridDim.x;
#ifdef TMASK
  unsigned long long tacc = 0, tprev = wall_clock64();
#endif
  { const int l = 0; PHASE_BEGIN phase_mods(q, smem, t_, b_, nblk); }
  grid.sync();
#pragma unroll 1
  for (int l = 0; l < 2; ++l) {
    if (PH(0)) { PHASE_BEGIN phase_convert(q, l_, smem, t_, b_, nblk); }
#ifdef TMASK
    { unsigned long long tn = wall_clock64(); if ((TMASK >> 0) & 1u) tacc += tn - tprev; tprev = tn; }
#endif
    if (PH(1)) { PHASE_BEGIN phase_norm(q, l_, 0, l_ == 0, t_, b_, nblk); }
    fast_grid_sync((unsigned*)(kp.ws + WS_BAR), (unsigned)(l * 18 + 1) * (unsigned)nblk);
#ifdef TMASK
    { unsigned long long tn = wall_clock64(); if ((TMASK >> 1) & 1u) tacc += tn - tprev; tprev = tn; }
#endif
    if (PH(2)) { PHASE_BEGIN phase_g1(q, 0, smem, t_, b_); }
    fast_grid_sync((unsigned*)(kp.ws + WS_BAR), (unsigned)(l * 18 + 2) * (unsigned)nblk);
    if (PH(3)) { PHASE_BEGIN phase_g2(q, l_, 0, l_ == 0, smem, t_, b_); }
    fast_grid_sync((unsigned*)(kp.ws + WS_BAR), (unsigned)(l * 18 + 3) * (unsigned)nblk);
#ifdef TMASK
    { unsigned long long tn = wall_clock64(); if ((TMASK >> 3) & 1u) tacc += tn - tprev; tprev = tn; }
#endif
    if (PH(4)) { PHASE_BEGIN phase_norm(q, l_, 1, false, t_, b_, nblk); }
    fast_grid_sync((unsigned*)(kp.ws + WS_BAR), (unsigned)(l * 18 + 4) * (unsigned)nblk);
#ifdef TMASK
    { unsigned long long tn = wall_clock64(); if ((TMASK >> 4) & 1u) tacc += tn - tprev; tprev = tn; }
#endif
    if (PH(5)) { PHASE_BEGIN phase_g3a(q, smem, t_, b_); }
    fast_grid_sync((unsigned*)(kp.ws + WS_BAR), (unsigned)(l * 18 + 5) * (unsigned)nblk);
#ifdef TMASK
    { unsigned long long tn = wall_clock64(); if ((TMASK >> 5) & 1u) tacc += tn - tprev; tprev = tn; }
#endif
    if (PH(6)) { PHASE_BEGIN phase_prep(q, l_, t_, b_, nblk); }
    fast_grid_sync((unsigned*)(kp.ws + WS_BAR), (unsigned)(l * 18 + 6) * (unsigned)nblk);
#ifdef TMASK
    { unsigned long long tn = wall_clock64(); if ((TMASK >> 6) & 1u) tacc += tn - tprev; tprev = tn; }
#endif
    if (PH(7)) { PHASE_BEGIN phase_mix1(q, l_, smem, s_item_p, t_); }
    fast_grid_sync((unsigned*)(kp.ws + WS_BAR), (unsigned)(l * 18 + 7) * (unsigned)nblk);
#ifdef TMASK
    { unsigned long long tn = wall_clock64(); if ((TMASK >> 7) & 1u) tacc += tn - tprev; tprev = tn; }
#endif
    if (PH(8)) { PHASE_BEGIN phase_g3b(q, smem, t_, b_); }
    fast_grid_sync((unsigned*)(kp.ws + WS_BAR), (unsigned)(l * 18 + 8) * (unsigned)nblk);
#ifdef TMASK
    { unsigned long long tn = wall_clock64(); if ((TMASK >> 8) & 1u) tacc += tn - tprev; tprev = tn; }
#endif
    if (PH(9)) { PHASE_BEGIN phase_dn_pre(q, l_, smem, t_, b_, nblk); }
    fast_grid_sync((unsigned*)(kp.ws + WS_BAR), (unsigned)(l * 18 + 9) * (unsigned)nblk);
#ifdef TMASK
    { unsigned long long tn = wall_clock64(); if ((TMASK >> 9) & 1u) tacc += tn - tprev; tprev = tn; }
#endif
    if (PH(10)) { PHASE_BEGIN phase_mix2(q, l_, smem, s_item_p, t_); }
    fast_grid_sync((unsigned*)(kp.ws + WS_BAR), (unsigned)(l * 18 + 10) * (unsigned)nblk);
#ifdef TMASK
    { unsigned long long tn = wall_clock64(); if ((TMASK >> 10) & 1u) tacc += tn - tprev; tprev = tn; }
#endif
    if (PH(18)) { PHASE_BEGIN phase_g3c(q, smem, t_, b_); }
    fast_grid_sync((unsigned*)(kp.ws + WS_BAR), (unsigned)(l * 18 + 11) * (unsigned)nblk);
#ifdef TMASK
    { unsigned long long tn = wall_clock64(); if ((TMASK >> 18) & 1u) tacc += tn - tprev; tprev = tn; }
#endif
    if (PH(11)) { PHASE_BEGIN phase_dn_post(q, l_, t_, b_, nblk); }
    fast_grid_sync((unsigned*)(kp.ws + WS_BAR), (unsigned)(l * 18 + 12) * (unsigned)nblk);
#ifdef TMASK
    { unsigned long long tn = wall_clock64(); if ((TMASK >> 11) & 1u) tacc += tn - tprev; tprev = tn; }
#endif
    if (PH(12)) { PHASE_BEGIN phase_mg(q, smem, t_, b_); }
    fast_grid_sync((unsigned*)(kp.ws + WS_BAR), (unsigned)(l * 18 + 13) * (unsigned)nblk);
    if (PH(12)) { PHASE_BEGIN
#pragma unroll 1
      for (int b = 0; b < 3; ++b) { int bb = b; asm volatile("" : "+s"(bb)); phase_br(q, bb, smem, t_, b_); } }
    fast_grid_sync((unsigned*)(kp.ws + WS_BAR), (unsigned)(l * 18 + 14) * (unsigned)nblk);
#ifdef TMASK
    { unsigned long long tn = wall_clock64(); if ((TMASK >> 12) & 1u) tacc += tn - tprev; tprev = tn; }
#endif
    if (PH(13)) { PHASE_BEGIN phase_g5(q, l_, smem, t_, b_); }
    fast_grid_sync((unsigned*)(kp.ws + WS_BAR), (unsigned)(l * 18 + 15) * (unsigned)nblk);
#ifdef TMASK
    { unsigned long long tn = wall_clock64(); if ((TMASK >> 13) & 1u) tacc += tn - tprev; tprev = tn; }
#endif
    if (PH(14)) { PHASE_BEGIN phase_norm(q, l_, 2, false, t_, b_, nblk); }
    fast_grid_sync((unsigned*)(kp.ws + WS_BAR), (unsigned)(l * 18 + 16) * (unsigned)nblk);
#ifdef TMASK
    { unsigned long long tn = wall_clock64(); if ((TMASK >> 14) & 1u) tacc += tn - tprev; tprev = tn; }
#endif
    if (PH(15)) { PHASE_BEGIN phase_g1(q, 1, smem, t_, b_); }
    fast_grid_sync((unsigned*)(kp.ws + WS_BAR), (unsigned)(l * 18 + 17) * (unsigned)nblk);
#ifdef TMASK
    { unsigned long long tn = wall_clock64(); if ((TMASK >> 15) & 1u) tacc += tn - tprev; tprev = tn; }
#endif
    if (PH(16)) { PHASE_BEGIN phase_g2(q, l_, 1, false, smem, t_, b_); }
    fast_grid_sync((unsigned*)(kp.ws + WS_BAR), (unsigned)(l * 18 + 18) * (unsigned)nblk);
#ifdef TMASK
    { unsigned long long tn = wall_clock64(); if ((TMASK >> 16) & 1u) tacc += tn - tprev; tprev = tn; }
#endif
  }
  if (PH(17)) { Params q{kp, kp.out, kp.ws}; phase_final_norm(q, tid, bid, nblk); }
#ifdef PROBE_MAX
  if (bid == 0 && tid == 0) { int* c_ = (int*)(kp.ws + WS_CTR) + 32; unsigned long long ta = (unsigned long long)(__hip_atomic_load(c_, __ATOMIC_RELAXED, __HIP_MEMORY_SCOPE_AGENT) + __hip_atomic_load(c_ + 1, __ATOMIC_RELAXED, __HIP_MEMORY_SCOPE_AGENT)); unsigned long long te = wall_clock64(); while (wall_clock64() - te < ta) { __builtin_amdgcn_s_sleep(8); } }
#endif
#ifdef PROBE_SEG
  if (tid == 0) { unsigned long long ta = *(unsigned long long*)(dyn_lds + 147456 + 8); unsigned long long te = wall_clock64(); while (wall_clock64() - te < ta) { __builtin_amdgcn_s_sleep(8); } }
#endif
#ifdef PROBE_ITEM
  if (bid == nblk - 1 && tid == 0) { unsigned long long ta = *(unsigned long long*)(s_item_p + 2); unsigned long long te = wall_clock64(); while (wall_clock64() - te < ta) { __builtin_amdgcn_s_sleep(8); } }
#endif
#ifdef TMASK
  if (bid == 0) { unsigned long long te = wall_clock64(); while (wall_clock64() - te < tacc) { __builtin_amdgcn_s_sleep(8); } }
#endif
}

extern "C" void kernel_launch(void* const* d_in, const int* in_sizes, int n_in, void* d_out, int out_size, void* d_ws, size_t ws_size,
                              hipStream_t stream) {
  static int grid_blocks = 0;
  if (!grid_blocks) {
    int dev = 0, cus = 0, per_cu = 0;
    hipGetDevice(&dev);
    hipDeviceGetAttribute(&cus, hipDeviceAttributeMultiprocessorCount, dev);
    hipFuncSetAttribute((const void*)trunk_megakernel, hipFuncAttributeMaxDynamicSharedMemorySize, LDS_DYN);
    hipOccupancyMaxActiveBlocksPerMultiprocessor(&per_cu, trunk_megakernel, NTHREADS, LDS_DYN);
    if (per_cu < 1) per_cu = 1;
    grid_blocks = cus * per_cu;
  }
  if (ws_size < WS_END) { fprintf(stderr, "workspace too small: %zu < %zu\n", ws_size, (size_t)WS_END); return; }
  KParams p{};
  for (int i = 0; i < 30; ++i) p.in[i] = (const float*)d_in[i];
  p.out = (float*)d_out;
  p.ws = (unsigned char*)d_ws;
  hipMemsetAsync((unsigned char*)d_ws + WS_BAR, 0, 256, stream);
  void* args[] = {&p};
  hipError_t e = hipLaunchCooperativeKernel((void*)trunk_megakernel, dim3(grid_blocks), dim3(NTHREADS), args, LDS_DYN, stream);
  if (e != hipSuccess) fprintf(stderr, "cooperative launch failed: %s (grid %d)\n", hipGetErrorString(e), grid_blocks);
}
```

```cpp
#include <hip/hip_runtime.h>
#include <hip/hip_cooperative_groups.h>
#include <cstdio>
namespace cg = cooperative_groups;

typedef unsigned short u16;
using bf16x8 = __attribute__((ext_vector_type(8))) short;
using f32x4 = __attribute__((ext_vector_type(4))) float;
#define DI __device__ __forceinline__

constexpr int TT = 40960;
constexpr int TI = 8192;
constexpr int DM = 1024;
constexpr int DFF = 2816;
constexpr float EPSF = 1e-6f;
constexpr int NTHREADS = 512;
constexpr int LDS_WORK = 161536;
constexpr int LDS_DYN = LDS_WORK + 32;
#ifndef PHMASK
#define PHMASK 0xffffffffu
#endif
#define PH(i) ((PHMASK >> (i)) & 1u)

constexpr size_t OCK = 41943040, OCV = 44040192, OSR = 46137344, OSD = 50331648;

constexpr size_t W1IN = 0, W1OUT = 5767168, WIN = 8650752, WBR = 17039360, WOUT = 18612224, W2IN = 19660800, W2OUT = 25427968, WTOTAL = 28311552;
constexpr size_t WS_W = 0;
constexpr size_t WS_H = WTOTAL * 2;
constexpr size_t SLABB = (size_t)TT * 512 * 2;
constexpr size_t WS_SLAB = WS_H + (size_t)TT * 1024 * 2;
constexpr size_t WS_MODS = WS_SLAB + 9 * SLABB;
constexpr size_t WS_DAB = WS_MODS + 2 * 9 * 9216 * 4;
constexpr size_t WS_GBG = WS_DAB + (size_t)TT * 16 * 4;
constexpr size_t WS_GBB = WS_GBG + (size_t)TT * 8 * 4;
constexpr size_t WS_HALO = WS_GBB + (size_t)TT * 8 * 4;
constexpr size_t WS_CTR = WS_HALO + (size_t)640 * 2 * 1536 * 2;
constexpr size_t WS_ROPE = WS_CTR + 256;
constexpr size_t WS_BAR = WS_ROPE + 2 * 1024 * 4;
constexpr size_t WS_END = WS_BAR + 256;
constexpr size_t KC_VT_OFF = 5505024;

struct KParams {
  const float* in[30];
  float* out;
  unsigned char* ws;
};
struct Params {
  const KParams& k;
  float* out;
  unsigned char* ws;
};

typedef __bf16 bf16v2_t __attribute__((ext_vector_type(2)));
typedef float f32v2_t __attribute__((ext_vector_type(2)));
typedef float f32x2_t __attribute__((ext_vector_type(2)));
DI unsigned cvtpk(float lo, float hi) { f32v2_t v = {lo, hi}; bf16v2_t b = __builtin_convertvector(v, bf16v2_t); return __builtin_bit_cast(unsigned, b); }
DI u16 f2bf(float x) { return (u16)(cvtpk(x, 0.f) & 0xffffu); }
DI float bf2f(u16 h) { return __uint_as_float(((unsigned)h) << 16); }
DI float bflo(unsigned u) { return __uint_as_float(u << 16); }
DI float bfhi(unsigned u) { return __uint_as_float(u & 0xffff0000u); }
DI f32x4 mfma16(bf16x8 a, bf16x8 b, f32x4 c) { return __builtin_amdgcn_mfma_f32_16x16x32_bf16(a, b, c, 0, 0, 0); }
DI float silu_f(float x) { return x / (1.f + __expf(-x)); }
DI float sigmoid_f(float x) { return 1.f / (1.f + __expf(-x)); }
DI float wave_sum(float x) {
#pragma unroll
  for (int o = 32; o >= 1; o >>= 1) x += __shfl_xor(x, o);
  return x;
}
DI float sum16(float x) {
  x += __shfl_xor(x, 1); x += __shfl_xor(x, 2); x += __shfl_xor(x, 4); x += __shfl_xor(x, 8);
  return x;
}
DI float max16(float x) {
  x = fmaxf(x, __shfl_xor(x, 1)); x = fmaxf(x, __shfl_xor(x, 2)); x = fmaxf(x, __shfl_xor(x, 4)); x = fmaxf(x, __shfl_xor(x, 8));
  return x;
}
DI void lds_barrier() { asm volatile("s_waitcnt lgkmcnt(0)" ::: "memory"); __builtin_amdgcn_s_barrier(); asm volatile("" ::: "memory"); }
DI int seq_base(int s) { return s < 32 ? s * 256 : TI + (s - 32) * 4096; }
DI int seq_len(int s) { return s < 32 ? 256 : 4096; }
DI int modrow_of(int t) { return t < TI ? 0 : 1 + ((t - TI) >> 12); }
DI const float* xin_row(const Params& p, int t) { return t < TI ? p.k.in[0] + (size_t)t * DM : p.k.in[1] + (size_t)(t - TI) * DM; }
DI size_t kv_base(int s, int kvh) { return s < 32 ? (size_t)(s * 2 + kvh) * (256 * 64) : (size_t)1048576 + (size_t)((s - 32) * 2 + kvh) * (4352 * 64); }

DI u16* ws_w(const Params& p) { return (u16*)(p.ws + WS_W); }
DI u16* ws_h(const Params& p) { return (u16*)(p.ws + WS_H); }
DI u16* ws_slab(const Params& p, int i) { return (u16*)(p.ws + WS_SLAB + (size_t)i * SLABB); }
DI float* ws_mods(const Params& p) { return (float*)(p.ws + WS_MODS); }

template <int NT, int KS>
DI void wave_mma(const u16* A, int lda, int arow0, const u16* B, int ldb, int brow0, f32x4 (&acc)[NT], int lane) {
  const int r = lane & 15, q = lane >> 4;
#pragma unroll
  for (int ks = 0; ks < KS; ++ks) {
    bf16x8 a = *(const bf16x8*)(A + (arow0 + r) * lda + ks * 32 + q * 8);
#pragma unroll
    for (int n = 0; n < NT; ++n) {
      bf16x8 b = *(const bf16x8*)(B + (brow0 + n * 16 + r) * ldb + ks * 32 + q * 8);
      acc[n] = mfma16(a, b, acc[n]);
    }
  }
}

namespace pg8 {
#define PG8_LAS __attribute__((address_space(3)))
typedef unsigned short bf16_t;
typedef short bf16x8 __attribute__((ext_vector_type(8)));
typedef float f32x4 __attribute__((ext_vector_type(4)));
typedef unsigned u32x4 __attribute__((ext_vector_type(4)));
constexpr int BM = 256, BK = 64, HALF = 128, HTB = HALF * BK * 2  , STAGE_BYTES = 8 * HTB, NXCD = 8, WGM = 8;

__host__ __device__ __forceinline__ int lds_byte(int r, int c) { const int st = (r >> 4) * 2 + (c >> 5), rr = r & 15, cc = c & 31, ob = rr * 64 + cc * 2; return st * 1024 + (ob ^ (((ob >> 9) & 1) << 5)); }
__host__ __device__ __forceinline__ void stage_rc(int b, int& R, int& C) { const int st = b / 1024, sb = b % 1024, swz = sb ^ (((sb >> 9) & 1) << 5); R = (st >> 1) * 16 + swz / 64; C = (st & 1) * 32 + (swz % 64) / 2; }
__host__ __device__ __forceinline__ int perm32(int rho) { const int n = rho >> 4, i = rho & 15; return 8 * (i >> 2) + 4 * n + (i & 3); }

struct Unit { int pm, pn; };
struct Gemm { const bf16_t* A; const bf16_t* Bt; int M, N, K; };

struct StaticOrder {
    int nM, nN, nwg, G, c;
    __host__ __device__ void init(int M, int N, int G_, int c_) { nM = M / BM; nN = N / BM; nwg = nM * nN; G = G_; c = c_; }
    __host__ __device__ bool next(int i, Unit& u) const {
        const long L = (long)i * G + c; if (L >= nwg) return false;
        int wgid = (int)L; { const int q = nwg / NXCD, r = nwg % NXCD, xcd = wgid % NXCD, off = wgid / NXCD; wgid = (xcd < r ? xcd * (q + 1) : r * (q + 1) + (xcd - r) * q) + off; }
        const int nig = WGM * nN, gid = wgid / nig, fm = gid * WGM, gsz = (nM - fm) < WGM ? (nM - fm) : WGM;
        u.pm = fm + ((wgid % nig) % gsz); u.pn = (wgid % nig) / gsz; return true;
    }
    __device__ __forceinline__ void a_ready(const Unit&) const {}
    __device__ __forceinline__ void done(const Unit&) const {}
};
template <class Epi, class Sched, bool STAMP = false>
__device__ __forceinline__ void gemm_phase(PG8_LAS unsigned char* lds, const Gemm g, const Sched& S, const Epi& E, unsigned long long* stamps, int tid_in) {
    const int tid = tid_in, wid = __builtin_amdgcn_readfirstlane(tid >> 6), lane = tid & 63, wr = wid >> 2, wc = wid & 3, fr = lane & 15, fq = lane >> 4;
    const int K = g.K, nt = K / BK;
    float zf_ = 0.f; asm volatile("" : "+v"(zf_));
    int ts_lo = 0, ts_hi = 0, nts = 0; const unsigned long long rt_entry = STAMP ? (unsigned long long)wall_clock64() : 0ull;
#define PG8_STAMP() do { if (STAMP && wid == 0 && nts < 64) { const unsigned long long _c = (unsigned long long)clock64(); \
        ts_lo = (lane == nts) ? (int)(unsigned)_c : ts_lo; ts_hi = (lane == nts) ? (int)(unsigned)(_c >> 32) : ts_hi; ++nts; } } while (0)
    PG8_STAMP();
    unsigned voffA[2], voffB[2];
#pragma unroll
    for (int i = 0; i < 2; ++i) { int R, C; stage_rc(tid * 16 + i * 8192, R, C); const int Rb = Epi::PERM ? ((R & ~31) + perm32(R & 31)) : R;
        voffA[i] = (unsigned)(R * K + C) * 2u; voffB[i] = (unsigned)(Rb * K + C) * 2u; }
    const size_t kstep = (size_t)(BK * 2);
    const size_t hstep = (size_t)HALF * K * 2;
    const size_t tstep = 2 * hstep;
    const unsigned ldsw = (unsigned)wid * 1024u;
    const int aoff = lds_byte(wr * 64 + fr, fq * 8), boff = lds_byte(wc * 32 + fr, fq * 8);
#define PG8_SA(b, h) (((b) * 2 + (h)) * HTB)
#define PG8_SB(b, h) ((4 + (b) * 2 + (h)) * HTB)
#define PG8_STAGE(bufoff, gbase, voff) do { _Pragma("unroll") for (int _i = 0; _i < 2; ++_i) \
        __builtin_amdgcn_global_load_lds((const unsigned*)((const char*)(gbase) + (voff)[_i]), (PG8_LAS unsigned*)(lds + (bufoff) + ldsw + _i * 8192), 16, 0, 0); } while (0)
#define PG8_LDA(dst, b, h) do { _Pragma("unroll") for (int m = 0; m < 4; ++m) _Pragma("unroll") for (int k = 0; k < 2; ++k) dst[m][k] = *(const PG8_LAS bf16x8*)(lds + PG8_SA(b, h) + aoff + m * 2048 + k * 1024); } while (0)
#define PG8_LDB(dst, b, h) do { _Pragma("unroll") for (int n = 0; n < 2; ++n) _Pragma("unroll") for (int k = 0; k < 2; ++k) dst[n][k] = *(const PG8_LAS bf16x8*)(lds + PG8_SB(b, h) + boff + n * 2048 + k * 1024); } while (0)
#define PG8_MMA(ai, bj, At, Bt) do { __builtin_amdgcn_s_setprio(1); _Pragma("unroll") for (int m = 0; m < 4; ++m) _Pragma("unroll") for (int n = 0; n < 2; ++n) _Pragma("unroll") for (int k = 0; k < 2; ++k) \
        acc[ai][bj][m][n] = __builtin_amdgcn_mfma_f32_16x16x32_bf16(Bt[n][k], At[m][k], acc[ai][bj][m][n], 0, 0, 0); __builtin_amdgcn_s_setprio(0); } while (0)
#define PG8_WAIT_V(n) asm volatile("s_waitcnt vmcnt(" #n ")" ::: "memory")
#define PG8_WAIT_L(n) asm volatile("s_waitcnt lgkmcnt(" #n ")" ::: "memory")
#define PG8_BAR __builtin_amdgcn_s_barrier()
#define PG8_SCHED __builtin_amdgcn_sched_barrier(0)
    Unit cur, nxt; int ui = 0;
    if (!S.next(0, cur)) return;
    f32x4 acc[2][2][4][2];
#pragma unroll
    for (int a = 0; a < 2; ++a)
#pragma unroll
        for (int b = 0; b < 2; ++b)
#pragma unroll
            for (int m = 0; m < 4; ++m)
#pragma unroll
                for (int n = 0; n < 2; ++n) acc[a][b][m][n] = (f32x4){zf_, zf_, zf_, zf_};
    bf16x8 At[4][2], B0[2][2], B1[2][2];
    const char* cA = (const char*)g.A + (size_t)cur.pm * tstep; const char* cB = (const char*)g.Bt + (size_t)cur.pn * tstep;
    S.a_ready(cur);
    PG8_STAGE(PG8_SB(0, 0), cB, voffB); PG8_STAGE(PG8_SA(0, 0), cA, voffA); PG8_STAGE(PG8_SB(0, 1), cB + hstep, voffB); PG8_STAGE(PG8_SA(0, 1), cA + hstep, voffA);
    if (wr == 1) PG8_BAR;
    PG8_WAIT_V(4); PG8_BAR;
    PG8_STAGE(PG8_SB(1, 0), cB + kstep, voffB); PG8_STAGE(PG8_SA(1, 0), cA + kstep, voffA); PG8_STAGE(PG8_SB(1, 1), cB + hstep + kstep, voffB);
    PG8_WAIT_V(6); PG8_BAR;
    PG8_STAMP();
    for (;;) {
        const bool has_next = S.next(ui + 1, nxt);
        const char* nA = has_next ? (const char*)g.A + (size_t)nxt.pm * tstep : cA; const char* nB = has_next ? (const char*)g.Bt + (size_t)nxt.pn * tstep : cB;
        for (int t = 0; t < nt; t += 2) {
            const bool last = (t == nt - 2);
            const char* a1 = cA + (size_t)(t + 1) * kstep;
            const char* a2 = last ? nA : cA + (size_t)(t + 2) * kstep; const char* b2 = last ? nB : cB + (size_t)(t + 2) * kstep;
            const char* a3 = a2 + kstep; const char* b3 = b2 + kstep;
            if (last && has_next) S.a_ready(nxt);
            PG8_LDB(B0, 0, 0); PG8_SCHED; PG8_LDA(At, 0, 0); PG8_STAGE(PG8_SA(1, 1), a1 + hstep, voffA);
            PG8_WAIT_L(8); PG8_BAR; PG8_WAIT_L(0); PG8_MMA(0, 0, At, B0); PG8_BAR; PG8_SCHED;
            PG8_LDB(B1, 0, 1); PG8_STAGE(PG8_SB(0, 0), b2, voffB);
            PG8_BAR; PG8_WAIT_L(0); PG8_MMA(0, 1, At, B1); PG8_BAR;
            PG8_LDA(At, 0, 1); PG8_STAGE(PG8_SA(0, 0), a2, voffA);
            PG8_BAR; PG8_WAIT_L(0); PG8_MMA(1, 0, At, B0); PG8_BAR; PG8_SCHED;
            PG8_STAGE(PG8_SB(0, 1), b2 + hstep, voffB);
            PG8_WAIT_V(6); PG8_BAR; PG8_MMA(1, 1, At, B1); PG8_BAR;
            PG8_LDB(B0, 1, 0); PG8_SCHED; PG8_LDA(At, 1, 0); PG8_STAGE(PG8_SA(0, 1), a2 + hstep, voffA);
            PG8_WAIT_L(8); PG8_BAR; PG8_WAIT_L(0); PG8_MMA(0, 0, At, B0); PG8_BAR; PG8_SCHED;
            PG8_LDB(B1, 1, 1); PG8_STAGE(PG8_SB(1, 0), b3, voffB);
            PG8_BAR; PG8_WAIT_L(0); PG8_MMA(0, 1, At, B1); PG8_BAR;
            PG8_LDA(At, 1, 1); PG8_STAGE(PG8_SA(1, 0), a3, voffA);
            PG8_BAR; PG8_WAIT_L(0); PG8_MMA(1, 0, At, B0); PG8_BAR; PG8_SCHED;
            PG8_STAGE(PG8_SB(1, 1), b3 + hstep, voffB);
            PG8_WAIT_V(6); PG8_BAR; PG8_MMA(1, 1, At, B1); PG8_BAR;
        }
        PG8_STAMP();
        if constexpr (!Epi::AFTER_DRAIN) { E(acc, cur, wr, wc, fr, fq); S.done(cur); }
        PG8_STAMP();
        if (!has_next) break;
#pragma unroll
        for (int a = 0; a < 2; ++a)
#pragma unroll
            for (int b = 0; b < 2; ++b)
#pragma unroll
                for (int m = 0; m < 4; ++m)
#pragma unroll
                    for (int n = 0; n < 2; ++n) acc[a][b][m][n] = (f32x4){zf_, zf_, zf_, zf_};
        cur = nxt; cA = nA; cB = nB; ++ui;
    }
    PG8_WAIT_V(0);
    if (wr == 0) PG8_BAR;
    PG8_BAR;
    if constexpr (Epi::AFTER_DRAIN) { E.fused(acc, cur, wr, wc, fr, fq, lds, wid, lane); S.done(cur); }
    PG8_STAMP();
    if (STAMP && wid == 0) { stamps[lane] = lane < nts ? (((unsigned long long)(unsigned)ts_hi << 32) | (unsigned)ts_lo) : 0ull;
        if (lane == 62) stamps[62] = rt_entry; if (lane == 63) stamps[63] = (unsigned long long)wall_clock64(); }
#undef PG8_STAMP
#undef PG8_SA
#undef PG8_SB
#undef PG8_STAGE
#undef PG8_LDA
#undef PG8_LDB
#undef PG8_MMA
#undef PG8_WAIT_V
#undef PG8_WAIT_L
#undef PG8_BAR
#undef PG8_SCHED
}
}

template <int MT>
DI void zero_acc(f32x4 (&acc)[MT][4]) {
#pragma unroll
  for (int m = 0; m < MT; ++m)
#pragma unroll
    for (int n = 0; n < 4; ++n) acc[m][n] = f32x4{0.f, 0.f, 0.f, 0.f};
}

DI int map_row(int type, int col) {
  if (type == 0) return col;
  if (type == 1) { if (col < DFF) return 256 * (col >> 7) + (col & 127); int c = col - DFF; return 256 * (c >> 7) + 128 + (c & 127); }
  if (col < 4352) return col;
  if (col < 4368) return 2816 + 1536 + (col - 4352);
  if (col < 4880) return 2816 + 1792 + (col - 4368);
  return 5120 + (col - 4880);
}

DI void conv_tile(const float* __restrict__ src, int ld, int ncols, int k0, int c0, u16* __restrict__ dst, int K, int type, u16* sm, int tid) {
  {
    const int n = tid & 63, kk = tid >> 6;
    const bool ok = (c0 + n) < ncols;
#pragma unroll
    for (int i = 0; i < 8; ++i) {
      int k = kk + 8 * i;
      float v = ok ? src[(size_t)(k0 + k) * ld + c0 + n] : 0.f;
      sm[n * 72 + k] = f2bf(v);
    }
  }
  lds_barrier();
  {
    const int n2 = tid >> 3, seg = tid & 7;
    const int col = c0 + n2;
    if (col < ncols) {
      int row = map_row(type, col);
      *(uint4*)(dst + (size_t)row * K + k0 + seg * 8) = *(const uint4*)(sm + n2 * 72 + seg * 8);
    }
  }
  lds_barrier();
}

DI void phase_convert(const Params& p, int l, u16* smem, int tid, int bid, int nblk) {
  u16* W = ws_w(p);
  const int NJ = 9;
  const int cum[NJ + 1] = {0, 1408, 2112, 4112, 4240, 4368, 4496, 4752, 6160, 6864};
  const int nconv = 6864;
  const int nmod = 0;
  const int total = nconv + 1 + nmod;
  for (int it = bid; it < total; it += nblk) {
    if (it < nconv) {
      int j = 0;
#pragma unroll
      for (int jj = 1; jj < NJ; ++jj) if (it >= cum[jj]) j = jj;
      int t = it - cum[j];
      const float* src; int ld, ncols, K, type = 0, nct; u16* dst;
      switch (j) {
        case 0: src = p.k.in[11] + (size_t)l * 1024 * 5632; ld = 5632; ncols = 5632; K = 1024; type = 1; nct = 88; dst = W + W1IN; break;
        case 1: src = p.k.in[12] + (size_t)l * 2816 * 1024; ld = 1024; ncols = 1024; K = 2816; nct = 16; dst = W + W1OUT; break;
        case 2: src = p.k.in[14] + (size_t)l * 1024 * 7952; ld = 7952; ncols = 7952; K = 1024; type = 2; nct = 125; dst = W + WIN; break;
        case 3: src = p.k.in[22] + (size_t)l * 512 * 1024; ld = 1024; ncols = 1024; K = 512; nct = 16; dst = W + WBR; break;
        case 4: src = p.k.in[23] + (size_t)l * 512 * 1024; ld = 1024; ncols = 1024; K = 512; nct = 16; dst = W + WBR + 524288; break;
        case 5: src = p.k.in[24] + (size_t)l * 512 * 1024; ld = 1024; ncols = 1024; K = 512; nct = 16; dst = W + WBR + 2 * 524288; break;
        case 6: src = p.k.in[25] + (size_t)l * 1024 * 1024; ld = 1024; ncols = 1024; K = 1024; nct = 16; dst = W + WOUT; break;
        case 7: src = p.k.in[27] + (size_t)l * 1024 * 5632; ld = 5632; ncols = 5632; K = 1024; type = 1; nct = 88; dst = W + W2IN; break;
        default: src = p.k.in[28] + (size_t)l * 2816 * 1024; ld = 1024; ncols = 1024; K = 2816; nct = 16; dst = W + W2OUT; break;
      }
      int kt = t / nct, ct = t % nct;
      conv_tile(src, ld, ncols, kt * 64, ct * 64, dst, K, type, smem, tid);
    } else if (it == nconv) {
      u16* z = W + WIN + (size_t)(2816 + 1552) * 1024;
      unsigned zu = 0u; asm volatile("" : "+v"(zu));
      for (int i = tid; i < 240 * 1024 / 8; i += NTHREADS) *(uint4*)(z + i * 8) = uint4{zu, zu, zu, zu};
    }
  }
}

DI void phase_mods(const Params& p, u16* smem, int tid, int bid, int nblk) {
  if (bid == 0 && tid < 64) ((int*)(p.ws + WS_CTR))[tid] = 0;
  if (bid == 1) {
    float* ROPE = (float*)(p.ws + WS_ROPE);
    for (int i = tid; i < 1024; i += NTHREADS) {
      float inv = exp2f(-(float)(i & 15) * (13.287712379549449f / 16.f));
      float sn, cs;
      sincosf((float)(i >> 4) * inv, &sn, &cs);
      ROPE[i] = cs; ROPE[1024 + i] = sn;
    }
  }
  const int nconv = -1;
  for (int it = bid; it < 288; it += nblk) {
    {
      int mi = it - nconv - 1;
      int ml = mi / 144, cb = mi % 144;
      float* sc = (float*)smem;
      float* red = sc + 9 * 1024;
      for (int i = tid; i < 9 * 1024; i += NTHREADS) {
        int r = i >> 10, k = i & 1023;
        float c = (r == 0) ? p.k.in[7][k] : p.k.in[6][(r - 1) * 1024 + k];
        sc[i] = silu_f(c);
      }
      __syncthreads();
      const int n = tid & 63, kg = tid >> 6;
      const float* Wm = p.k.in[8] + (size_t)ml * 1024 * 9216 + cb * 64 + n;
      float a[9];
#pragma unroll
      for (int r = 0; r < 9; ++r) a[r] = 0.f;
#pragma unroll 8
      for (int k = kg * 128; k < kg * 128 + 128; ++k) {
        float wv = Wm[(size_t)k * 9216];
#pragma unroll
        for (int r = 0; r < 9; ++r) a[r] += sc[r * 1024 + k] * wv;
      }
#pragma unroll
      for (int r = 0; r < 9; ++r) red[(kg * 9 + r) * 64 + n] = a[r];
      __syncthreads();
      for (int i = tid; i < 576; i += NTHREADS) {
        int r = i >> 6, nn = i & 63;
        float s = p.k.in[9][(size_t)ml * 9216 + cb * 64 + nn];
#pragma unroll
        for (int g = 0; g < 8; ++g) s += red[(g * 9 + r) * 64 + nn];
        ws_mods(p)[(size_t)(ml * 9 + r) * 9216 + cb * 64 + nn] = s;
      }
      __syncthreads();
    }
  }
}

DI void phase_norm(const Params& p, int l, int which, bool first, int tid, int bid, int nblk) {
  const int lane = tid & 63;
  const int gw = bid * 8 + (tid >> 6), nw = nblk * 8;
  const float* nwp = p.k.in[which == 0 ? 10 : (which == 1 ? 13 : 26)] + l * 1024;
  u16* H = ws_h(p);
  for (int t0 = gw; t0 < TT; t0 += 2 * nw) {
    const int t1 = t0 + nw;
    const bool has1 = t1 < TT;
    const float* xr0 = first ? xin_row(p, t0) : p.out + (size_t)t0 * DM;
    const float* xr1 = has1 ? (first ? xin_row(p, t1) : p.out + (size_t)t1 * DM) : xr0;
    float4 v[2][4];
#pragma unroll
    for (int i = 0; i < 4; ++i) { v[0][i] = *(const float4*)(xr0 + i * 256 + lane * 4); v[1][i] = *(const float4*)(xr1 + i * 256 + lane * 4); }
#pragma unroll
    for (int rr = 0; rr < 2; ++rr) {
      if (rr == 1 && !has1) break;
      const int t = rr ? t1 : t0;
      float ss = 0.f;
#pragma unroll
      for (int i = 0; i < 4; ++i) ss += v[rr][i].x * v[rr][i].x + v[rr][i].y * v[rr][i].y + v[rr][i].z * v[rr][i].z + v[rr][i].w * v[rr][i].w;
      ss = wave_sum(ss);
      const float rstd = rsqrtf(ss * (1.f / 1024.f) + EPSF);
      const float* mod = ws_mods(p) + (size_t)(l * 9 + modrow_of(t)) * 9216;
      const float* sh = mod + (3 * which) * 1024;
      const float* sc = mod + (3 * which + 1) * 1024;
#pragma unroll
      for (int i = 0; i < 4; ++i) {
        int c = i * 256 + lane * 4;
        float4 wv = *(const float4*)(nwp + c), s4 = *(const float4*)(sc + c), h4 = *(const float4*)(sh + c);
        float y0 = v[rr][i].x * rstd * wv.x * (1.f + s4.x) + h4.x;
        float y1 = v[rr][i].y * rstd * wv.y * (1.f + s4.y) + h4.y;
        float y2 = v[rr][i].z * rstd * wv.z * (1.f + s4.z) + h4.z;
        float y3 = v[rr][i].w * rstd * wv.w * (1.f + s4.w) + h4.w;
        *(uint2*)(H + (size_t)t * 1024 + c) = uint2{cvtpk(y0, y1), cvtpk(y2, y3)};
      }
    }
  }
}

DI void phase_final_norm(const Params& p, int tid, int bid, int nblk) {
  const int lane = tid & 63;
  const int gw = bid * 8 + (tid >> 6), nw = nblk * 8;
  const float* nwp = p.k.in[29];
  for (int t0 = gw; t0 < TT; t0 += 2 * nw) {
    const int t1 = t0 + nw;
    const bool has1 = t1 < TT;
    float* xr0 = p.out + (size_t)t0 * DM;
    float* xr1 = has1 ? p.out + (size_t)t1 * DM : xr0;
    float4 v[2][4];
#pragma unroll
    for (int i = 0; i < 4; ++i) { v[0][i] = *(const float4*)(xr0 + i * 256 + lane * 4); v[1][i] = *(const float4*)(xr1 + i * 256 + lane * 4); }
#pragma unroll
    for (int rr = 0; rr < 2; ++rr) {
      if (rr == 1 && !has1) break;
      float* xr = rr ? xr1 : xr0;
      float ss = 0.f;
#pragma unroll
      for (int i = 0; i < 4; ++i) ss += v[rr][i].x * v[rr][i].x + v[rr][i].y * v[rr][i].y + v[rr][i].z * v[rr][i].z + v[rr][i].w * v[rr][i].w;
      ss = wave_sum(ss);
      const float rstd = rsqrtf(ss * (1.f / 1024.f) + EPSF);
#pragma unroll
      for (int i = 0; i < 4; ++i) {
        int c = i * 256 + lane * 4;
        float4 wv = *(const float4*)(nwp + c);
        *(float4*)(xr + c) = float4{v[rr][i].x * rstd * wv.x, v[rr][i].y * rstd * wv.y, v[rr][i].z * rstd * wv.z, v[rr][i].w * rstd * wv.w};
      }
    }
  }
}

typedef __attribute__((address_space(3))) unsigned char lds_u8;

struct EpiSwiglu {
  static constexpr bool PERM = true, AFTER_DRAIN = false;
  u16* hid;
  DI void operator()(const f32x4 (&acc)[2][2][4][2], const pg8::Unit& u, int wr, int wc, int fr, int fq) const {
    const int row0 = u.pm * 256 + wr * 64 + fr, col0 = u.pn * 128 + wc * 32 + fq * 8;
#pragma unroll
    for (int ai = 0; ai < 2; ++ai)
#pragma unroll
      for (int m = 0; m < 4; ++m) {
        const f32x4 g0 = acc[ai][0][m][0], g1 = acc[ai][0][m][1], u0 = acc[ai][1][m][0], u1 = acc[ai][1][m][1];
        uint4 o;
        o.x = cvtpk(silu_f(g0[0]) * u0[0], silu_f(g0[1]) * u0[1]);
        o.y = cvtpk(silu_f(g0[2]) * u0[2], silu_f(g0[3]) * u0[3]);
        o.z = cvtpk(silu_f(g1[0]) * u1[0], silu_f(g1[1]) * u1[1]);
        o.w = cvtpk(silu_f(g1[2]) * u1[2], silu_f(g1[3]) * u1[3]);
        *(uint4*)(hid + (size_t)(row0 + ai * 128 + m * 16) * DFF + col0) = o;
      }
  }
};

struct EpiResid {
  static constexpr bool PERM = false, AFTER_DRAIN = false;
  const float* x0; const float* x1; float* out; const float* gm_base; float scale; bool first;
  DI const float* src_row(int row) const { return first ? (row < TI ? x0 + (size_t)row * DM : x1 + (size_t)(row - TI) * DM) : out + (size_t)row * DM; }
  DI void operator()(const f32x4 (&acc)[2][2][4][2], const pg8::Unit& u, int wr, int wc, int fr, int fq) const {
    const float* gm = gm_base + (size_t)modrow_of(u.pm * 256) * 9216;
    const int row0 = u.pm * 256 + wr * 64 + fr, col0 = u.pn * 256 + wc * 32 + 4 * fq;
    f32x4 gv[2][2];
#pragma unroll
    for (int bj = 0; bj < 2; ++bj)
#pragma unroll
      for (int n = 0; n < 2; ++n) gv[bj][n] = *(const f32x4*)(gm + col0 + bj * 128 + n * 16) * scale;
    f32x4 xa[2][2], xb[2][2];
    {
      const float* __restrict__ xr = src_row(row0) + col0;
      const float* __restrict__ xs = src_row(row0 + 16) + col0;
#pragma unroll
      for (int bj = 0; bj < 2; ++bj)
#pragma unroll
        for (int n = 0; n < 2; ++n) { xa[bj][n] = *(const f32x4*)(xr + bj * 128 + n * 16); xb[bj][n] = *(const f32x4*)(xs + bj * 128 + n * 16); }
    }
#pragma unroll
    for (int rr = 0; rr < 8; ++rr) {
      const int ai = rr >> 2, m = rr & 3;
      f32x4 nx[2][2];
      if (rr + 2 < 8) {
        const float* __restrict__ xr = src_row(row0 + ((rr + 2) >> 2) * 128 + ((rr + 2) & 3) * 16) + col0;
#pragma unroll
        for (int bj = 0; bj < 2; ++bj)
#pragma unroll
          for (int n = 0; n < 2; ++n) nx[bj][n] = *(const f32x4*)(xr + bj * 128 + n * 16);
      }
      float* __restrict__ xo = out + (size_t)(row0 + ai * 128 + m * 16) * DM + col0;
#pragma unroll
      for (int bj = 0; bj < 2; ++bj)
#pragma unroll
        for (int n = 0; n < 2; ++n) *(f32x4*)(xo + bj * 128 + n * 16) = xa[bj][n] + gv[bj][n] * acc[ai][bj][m][n];
#pragma unroll
      for (int bj = 0; bj < 2; ++bj)
#pragma unroll
        for (int n = 0; n < 2; ++n) { xa[bj][n] = xb[bj][n]; if (rr + 2 < 8) xb[bj][n] = nx[bj][n]; }
    }
  }
};

DI uint4 pack8(const f32x4& a, const f32x4& b) { return uint4{cvtpk(a[0], a[1]), cvtpk(a[2], a[3]), cvtpk(b[0], b[1]), cvtpk(b[2], b[3])}; }

struct EpiProjA {
  static constexpr bool PERM = true, AFTER_DRAIN = false;
  unsigned char* slab0;
  DI void operator()(const f32x4 (&acc)[2][2][4][2], const pg8::Unit& u, int wr, int wc, int fr, int fq) const {
    u16* dst; int ldd, c0;
    if (u.pn < 2) { dst = (u16*)slab0; ldd = 512; c0 = u.pn * 256; }
    else if (u.pn == 2) { dst = (u16*)(slab0 + 6 * SLABB); ldd = 256; c0 = 0; }
    else { dst = (u16*)(slab0 + (size_t)(2 + ((u.pn - 3) >> 1)) * SLABB); ldd = 512; c0 = ((u.pn - 3) & 1) * 256; }
    const int row0 = u.pm * 256 + wr * 64 + fr, col0 = c0 + wc * 32 + fq * 8;
#pragma unroll
    for (int ai = 0; ai < 2; ++ai)
#pragma unroll
      for (int m = 0; m < 4; ++m)
#pragma unroll
        for (int bj = 0; bj < 2; ++bj)
          *(uint4*)(dst + (size_t)(row0 + ai * 128 + m * 16) * ldd + col0 + bj * 128) = pack8(acc[ai][bj][m][0], acc[ai][bj][m][1]);
  }
};

struct EpiProjB {
  static constexpr bool PERM = true, AFTER_DRAIN = false;
  unsigned char* slab0; float* dab; u16* halo;
  DI void operator()(const f32x4 (&acc)[2][2][4][2], const pg8::Unit& u, int wr, int wc, int fr, int fq) const {
    const int row0 = u.pm * 256 + wr * 64 + fr;
    if (u.pn < 6) {
      u16* dst = (u16*)(slab0 + (size_t)(2 + (u.pn >> 1)) * SLABB);
      const int col0 = (u.pn & 1) * 256 + wc * 32 + fq * 8;
      const int hcol0 = u.pn * 256 + wc * 32 + fq * 8;
#pragma unroll
      for (int ai = 0; ai < 2; ++ai)
#pragma unroll
        for (int m = 0; m < 4; ++m)
#pragma unroll
          for (int bj = 0; bj < 2; ++bj) {
            const int row = row0 + ai * 128 + m * 16;
            const uint4 v = pack8(acc[ai][bj][m][0], acc[ai][bj][m][1]);
            *(uint4*)(dst + (size_t)row * 512 + col0 + bj * 128) = v;
            if (m == 0 && fr == 0) *(uint4*)(halo + ((size_t)(row >> 6) * 2 + 0) * 1536 + hcol0 + bj * 128) = v;
            if (m == 3 && fr == 15) *(uint4*)(halo + ((size_t)(row >> 6) * 2 + 1) * 1536 + hcol0 + bj * 128) = v;
          }
    } else {
      if (wc == 0 && fq < 2) {
#pragma unroll
        for (int ai = 0; ai < 2; ++ai)
#pragma unroll
          for (int m = 0; m < 4; ++m)
#pragma unroll
            for (int n = 0; n < 2; ++n)
              *(f32x4*)(dab + (size_t)(row0 + ai * 128 + m * 16) * 16 + 8 * fq + 4 * n) = acc[ai][0][m][n];
      }
    }
  }
};

struct EpiProjDG {
  static constexpr bool PERM = true, AFTER_DRAIN = false;
  u16* dst;
  DI void operator()(const f32x4 (&acc)[2][2][4][2], const pg8::Unit& u, int wr, int wc, int fr, int fq) const {
    const int row0 = u.pm * 256 + wr * 64 + fr, col0 = u.pn * 256 + wc * 32 + fq * 8;
#pragma unroll
    for (int ai = 0; ai < 2; ++ai)
#pragma unroll
      for (int m = 0; m < 4; ++m)
#pragma unroll
        for (int bj = 0; bj < 2; ++bj)
          *(uint4*)(dst + (size_t)(row0 + ai * 128 + m * 16) * 512 + col0 + bj * 128) = pack8(acc[ai][bj][m][0], acc[ai][bj][m][1]);
  }
};

DI f32x4 sig4(const f32x4& a) { return f32x4{sigmoid_f(a[0]), sigmoid_f(a[1]), sigmoid_f(a[2]), sigmoid_f(a[3])}; }

struct EpiMG {
  static constexpr bool PERM = true, AFTER_DRAIN = false;
  u16* G;
  DI void operator()(const f32x4 (&acc)[2][2][4][2], const pg8::Unit& u, int wr, int wc, int fr, int fq) const {
    const int row0 = u.pm * 256 + wr * 64 + fr, col0 = u.pn * 256 + wc * 32 + fq * 8;
#pragma unroll
    for (int ai = 0; ai < 2; ++ai)
#pragma unroll
      for (int m = 0; m < 4; ++m)
#pragma unroll
        for (int bj = 0; bj < 2; ++bj)
          *(uint4*)(G + (size_t)(row0 + ai * 128 + m * 16) * 3072 + col0 + bj * 128) = pack8(sig4(acc[ai][bj][m][0]), sig4(acc[ai][bj][m][1]));
  }
};

struct EpiBR {
  static constexpr bool PERM = true, AFTER_DRAIN = false;
  const u16* G; u16* mrg; int b;
  DI void operator()(const f32x4 (&acc)[2][2][4][2], const pg8::Unit& u, int wr, int wc, int fr, int fq) const {
    const int row0 = u.pm * 256 + wr * 64 + fr, col0 = u.pn * 256 + wc * 32 + fq * 8;
    uint4 g[2], pv[2];
    {
      const size_t row = (size_t)row0;
#pragma unroll
      for (int bj = 0; bj < 2; ++bj) {
        g[bj] = *(const uint4*)(G + row * 3072 + b * 1024 + col0 + bj * 128);
        pv[bj] = uint4{0, 0, 0, 0};
        if (b > 0) pv[bj] = *(const uint4*)(mrg + row * 1024 + col0 + bj * 128);
      }
    }
#pragma unroll
    for (int rr = 0; rr < 8; ++rr) {
      const int ai = rr >> 2, m = rr & 3;
      uint4 ng[2], npv[2];
      if (rr + 1 < 8) {
        const size_t row = (size_t)(row0 + ((rr + 1) >> 2) * 128 + ((rr + 1) & 3) * 16);
#pragma unroll
        for (int bj = 0; bj < 2; ++bj) {
          ng[bj] = *(const uint4*)(G + row * 3072 + b * 1024 + col0 + bj * 128);
          npv[bj] = uint4{0, 0, 0, 0};
          if (b > 0) npv[bj] = *(const uint4*)(mrg + row * 1024 + col0 + bj * 128);
        }
      }
      const size_t row = (size_t)(row0 + ai * 128 + m * 16);
#pragma unroll
      for (int bj = 0; bj < 2; ++bj) {
        const f32x4 a0 = acc[ai][bj][m][0], a1 = acc[ai][bj][m][1];
        uint4 o;
        o.x = cvtpk(bflo(pv[bj].x) + bflo(g[bj].x) * a0[0], bfhi(pv[bj].x) + bfhi(g[bj].x) * a0[1]);
        o.y = cvtpk(bflo(pv[bj].y) + bflo(g[bj].y) * a0[2], bfhi(pv[bj].y) + bfhi(g[bj].y) * a0[3]);
        o.z = cvtpk(bflo(pv[bj].z) + bflo(g[bj].z) * a1[0], bfhi(pv[bj].z) + bfhi(g[bj].z) * a1[1]);
        o.w = cvtpk(bflo(pv[bj].w) + bflo(g[bj].w) * a1[2], bfhi(pv[bj].w) + bfhi(g[bj].w) * a1[3]);
        *(uint4*)(mrg + row * 1024 + col0 + bj * 128) = o;
      }
      if (rr + 1 < 8) {
#pragma unroll
        for (int bj = 0; bj < 2; ++bj) { g[bj] = ng[bj]; pv[bj] = npv[bj]; }
      }
    }
  }
};

template <class Epi>
DI void run_gemm(u16* smem, const u16* A, const u16* Bt, int N, int K, const Epi& E, int tid, int bid) {
  pg8::Gemm g{A, Bt, TT, N, K};
  pg8::StaticOrder S;
  S.init(TT, N, (int)gridDim.x, bid);
  pg8::gemm_phase<Epi, pg8::StaticOrder, false>((lds_u8*)smem, g, S, E, nullptr, tid);
}

DI void phase_g1(const Params& p, int which, u16* smem, int tid, int bid) {
  EpiSwiglu E{ws_slab(p, 0)};
  run_gemm(smem, ws_h(p), ws_w(p) + (which ? W2IN : W1IN), 5632, 1024, E, tid, bid);
}
DI void phase_g2(const Params& p, int l, int which, bool first, u16* smem, int tid, int bid) {
  EpiResid E{p.k.in[0], p.k.in[1], p.out, ws_mods(p) + (size_t)(l * 9) * 9216 + (which ? 8 : 2) * 1024, 0.5f, first};
  run_gemm(smem, ws_slab(p, 0), ws_w(p) + (which ? W2OUT : W1OUT), 1024, DFF, E, tid, bid);
}
DI void phase_g3a(const Params& p, u16* smem, int tid, int bid) {
  EpiProjA E{p.ws + WS_SLAB};
  run_gemm(smem, ws_h(p), ws_w(p) + WIN, 2816, 1024, E, tid, bid);
}
DI void phase_g3b(const Params& p, u16* smem, int tid, int bid) {
  EpiProjB E{p.ws + WS_SLAB, (float*)(p.ws + WS_DAB), (u16*)(p.ws + WS_HALO)};
  run_gemm(smem, ws_h(p), ws_w(p) + WIN + (size_t)2816 * 1024, 1792, 1024, E, tid, bid);
}
DI void phase_g3c(const Params& p, u16* smem, int tid, int bid) {
  EpiProjDG E{ws_slab(p, 5)};
  run_gemm(smem, ws_h(p), ws_w(p) + WIN + (size_t)4608 * 1024, 512, 1024, E, tid, bid);
}
DI void phase_mg(const Params& p, u16* smem, int tid, int bid) {
  EpiMG E{ws_slab(p, 3)};
  run_gemm(smem, ws_h(p), ws_w(p) + WIN + (size_t)5120 * 1024, 3072, 1024, E, tid, bid);
}
DI void phase_br(const Params& p, int b, u16* smem, int tid, int bid) {
  EpiBR E{ws_slab(p, 3), ws_h(p), b};
  run_gemm(smem, ws_slab(p, b), ws_w(p) + WBR + (size_t)b * 524288, 1024, 512, E, tid, bid);
}
DI void phase_g5(const Params& p, int l, u16* smem, int tid, int bid) {
  EpiResid E{p.k.in[0], p.k.in[1], p.out, ws_mods(p) + (size_t)(l * 9) * 9216 + 5 * 1024, 1.0f, false};
  run_gemm(smem, ws_h(p), ws_w(p) + WOUT, 1024, 1024, E, tid, bid);
}

DI void phase_prep(const Params& p, int l, int tid, int bid, int nblk) {
  const int lane = tid & 63, hl = lane & 7;
  const int gw = bid * 8 + (tid >> 6), nw = nblk * 8;
  u16* AQ = ws_slab(p, 0); u16* RQ = ws_slab(p, 2); u16* RK = ws_slab(p, 3);
  const u16* KV = ws_slab(p, 6);
  u16* KC = ws_slab(p, 7);
  const float* ROPE = (const float*)(p.ws + WS_ROPE);
  float wq[8], wk[8];
#pragma unroll
  for (int e = 0; e < 8; ++e) { wq[e] = p.k.in[15][l * 64 + hl * 8 + e]; wk[e] = p.k.in[16][l * 64 + hl * 8 + e]; }
  const float sgn = (hl < 4) ? -1.f : 1.f;
  for (int t = gw; t < TT; t += nw) {
    const bool g2 = t >= TI;
    const int s = g2 ? 32 + ((t - TI) >> 12) : (t >> 8);
    const int tl = t - seq_base(s);
    const int S = g2 ? 4352 : 256;
    float cs[8], sn[8];
    if (g2) {
      const int i0 = (hl & 3) * 8;
      const int pos = (i0 < 16) ? (tl >> 6) : (tl & 63);
      const float* rp = ROPE + pos * 16 + (i0 & 15);
      float4 c0 = *(const float4*)rp, c1 = *(const float4*)(rp + 4), s0 = *(const float4*)(rp + 1024), s1 = *(const float4*)(rp + 1028);
      cs[0] = c0.x; cs[1] = c0.y; cs[2] = c0.z; cs[3] = c0.w; cs[4] = c1.x; cs[5] = c1.y; cs[6] = c1.z; cs[7] = c1.w;
      sn[0] = s0.x; sn[1] = s0.y; sn[2] = s0.z; sn[3] = s0.w; sn[4] = s1.x; sn[5] = s1.y; sn[6] = s1.z; sn[7] = s1.w;
    } else {
#pragma unroll
      for (int e = 0; e < 8; ++e) { cs[e] = 1.f; sn[e] = 0.f; }
    }
    const uint4 raw_aq = *(const uint4*)(AQ + (size_t)t * 512 + lane * 8);
    const uint4 raw_kv = (lane < 32) ? *(const uint4*)(KV + (size_t)t * 256 + lane * 8) : uint4{0, 0, 0, 0};
    const uint4 raw_rq = *(const uint4*)(RQ + (size_t)t * 512 + lane * 8);
    const uint4 raw_rk = g2 ? *(const uint4*)(RK + (size_t)t * 512 + lane * 8) : uint4{0, 0, 0, 0};
    {
      u16* pq = AQ + (size_t)t * 512 + lane * 8;
      uint4 raw = raw_aq;
      float x[8] = {bflo(raw.x), bfhi(raw.x), bflo(raw.y), bfhi(raw.y), bflo(raw.z), bfhi(raw.z), bflo(raw.w), bfhi(raw.w)};
      float ss = 0.f;
#pragma unroll
      for (int e = 0; e < 8; ++e) ss += x[e] * x[e];
      ss += __shfl_xor(ss, 1); ss += __shfl_xor(ss, 2); ss += __shfl_xor(ss, 4);
      const float rstd = rsqrtf(ss * (1.f / 64.f) + EPSF);
#pragma unroll
      for (int e = 0; e < 8; ++e) x[e] = x[e] * rstd * wq[e];
      if (g2) {
#pragma unroll
        for (int e = 0; e < 8; ++e) { float pr = __shfl_xor(x[e], 4); x[e] = x[e] * cs[e] + sgn * pr * sn[e]; }
      }
      *(uint4*)pq = uint4{cvtpk(x[0], x[1]), cvtpk(x[2], x[3]), cvtpk(x[4], x[5]), cvtpk(x[6], x[7])};
    }
    if (lane < 32) {
      const int kv = (lane >> 3) & 1;
      uint4 raw = raw_kv;
      float x[8] = {bflo(raw.x), bfhi(raw.x), bflo(raw.y), bfhi(raw.y), bflo(raw.z), bfhi(raw.z), bflo(raw.w), bfhi(raw.w)};
      if (lane < 16) {
        float ss = 0.f;
#pragma unroll
        for (int e = 0; e < 8; ++e) ss += x[e] * x[e];
        ss += __shfl_xor(ss, 1); ss += __shfl_xor(ss, 2); ss += __shfl_xor(ss, 4);
        const float rstd = rsqrtf(ss * (1.f / 64.f) + EPSF);
#pragma unroll
        for (int e = 0; e < 8; ++e) x[e] = x[e] * rstd * wk[e];
        if (!g2) {
          float* oc = p.out + OCK + ((((size_t)s * 2 + l) * 256 + tl) * 2 + kv) * 64 + hl * 8;
          *(float4*)oc = float4{x[0], x[1], x[2], x[3]};
          *(float4*)(oc + 4) = float4{x[4], x[5], x[6], x[7]};
        } else {
#pragma unroll
          for (int e = 0; e < 8; ++e) { float pr = __shfl_xor(x[e], 4); x[e] = x[e] * cs[e] + sgn * pr * sn[e]; }
        }
        *(uint4*)(KC + kv_base(s, kv) + (size_t)tl * 64 + hl * 8) = uint4{cvtpk(x[0], x[1]), cvtpk(x[2], x[3]), cvtpk(x[4], x[5]), cvtpk(x[6], x[7])};
      } else {
        if (!g2) {
          float* oc = p.out + OCV + ((((size_t)s * 2 + l) * 256 + tl) * 2 + kv) * 64 + hl * 8;
          *(float4*)oc = float4{x[0], x[1], x[2], x[3]};
          *(float4*)(oc + 4) = float4{x[4], x[5], x[6], x[7]};
        }
        u16* vt = KC + KC_VT_OFF + kv_base(s, kv) + (size_t)(hl * 8) * S + tl;
        unsigned ru[4] = {raw.x, raw.y, raw.z, raw.w};
#pragma unroll
        for (int e = 0; e < 4; ++e) { vt[(size_t)(2 * e) * S] = (u16)(ru[e] & 0xffffu); vt[(size_t)(2 * e + 1) * S] = (u16)(ru[e] >> 16); }
      }
    }
    {
      u16* pq = RQ + (size_t)t * 512 + lane * 8;
      uint4 raw = raw_rq;
      float x[8] = {bflo(raw.x), bfhi(raw.x), bflo(raw.y), bfhi(raw.y), bflo(raw.z), bfhi(raw.z), bflo(raw.w), bfhi(raw.w)};
      if (g2) {
#pragma unroll
        for (int e = 0; e < 8; ++e) { float pr = __shfl_xor(x[e], 4); x[e] = x[e] * cs[e] + sgn * pr * sn[e]; }
      }
      *(uint4*)pq = uint4{cvtpk(x[0] * 0.125f, x[1] * 0.125f), cvtpk(x[2] * 0.125f, x[3] * 0.125f), cvtpk(x[4] * 0.125f, x[5] * 0.125f), cvtpk(x[6] * 0.125f, x[7] * 0.125f)};
    }
    if (g2) {
      u16* pk = RK + (size_t)t * 512 + lane * 8;
      uint4 raw = raw_rk;
      float x[8] = {bflo(raw.x), bfhi(raw.x), bflo(raw.y), bfhi(raw.y), bflo(raw.z), bfhi(raw.z), bflo(raw.w), bfhi(raw.w)};
#pragma unroll
      for (int e = 0; e < 8; ++e) { float pr = __shfl_xor(x[e], 4); x[e] = x[e] * cs[e] + sgn * pr * sn[e]; }
      *(uint4*)pk = uint4{cvtpk(x[0], x[1]), cvtpk(x[2], x[3]), cvtpk(x[4], x[5]), cvtpk(x[6], x[7])};
    }
  }
  const int gt = bid * NTHREADS + tid, ngt = nblk * NTHREADS;
  for (int idx = gt; idx < 8 * 256 * 2 * 64; idx += ngt) {
    int d = idx & 63, kv = (idx >> 6) & 1, j = (idx >> 7) & 255, b = idx >> 15;
    size_t src = ((((size_t)b * 2 + l) * 256 + j) * 2 + kv) * 64 + d;
    KC[kv_base(32 + b, kv) + (size_t)(4096 + j) * 64 + d] = f2bf(p.k.in[2][src]);
    KC[KC_VT_OFF + kv_base(32 + b, kv) + (size_t)d * 4352 + 4096 + j] = f2bf(p.k.in[3][src]);
  }
}

DI void attn_qk(const u16* cK, const bf16x8 (&qf)[2][2], f32x4 (&st)[2][4], int r, int q) {
  zero_acc<2>(st);
#pragma unroll
  for (int ks = 0; ks < 2; ++ks)
#pragma unroll
    for (int t = 0; t < 4; ++t) {
      bf16x8 a = *(const bf16x8*)(cK + (t * 16 + r) * 72 + ks * 32 + q * 8);
#pragma unroll
      for (int m = 0; m < 2; ++m) st[m][t] = mfma16(a, qf[m][ks], st[m][t]);
    }
}

DI void attn_item(const Params& p, int s, int head, int qt, u16* smem, int tid) {
  const int lane = tid & 63, w = tid >> 6, r = lane & 15, q = lane >> 4;
  const int base = seq_base(s);
  const int S = s < 32 ? 256 : 4352;
  const int kvh = head >> 2;
  const u16* Kc = ws_slab(p, 7) + kv_base(s, kvh);
  const u16* Vt = ws_slab(p, 7) + KC_VT_OFF + kv_base(s, kvh);
  u16* Qb = ws_slab(p, 0);
  const int row0 = base + qt * 256 + w * 32;
  bf16x8 qf[2][2];
#pragma unroll
  for (int m = 0; m < 2; ++m)
#pragma unroll
    for (int ks = 0; ks < 2; ++ks) qf[m][ks] = *(const bf16x8*)(Qb + (size_t)(row0 + m * 16 + r) * 512 + head * 64 + ks * 32 + q * 8);
  f32x4 o[2][4];
  zero_acc<2>(o);
  float mx[2] = {-INFINITY, -INFINITY}, ls[2] = {0.f, 0.f};
  u16* sK = smem;
  u16* sV = smem + 2 * 64 * 72;
  const int nkt = S >> 6;
  const int lrow = tid >> 3, lseg = tid & 7;
  const float c = 0.125f * 1.4426950408889634f;
  const u16* kp = Kc + (size_t)lrow * 64 + lseg * 8;
  const u16* vp0 = Vt + (size_t)lrow * S + lseg * 8;
  const int lofs = lrow * 72 + lseg * 8;
  {
    uint4 k0 = *(const uint4*)kp, k1 = *(const uint4*)(kp + 4096), v0 = *(const uint4*)vp0;
    *(uint4*)(sK + lofs) = k0; *(uint4*)(sK + 4608 + lofs) = k1; *(uint4*)(sV + lofs) = v0;
  }
  uint4 rk = *(const uint4*)(kp + 2 * 4096);
  uint4 rv = *(const uint4*)(vp0 + 64);
  lds_barrier();
  f32x4 stn[2][4];
  attn_qk(sK, qf, stn, r, q);
  lds_barrier();
  for (int kt = 0; kt < nkt; ++kt) {
    if (kt + 2 < nkt) *(uint4*)(sK + (kt & 1) * 4608 + lofs) = rk;
    if (kt + 1 < nkt) *(uint4*)(sV + ((kt + 1) & 1) * 4608 + lofs) = rv;
    if (kt + 3 < nkt) rk = *(const uint4*)(kp + (size_t)(kt + 3) * 4096);
    if (kt + 2 < nkt) rv = *(const uint4*)(vp0 + (kt + 2) * 64);
    const u16* nK = sK + ((kt + 1) & 1) * 4608;
    const u16* cV = sV + (kt & 1) * 4608;
    f32x4 st[2][4];
#pragma unroll
    for (int m = 0; m < 2; ++m)
#pragma unroll
      for (int t = 0; t < 4; ++t) { st[m][t] = stn[m][t]; stn[m][t] = f32x4{0.f, 0.f, 0.f, 0.f}; }
#pragma unroll
    for (int ks = 0; ks < 2; ++ks) {
      bf16x8 kf[4];
#pragma unroll
      for (int t = 0; t < 4; ++t) kf[t] = *(const bf16x8*)(nK + (t * 16 + r) * 72 + ks * 32 + q * 8);
      __builtin_amdgcn_sched_barrier(0);
#pragma unroll
      for (int t = 0; t < 4; ++t)
#pragma unroll
        for (int m = 0; m < 2; ++m) stn[m][t] = mfma16(kf[t], qf[m][ks], stn[m][t]);
      __builtin_amdgcn_sched_barrier(0);
    }
#pragma unroll
    for (int m = 0; m < 2; ++m) {
      float rm = fmaxf(fmaxf(st[m][0][0], st[m][0][1]), fmaxf(st[m][0][2], st[m][0][3]));
#pragma unroll
      for (int t = 1; t < 4; ++t) { rm = fmaxf(fmaxf(rm, st[m][t][0]), st[m][t][1]); rm = fmaxf(fmaxf(rm, st[m][t][2]), st[m][t][3]); }
      rm = fmaxf(rm, __shfl_xor(rm, 16));
      rm = fmaxf(rm, __shfl_xor(rm, 32));
      const float mnew = fmaxf(mx[m], rm);
      const float alpha = __builtin_amdgcn_exp2f((mx[m] - mnew) * c);
      mx[m] = mnew;
      const f32x2_t c2 = {c, c}, mc2 = {mnew * c, mnew * c};
      f32x2_t ps2 = {0.f, 0.f};
#pragma unroll
      for (int t = 0; t < 4; ++t)
#pragma unroll
        for (int jp = 0; jp < 2; ++jp) {
          f32x2_t v = {st[m][t][2 * jp], st[m][t][2 * jp + 1]};
          v = v * c2 - mc2;
          v.x = __builtin_amdgcn_exp2f(v.x); v.y = __builtin_amdgcn_exp2f(v.y);
          ps2 += v;
          st[m][t][2 * jp] = v.x; st[m][t][2 * jp + 1] = v.y;
        }
      ls[m] = ls[m] * alpha + ps2.x + ps2.y;
#pragma unroll
      for (int dt = 0; dt < 4; ++dt) o[m][dt] = o[m][dt] * alpha;
    }
#pragma unroll
    for (int kb = 0; kb < 2; ++kb) {
      bf16x8 vf[4];
#pragma unroll
      for (int dt = 0; dt < 4; ++dt) {
        const u16* vp = cV + (dt * 16 + r) * 72 + kb * 32 + 4 * q;
        uint2 lo = *(const uint2*)vp, hi = *(const uint2*)(vp + 16);
        vf[dt] = __builtin_bit_cast(bf16x8, uint4{lo.x, lo.y, hi.x, hi.y});
      }
      bf16x8 pb[2];
#pragma unroll
      for (int m = 0; m < 2; ++m) {
        uint4 u = uint4{cvtpk(st[m][2 * kb][0], st[m][2 * kb][1]), cvtpk(st[m][2 * kb][2], st[m][2 * kb][3]),
                        cvtpk(st[m][2 * kb + 1][0], st[m][2 * kb + 1][1]), cvtpk(st[m][2 * kb + 1][2], st[m][2 * kb + 1][3])};
        pb[m] = __builtin_bit_cast(bf16x8, u);
      }
      __builtin_amdgcn_sched_barrier(0);
#pragma unroll
      for (int dt = 0; dt < 4; ++dt)
#pragma unroll
        for (int m = 0; m < 2; ++m) o[m][dt] = mfma16(vf[dt], pb[m], o[m][dt]);
      __builtin_amdgcn_sched_barrier(0);
    }
    lds_barrier();
  }
#pragma unroll
  for (int m = 0; m < 2; ++m) {
    float l = ls[m];
    l += __shfl_xor(l, 16);
    l += __shfl_xor(l, 32);
    const float inv = 1.f / l;
#pragma unroll
    for (int dt = 0; dt < 4; ++dt)
      *(uint2*)(Qb + (size_t)(row0 + m * 16 + r) * 512 + head * 64 + dt * 16 + 4 * q) =
          uint2{cvtpk(o[m][dt][0] * inv, o[m][dt][1] * inv), cvtpk(o[m][dt][2] * inv, o[m][dt][3] * inv)};
  }
}

DI void ret_stage(u16* Qs, u16* Ks, u16* Kdt, u16* Vt, int row, int seg, const uint4& qv, const uint4& kv, const uint4& vv, float kdec) {
  *(uint4*)(Qs + row * 72 + seg * 8) = qv;
  *(uint4*)(Ks + row * 72 + seg * 8) = kv;
  u16* kd = Kdt + (seg * 8) * 72 + row;
  u16* vt = Vt + (seg * 8) * 72 + row;
  kd[0 * 72] = f2bf(bflo(kv.x) * kdec); kd[1 * 72] = f2bf(bfhi(kv.x) * kdec);
  kd[2 * 72] = f2bf(bflo(kv.y) * kdec); kd[3 * 72] = f2bf(bfhi(kv.y) * kdec);
  kd[4 * 72] = f2bf(bflo(kv.z) * kdec); kd[5 * 72] = f2bf(bfhi(kv.z) * kdec);
  kd[6 * 72] = f2bf(bflo(kv.w) * kdec); kd[7 * 72] = f2bf(bfhi(kv.w) * kdec);
  vt[0 * 72] = (u16)(vv.x & 0xffffu); vt[1 * 72] = (u16)(vv.x >> 16);
  vt[2 * 72] = (u16)(vv.y & 0xffffu); vt[3 * 72] = (u16)(vv.y >> 16);
  vt[4 * 72] = (u16)(vv.z & 0xffffu); vt[5 * 72] = (u16)(vv.z >> 16);
  vt[6 * 72] = (u16)(vv.w & 0xffffu); vt[7 * 72] = (u16)(vv.w >> 16);
}

DI void ret_rowwise(const float* Os, u16* RO, int t, int h, int ct, bool fin, const uint4& f0, const uint4& f1, const uint4& f2, const uint4& f3, const float (&rw)[16]) {
  const int row = ct >> 2, c4 = ct & 3;
  float x[16];
#pragma unroll
  for (int e4 = 0; e4 < 4; ++e4) {
    float4 v = *(const float4*)(Os + row * 68 + c4 * 16 + e4 * 4);
    x[e4 * 4] = v.x; x[e4 * 4 + 1] = v.y; x[e4 * 4 + 2] = v.z; x[e4 * 4 + 3] = v.w;
  }
  u16* po = RO + (size_t)t * 512 + h * 64 + c4 * 16;
  if (fin) {
    const unsigned pu[8] = {f0.x, f0.y, f0.z, f0.w, f1.x, f1.y, f1.z, f1.w};
    const unsigned gu[8] = {f2.x, f2.y, f2.z, f2.w, f3.x, f3.y, f3.z, f3.w};
    float s1 = 0.f;
#pragma unroll
    for (int e = 0; e < 8; ++e) { x[2 * e] += bflo(pu[e]); x[2 * e + 1] += bfhi(pu[e]); s1 += x[2 * e] + x[2 * e + 1]; }
    s1 += __shfl_xor(s1, 1); s1 += __shfl_xor(s1, 2);
    const float mu = s1 * (1.f / 64.f);
    float s2 = 0.f;
#pragma unroll
    for (int e = 0; e < 16; ++e) { float d = x[e] - mu; s2 += d * d; }
    s2 += __shfl_xor(s2, 1); s2 += __shfl_xor(s2, 2);
    const float rs = rsqrtf(s2 * (1.f / 64.f) + EPSF);
#pragma unroll
    for (int e = 0; e < 8; ++e) {
      x[2 * e] = (x[2 * e] - mu) * rs * rw[2 * e] * silu_f(bflo(gu[e]));
      x[2 * e + 1] = (x[2 * e + 1] - mu) * rs * rw[2 * e + 1] * silu_f(bfhi(gu[e]));
    }
  }
  *(uint4*)po = uint4{cvtpk(x[0], x[1]), cvtpk(x[2], x[3]), cvtpk(x[4], x[5]), cvtpk(x[6], x[7])};
  *(uint4*)(po + 8) = uint4{cvtpk(x[8], x[9]), cvtpk(x[10], x[11]), cvtpk(x[12], x[13]), cvtpk(x[14], x[15])};
}

DI void ret_item(const Params& p, int l, int s, int h, u16* smem, int tid) {
  const int lane = tid & 63, r = lane & 15, q = lane >> 4;
  const int dir = tid >> 8, ct = tid & 255, wv = (tid >> 6) & 3;
  const int base = seq_base(s), len = seq_len(s), N = len >> 6;
  const bool g2 = s >= 32;
  const float lg = log1pf(-exp2f(-(dir ? 5.5f : 5.0f) - (float)h));
  u16* cs = smem + dir * 36352;
  u16* Qs = cs; u16* Ks = cs + 4608; u16* Vt = cs + 2 * 4608; u16* Kdt = cs + 3 * 4608; u16* Ps = cs + 4 * 4608; u16* St = cs + 5 * 4608;
  float* Os = (float*)(cs + 6 * 4608);
  const u16* RQ = ws_slab(p, 2); const u16* RK = ws_slab(p, 3); const u16* RV = ws_slab(p, 4); const u16* RG = ws_slab(p, 5);
  u16* RO = ws_slab(p, 1);
  f32x4 accS[4];
#pragma unroll
  for (int n = 0; n < 4; ++n)
#pragma unroll
    for (int j = 0; j < 4; ++j) {
      float v0 = 0.f;
      if (g2) v0 = p.k.in[4][(((((size_t)(s - 32) * 2 + l) * 2 + dir) * 8 + h) * 64 + (n * 16 + r)) * 64 + (wv * 16 + q * 4 + j)];
      accS[n][j] = v0;
      St[(wv * 16 + q * 4 + j) * 72 + n * 16 + r] = f2bf(v0);
    }
  const float cdec = __expf(lg * 64.f);
  float rw[16];
  {
    const float* rnw = p.k.in[17] + l * 512 + h * 64 + (ct & 3) * 16;
#pragma unroll
    for (int e = 0; e < 16; ++e) rw[e] = rnw[e];
  }
  float rowf[4], colf[4], qdf[4];
#pragma unroll
  for (int j = 0; j < 4; ++j) {
    rowf[j] = __expf(lg * (float)(wv * 16 + q * 4 + j)); colf[j] = __expf(-lg * (float)(j * 16 + r));
    qdf[j] = __expf(lg * (float)(wv * 16 + q * 4 + j + 1));
  }
  uint4 pq0, pq1, pk0, pk1, pv0, pv1;
  {
    const int t = base + (dir ? len - 1 - lane : lane);
    const size_t off0 = (size_t)t * 512 + h * 64 + wv * 8, off1 = off0 + 32;
    pq0 = *(const uint4*)(RQ + off0); pk0 = *(const uint4*)(RK + off0); pv0 = *(const uint4*)(RV + off0);
    pq1 = *(const uint4*)(RQ + off1); pk1 = *(const uint4*)(RK + off1); pv1 = *(const uint4*)(RV + off1);
  }
  const float kdec = __expf(lg * (float)(63 - lane));
  uint4 f0 = uint4{0, 0, 0, 0}, f1 = f0, f2 = f0, f3 = f0;
  const int erow = ct >> 2;
  for (int n = 0; n < N; ++n) {
    if (n > 0) {
      const int pp = (n - 1) * 64 + erow;
      ret_rowwise(Os, RO, base + (dir ? len - 1 - pp : pp), h, ct, (n - 1) >= (N >> 1), f0, f1, f2, f3, rw);
    }
    ret_stage(Qs, Ks, Kdt, Vt, lane, wv, pq0, pk0, pv0, kdec);
    ret_stage(Qs, Ks, Kdt, Vt, lane, wv + 4, pq1, pk1, pv1, kdec);
    if (n + 1 < N) {
      const int pp = (n + 1) * 64 + lane;
      const int t = base + (dir ? len - 1 - pp : pp);
      const size_t off0 = (size_t)t * 512 + h * 64 + wv * 8, off1 = off0 + 32;
      pq0 = *(const uint4*)(RQ + off0); pk0 = *(const uint4*)(RK + off0); pv0 = *(const uint4*)(RV + off0);
      pq1 = *(const uint4*)(RQ + off1); pk1 = *(const uint4*)(RK + off1); pv1 = *(const uint4*)(RV + off1);
    }
    if (n == (N >> 1)) __syncthreads(); else lds_barrier();
    if (n >= (N >> 1)) {
      const int pp = n * 64 + erow;
      const int t = base + (dir ? len - 1 - pp : pp);
      const size_t off = (size_t)t * 512 + h * 64 + (ct & 3) * 16;
      f0 = *(const uint4*)(RO + off); f1 = *(const uint4*)(RO + off + 8);
      f2 = *(const uint4*)(RG + off); f3 = *(const uint4*)(RG + off + 8);
    }
    f32x4 sa[4];
#pragma unroll
    for (int nn = 0; nn < 4; ++nn) sa[nn] = f32x4{0.f, 0.f, 0.f, 0.f};
    wave_mma<4, 2>(Qs, 72, wv * 16, Ks, 72, 0, sa, lane);
#pragma unroll
    for (int nn = 0; nn < 4; ++nn)
#pragma unroll
      for (int j = 0; j < 4; ++j) {
        int i = wv * 16 + q * 4 + j, jj = nn * 16 + r;
        float pv = (i >= jj) ? sa[nn][j] * (rowf[j] * colf[nn]) : 0.f;
        Ps[i * 72 + jj] = f2bf(pv);
      }
    f32x4 a1[4], a2[4];
#pragma unroll
    for (int nn = 0; nn < 4; ++nn) { a1[nn] = f32x4{0.f, 0.f, 0.f, 0.f}; a2[nn] = f32x4{0.f, 0.f, 0.f, 0.f}; }
    wave_mma<4, 2>(Ps, 72, wv * 16, Vt, 72, 0, a1, lane);
    wave_mma<4, 2>(Qs, 72, wv * 16, St, 72, 0, a2, lane);
#pragma unroll
    for (int j = 0; j < 4; ++j)
#pragma unroll
      for (int nn = 0; nn < 4; ++nn) Os[(wv * 16 + q * 4 + j) * 68 + nn * 16 + r] = a1[nn][j] + qdf[j] * a2[nn][j];
#pragma unroll
    for (int nn = 0; nn < 4; ++nn)
#pragma unroll
      for (int j = 0; j < 4; ++j) accS[nn][j] *= cdec;
    wave_mma<4, 2>(Vt, 72, wv * 16, Kdt, 72, 0, accS, lane);
    lds_barrier();
#pragma unroll
    for (int nn = 0; nn < 4; ++nn)
#pragma unroll
      for (int j = 0; j < 4; ++j) St[(wv * 16 + q * 4 + j) * 72 + nn * 16 + r] = f2bf(accS[nn][j]);
  }
  {
    const int pp = (N - 1) * 64 + erow;
    ret_rowwise(Os, RO, base + (dir ? len - 1 - pp : pp), h, ct, true, f0, f1, f2, f3, rw);
  }
  if (!g2) {
#pragma unroll
    for (int nn = 0; nn < 4; ++nn)
#pragma unroll
      for (int j = 0; j < 4; ++j)
        p.out[OSR + (((((size_t)s * 2 + l) * 2 + dir) * 8 + h) * 64 + (nn * 16 + r)) * 64 + (wv * 16 + q * 4 + j)] = accS[nn][j];
  }
  lds_barrier();
}

constexpr int ATT_X1 = 320;
DI void phase_mix1(const Params& p, int l, u16* smem, int* s_item, int tid) {
  int* ctr = (int*)(p.ws + WS_CTR) + l * 4;
  while (true) {
    if (tid == 0) *s_item = atomicAdd(ctr, 1);
    lds_barrier();
    const int it = *s_item;
    lds_barrier();
    if (it >= 64 + ATT_X1 + 512) break;
    int kind, s, h, qt = 0;
    if (it < 64) { kind = 0; s = 32 + (it >> 3); h = it & 7; }
    else if (it < 64 + ATT_X1) { int a = it - 64; kind = 1; s = 32 + (a >> 7); h = (a >> 4) & 7; qt = a & 15; }
    else if (it < 64 + ATT_X1 + 256) { int a = it - 64 - ATT_X1; kind = 0; s = a >> 3; h = a & 7; }
    else { int a = it - 64 - ATT_X1 - 256; kind = 1; s = a >> 3; h = a & 7; }
#ifdef PROBE_MAX
    unsigned long long tb_ = wall_clock64();
#endif
    if (kind == 0) ret_item(p, l, s, h, smem, tid);
    else attn_item(p, s, h, qt, smem, tid);
#ifdef PROBE_MAX
    if (tid == 0 && kind == (PROBE_MAX)) atomicMax((int*)(p.ws + WS_CTR) + 32 + l, (int)(wall_clock64() - tb_));
#endif
  }
}

DI void dn_pre_item(const Params& p, int l, int cgk, int h, u16* smem, int tid) {
  const int lane = tid & 63, w = tid >> 6, r = lane & 15, q = lane >> 4;
  u16* Ks = smem;
  float* sKK = (float*)(smem + 64 * 136);
  float* sA = sKK + 64 * 65;
  float* sX = sA + 2 * 4096;
  float* sg = sX + 2 * 64 * 68;
  float* sb = sg + 128;
  float* sG = sb + 128;
  const int t0 = cgk * 64;
  const int s = t0 < TI ? (t0 >> 8) : 32 + ((t0 - TI) >> 12);
  const int base = seq_base(s), len = seq_len(s);
  const u16* HALO = (const u16*)(p.ws + WS_HALO);
  float pre_da = 0.f, pre_db = 0.f;
  if (tid < 128) {
    const int dir_ = tid >> 6, i_ = tid & 63;
    const int t_ = t0 + (dir_ ? 63 - i_ : i_);
    const float* DAB_ = (const float*)(p.ws + WS_DAB);
    pre_da = DAB_[(size_t)t_ * 16 + dir_ * 4 + h]; pre_db = DAB_[(size_t)t_ * 16 + 8 + dir_ * 4 + h];
  }
  {
    const int rr = tid >> 3, cseg = tid & 7;
    const int t = t0 + rr;
    const int col0 = h * 128 + cseg * 16;
    unsigned res[3][8];
#pragma unroll
    for (int xi = 0; xi < 3; ++xi) {
      const u16* X = ws_slab(p, 2 + xi);
      uint4 c0 = *(const uint4*)(X + (size_t)t * 512 + col0), c1 = *(const uint4*)(X + (size_t)t * 512 + col0 + 8);
      uint4 p0 = uint4{0, 0, 0, 0}, p1 = p0, n0 = p0, n1 = p0;
      if (t > base) {
        const u16* src = (rr > 0) ? X + (size_t)(t - 1) * 512 + col0 : HALO + ((size_t)(cgk - 1) * 2 + 1) * 1536 + xi * 512 + col0;
        p0 = *(const uint4*)src; p1 = *(const uint4*)(src + 8);
      }
      if (t + 1 < base + len) {
        const u16* src = (rr < 63) ? X + (size_t)(t + 1) * 512 + col0 : HALO + ((size_t)(cgk + 1) * 2 + 0) * 1536 + xi * 512 + col0;
        n0 = *(const uint4*)src; n1 = *(const uint4*)(src + 8);
      }
      const float* cw = p.k.in[18] + (size_t)l * 3 * 1536 + xi * 512 + col0;
      unsigned cu[8] = {c0.x, c0.y, c0.z, c0.w, c1.x, c1.y, c1.z, c1.w};
      unsigned pu[8] = {p0.x, p0.y, p0.z, p0.w, p1.x, p1.y, p1.z, p1.w};
      unsigned nu[8] = {n0.x, n0.y, n0.z, n0.w, n1.x, n1.y, n1.z, n1.w};
      float y[16];
      float ss = 0.f;
#pragma unroll
      for (int e = 0; e < 8; ++e) {
        float a0 = cw[2 * e] * bflo(pu[e]) + cw[1536 + 2 * e] * bflo(cu[e]) + cw[3072 + 2 * e] * bflo(nu[e]);
        float a1 = cw[2 * e + 1] * bfhi(pu[e]) + cw[1536 + 2 * e + 1] * bfhi(cu[e]) + cw[3072 + 2 * e + 1] * bfhi(nu[e]);
        a0 = silu_f(a0); a1 = silu_f(a1);
        y[2 * e] = a0; y[2 * e + 1] = a1;
        ss += a0 * a0 + a1 * a1;
      }
      if (xi < 2) {
        ss += __shfl_xor(ss, 1); ss += __shfl_xor(ss, 2); ss += __shfl_xor(ss, 4);
        float rn = rsqrtf(ss + EPSF) * (xi == 0 ? 0.08838834764831845f : 1.f);
#pragma unroll
        for (int e = 0; e < 16; ++e) y[e] *= rn;
      }
#pragma unroll
      for (int e = 0; e < 8; ++e) res[xi][e] = cvtpk(y[2 * e], y[2 * e + 1]);
    }
    *(uint4*)(Ks + rr * 136 + cseg * 16) = uint4{res[1][0], res[1][1], res[1][2], res[1][3]};
    *(uint4*)(Ks + rr * 136 + cseg * 16 + 8) = uint4{res[1][4], res[1][5], res[1][6], res[1][7]};
    __syncthreads();
#pragma unroll
    for (int xi = 0; xi < 3; ++xi) {
      u16* X = ws_slab(p, 2 + xi);
      *(uint4*)(X + (size_t)t * 512 + col0) = uint4{res[xi][0], res[xi][1], res[xi][2], res[xi][3]};
      *(uint4*)(X + (size_t)t * 512 + col0 + 8) = uint4{res[xi][4], res[xi][5], res[xi][6], res[xi][7]};
    }
  }
  const float* DAB = (const float*)(p.ws + WS_DAB);
  float* GBG = (float*)(p.ws + WS_GBG);
  float* GBB = (float*)(p.ws + WS_GBB);
  if (tid < 128) {
    int dir = tid >> 6, i = tid & 63;
    int t = t0 + (dir ? 63 - i : i);
    float da = pre_da, db = pre_db;
    float x = da + p.k.in[20][l * 8 + dir * 4 + h];
    float sp = (x > 20.f) ? x : log1pf(expf(x));
    sg[tid] = -expf(p.k.in[19][l * 8 + dir * 4 + h]) * sp;
    sb[tid] = 1.f / (1.f + expf(-db));
  }
  lds_barrier();
  if (tid < 128) {
    float x = sg[tid];
#pragma unroll
    for (int o = 1; o < 64; o <<= 1) { float y = __shfl_up(x, o); if ((tid & 63) >= o) x += y; }
    sG[tid] = x;
  }
  {
    f32x4 kk[2];
    kk[0] = f32x4{0.f, 0.f, 0.f, 0.f}; kk[1] = kk[0];
    wave_mma<2, 4>(Ks, 136, (w >> 1) * 16, Ks, 136, (w & 1) * 32, kk, lane);
#pragma unroll
    for (int nn = 0; nn < 2; ++nn)
#pragma unroll
      for (int j = 0; j < 4; ++j) sKK[((w >> 1) * 16 + q * 4 + j) * 65 + (w & 1) * 32 + nn * 16 + r] = kk[nn][j];
  }
  lds_barrier();
  if (tid < 128) {
    int dir = tid >> 6, i = tid & 63;
    int t = t0 + (dir ? 63 - i : i);
    GBG[(size_t)t * 8 + dir * 4 + h] = sG[tid];
    GBB[(size_t)t * 8 + dir * 4 + h] = sb[tid];
  }
  for (int idx = tid; idx < 2 * 4096; idx += NTHREADS) {
    int dir = idx >> 12, i = (idx >> 6) & 63, j = idx & 63;
    int ri = dir ? 63 - i : i, rj = dir ? 63 - j : j;
    float a = 0.f;
    if (i > j) a = sb[dir * 64 + i] * sKK[ri * 65 + rj] * __expf(sG[dir * 64 + i] - sG[dir * 64 + j]);
    sA[idx] = a;
  }
  lds_barrier();
  {
    const int dir = tid >> 8, c = (tid >> 2) & 63, sl = tid & 3;
    const float* ar = sA + dir * 4096 + sl * 16;
    float x[16];
#pragma unroll
    for (int jj = 0; jj < 16; ++jj) x[jj] = (sl * 16 + jj == c) ? 1.f : 0.f;
    float4 an[4];
#pragma unroll
    for (int k = 0; k < 4; ++k) an[k] = *(const float4*)(ar + 64 + 4 * k);
    int ro = 64;
#pragma unroll
    for (int i = 1; i < 64; ++i) {
      float4 a4[4];
#pragma unroll
      for (int k = 0; k < 4; ++k) a4[k] = an[k];
      if (i + 1 < 64) {
        ro += 64;
        asm volatile("" : "+v"(ro));
#pragma unroll
        for (int k = 0; k < 4; ++k) an[k] = *(const float4*)(ar + ro + 4 * k);
      }
      __builtin_amdgcn_sched_barrier(0);
      float s0 = 0.f, s1 = 0.f;
#pragma unroll
      for (int k = 0; k < 4; ++k) {
        s0 += a4[k].x * x[4 * k] + a4[k].z * x[4 * k + 2];
        s1 += a4[k].y * x[4 * k + 1] + a4[k].w * x[4 * k + 3];
      }
      float tot = s0 + s1;
      tot += __builtin_bit_cast(float, __builtin_amdgcn_update_dpp(0, __builtin_bit_cast(int, tot), 0xB1, 0xF, 0xF, false));
      tot += __builtin_bit_cast(float, __builtin_amdgcn_update_dpp(0, __builtin_bit_cast(int, tot), 0x4E, 0xF, 0xF, false));
      x[i & 15] = (sl == (i >> 4)) ? x[i & 15] - tot : x[i & 15];
      __builtin_amdgcn_sched_barrier(0);
    }
    u16* TM = ws_slab(p, 5) + (((size_t)cgk * 4 + h) * 2 + dir) * 4096 + (size_t)(sl * 16) * 64 + c;
#pragma unroll
    for (int jj = 0; jj < 16; ++jj) TM[jj * 64] = f2bf(x[jj]);
  }
  lds_barrier();
}

DI void phase_dn_pre(const Params& p, int l, u16* smem, int tid, int bid, int nblk) {
  for (int it = bid; it < 640 * 4; it += nblk) dn_pre_item(p, l, it >> 2, it & 3, smem, tid);
}

DI void dn_scan_item(const Params& p, int l, int s, int h, int dir, u16* smem, int tid) {
  const int lane = tid & 63, w = tid >> 6, r = lane & 15, q = lane >> 4;
  u16* Qs = smem;
  u16* Ks = Qs + 8704;
  u16* Kdt = Ks + 8704;
  u16* Rt = Kdt + 9216;
  u16* Vnt = Rt + 9216;
  u16* St = Vnt + 9216;
  u16* Tms = St + 17408;
  u16* Atm = Tms + 4608;
  float* sG = (float*)(Atm + 4608);
  float* sB = sG + 64;
  float* sEG = sB + 64;
  u16* Os = (u16*)(sEG + 64);
  const int base = seq_base(s), len = seq_len(s), N = len >> 6;
  const bool g2 = s >= 32;
  const u16* DQ = ws_slab(p, 2); const u16* DK = ws_slab(p, 3); const u16* DV = ws_slab(p, 4);
  const u16* TM = ws_slab(p, 5);
  u16* OUT = ws_slab(p, dir ? 8 : 6);
  const float* GBG = (const float*)(p.ws + WS_GBG);
  const float* GBB = (const float*)(p.ws + WS_GBB);
  const int mP = w >> 1, nP0 = (w & 1) * 4;
  f32x4 ST[8];
#pragma unroll
  for (int n = 0; n < 8; ++n)
#pragma unroll
    for (int j = 0; j < 4; ++j) {
      float v0 = 0.f;
      if (g2) v0 = p.k.in[5][(((((size_t)(s - 32) * 2 + l) * 2 + dir) * 4 + h) * 128 + (n * 16 + r)) * 128 + (w * 16 + q * 4 + j)];
      ST[n][j] = v0;
      St[(w * 16 + q * 4 + j) * 136 + n * 16 + r] = f2bf(v0);
    }
  uint4 pq0, pq1, pk0, pk1, pv0, pv1, ptm;
  float pgrow, pglast, pbeta;
  {
    const int cg0 = (base >> 6) + (dir ? N - 1 : 0);
    const int t = base + (dir ? len - 1 - lane : lane);
    const int tlast = base + (dir ? len - 1 - 63 : 63);
    const size_t off = (size_t)t * 512 + h * 128 + w * 16;
    pq0 = *(const uint4*)(DQ + off); pq1 = *(const uint4*)(DQ + off + 8);
    pk0 = *(const uint4*)(DK + off); pk1 = *(const uint4*)(DK + off + 8);
    pv0 = *(const uint4*)(DV + off); pv1 = *(const uint4*)(DV + off + 8);
    ptm = *(const uint4*)(TM + (((size_t)cg0 * 4 + h) * 2 + dir) * 4096 + lane * 64 + w * 8);
    pgrow = GBG[(size_t)t * 8 + dir * 4 + h]; pglast = GBG[(size_t)tlast * 8 + dir * 4 + h]; pbeta = GBB[(size_t)t * 8 + dir * 4 + h];
  }
  const int orow = tid >> 3, oseg = tid & 7;
  for (int n = 0; n < N; ++n) {
    if (n > 0) {
      const int pp = (n - 1) * 64 + orow;
      const int t = base + (dir ? len - 1 - pp : pp);
      const uint4 o0 = *(const uint4*)(Os + orow * 136 + oseg * 16), o1 = *(const uint4*)(Os + orow * 136 + oseg * 16 + 8);
      *(uint4*)(OUT + (size_t)t * 512 + h * 128 + oseg * 16) = o0;
      *(uint4*)(OUT + (size_t)t * 512 + h * 128 + oseg * 16 + 8) = o1;
    }
    {
      const int row = lane, seg = w;
      *(uint4*)(Qs + row * 136 + seg * 16) = pq0; *(uint4*)(Qs + row * 136 + seg * 16 + 8) = pq1;
      *(uint4*)(Ks + row * 136 + seg * 16) = pk0; *(uint4*)(Ks + row * 136 + seg * 16 + 8) = pk1;
      const float kd = __expf(pglast - pgrow);
      unsigned ku[8] = {pk0.x, pk0.y, pk0.z, pk0.w, pk1.x, pk1.y, pk1.z, pk1.w};
      unsigned vu[8] = {pv0.x, pv0.y, pv0.z, pv0.w, pv1.x, pv1.y, pv1.z, pv1.w};
#pragma unroll
      for (int e = 0; e < 8; ++e) {
        Kdt[(seg * 16 + 2 * e) * 72 + row] = f2bf(bflo(ku[e]) * kd);
        Kdt[(seg * 16 + 2 * e + 1) * 72 + row] = f2bf(bfhi(ku[e]) * kd);
        Rt[(seg * 16 + 2 * e) * 72 + row] = (u16)(vu[e] & 0xffffu);
        Rt[(seg * 16 + 2 * e + 1) * 72 + row] = (u16)(vu[e] >> 16);
      }
      *(uint4*)(Tms + row * 72 + seg * 8) = ptm;
      if (w == 0) { sG[lane] = pgrow; sEG[lane] = __expf(pgrow); sB[lane] = pbeta; }
      if (n + 1 < N) {
        const int cgn = (base >> 6) + (dir ? N - 2 - n : n + 1);
        const int pp = (n + 1) * 64 + lane;
        const int t = base + (dir ? len - 1 - pp : pp);
        const int tlast = base + (dir ? len - 1 - ((n + 1) * 64 + 63) : (n + 1) * 64 + 63);
        const size_t off = (size_t)t * 512 + h * 128 + w * 16;
        pq0 = *(const uint4*)(DQ + off); pq1 = *(const uint4*)(DQ + off + 8);
        pk0 = *(const uint4*)(DK + off); pk1 = *(const uint4*)(DK + off + 8);
        pv0 = *(const uint4*)(DV + off); pv1 = *(const uint4*)(DV + off + 8);
        ptm = *(const uint4*)(TM + (((size_t)cgn * 4 + h) * 2 + dir) * 4096 + lane * 64 + w * 8);
        pgrow = GBG[(size_t)t * 8 + dir * 4 + h]; pglast = GBG[(size_t)tlast * 8 + dir * 4 + h]; pbeta = GBB[(size_t)t * 8 + dir * 4 + h];
      }
    }
    lds_barrier();
    f32x4 p1[4], qs[4], at[2];
#pragma unroll
    for (int nn = 0; nn < 4; ++nn) { p1[nn] = f32x4{0.f, 0.f, 0.f, 0.f}; qs[nn] = p1[nn]; }
    at[0] = f32x4{0.f, 0.f, 0.f, 0.f}; at[1] = at[0];
    wave_mma<4, 4>(Ks, 136, mP * 16, St, 136, nP0 * 16, p1, lane);
    wave_mma<4, 4>(Qs, 136, mP * 16, St, 136, nP0 * 16, qs, lane);
    wave_mma<2, 4>(Qs, 136, mP * 16, Ks, 136, (w & 1) * 32, at, lane);
    const int i0 = mP * 16 + q * 4;
    float bi[4], egi[4], gi[4];
#pragma unroll
    for (int j = 0; j < 4; ++j) { bi[j] = sB[i0 + j]; egi[j] = sEG[i0 + j]; gi[j] = sG[i0 + j]; }
#pragma unroll
    for (int nn = 0; nn < 4; ++nn) {
      const int v = (nP0 + nn) * 16 + r;
      uint2 raw = *(const uint2*)(Rt + v * 72 + i0);
      float f0 = bi[0] * (bflo(raw.x) - egi[0] * p1[nn][0]);
      float f1 = bi[1] * (bfhi(raw.x) - egi[1] * p1[nn][1]);
      float f2 = bi[2] * (bflo(raw.y) - egi[2] * p1[nn][2]);
      float f3 = bi[3] * (bfhi(raw.y) - egi[3] * p1[nn][3]);
      *(uint2*)(Rt + v * 72 + i0) = uint2{cvtpk(f0, f1), cvtpk(f2, f3)};
    }
#pragma unroll
    for (int nn = 0; nn < 2; ++nn) {
      const int jj = (w & 1) * 32 + nn * 16 + r;
      const float gj = sG[jj];
#pragma unroll
      for (int j = 0; j < 4; ++j) {
        int i = i0 + j;
        float val = (i >= jj) ? at[nn][j] * __expf(gi[j] - gj) : 0.f;
        Atm[i * 72 + jj] = f2bf(val);
      }
    }
    lds_barrier();
    f32x4 vn[4];
#pragma unroll
    for (int nn = 0; nn < 4; ++nn) vn[nn] = f32x4{0.f, 0.f, 0.f, 0.f};
    wave_mma<4, 2>(Tms, 72, mP * 16, Rt, 72, nP0 * 16, vn, lane);
#pragma unroll
    for (int nn = 0; nn < 4; ++nn) {
      const int v = (nP0 + nn) * 16 + r;
      *(uint2*)(Vnt + v * 72 + i0) = uint2{cvtpk(vn[nn][0], vn[nn][1]), cvtpk(vn[nn][2], vn[nn][3])};
    }
    lds_barrier();
#pragma unroll
    for (int nn = 0; nn < 4; ++nn)
#pragma unroll
      for (int j = 0; j < 4; ++j) qs[nn][j] *= egi[j];
    wave_mma<4, 2>(Atm, 72, mP * 16, Vnt, 72, nP0 * 16, qs, lane);
#pragma unroll
    for (int j = 0; j < 4; ++j)
#pragma unroll
      for (int nn = 0; nn < 4; ++nn) Os[(i0 + j) * 136 + (nP0 + nn) * 16 + r] = f2bf(qs[nn][j]);
    const float egl = sEG[63];
#pragma unroll
    for (int n8 = 0; n8 < 8; ++n8)
#pragma unroll
      for (int j = 0; j < 4; ++j) ST[n8][j] *= egl;
    wave_mma<8, 2>(Vnt, 72, w * 16, Kdt, 72, 0, ST, lane);
#pragma unroll
    for (int n8 = 0; n8 < 8; ++n8)
#pragma unroll
      for (int j = 0; j < 4; ++j) St[(w * 16 + q * 4 + j) * 136 + n8 * 16 + r] = f2bf(ST[n8][j]);
    lds_barrier();
  }
  {
    const int pp = (N - 1) * 64 + orow;
    const int t = base + (dir ? len - 1 - pp : pp);
    const uint4 o0 = *(const uint4*)(Os + orow * 136 + oseg * 16), o1 = *(const uint4*)(Os + orow * 136 + oseg * 16 + 8);
    *(uint4*)(OUT + (size_t)t * 512 + h * 128 + oseg * 16) = o0;
    *(uint4*)(OUT + (size_t)t * 512 + h * 128 + oseg * 16 + 8) = o1;
  }
  if (!g2) {
#pragma unroll
    for (int n8 = 0; n8 < 8; ++n8)
#pragma unroll
      for (int j = 0; j < 4; ++j)
        p.out[OSD + (((((size_t)s * 2 + l) * 2 + dir) * 4 + h) * 128 + (n8 * 16 + r)) * 128 + (w * 16 + q * 4 + j)] = ST[n8][j];
  }
  lds_barrier();
}

DI void phase_mix2(const Params& p, int l, u16* smem, int* s_item, int tid) {
  int* ctr = (int*)(p.ws + WS_CTR) + l * 4 + 1;
  constexpr int NA2 = 1024 - ATT_X1;
  while (true) {
    if (tid == 0) *s_item = atomicAdd(ctr, 1);
    lds_barrier();
    const int it = *s_item;
    lds_barrier();
    if (it >= 64 + NA2 + 256) break;
    if (it >= 64 && it < 64 + NA2) {
      const int a = it - 64 + ATT_X1;
#ifdef PROBE_MAX
      unsigned long long tb_ = wall_clock64();
#endif
      attn_item(p, 32 + (a >> 7), (a >> 4) & 7, a & 15, smem, tid);
#ifdef PROBE_MAX
      if (tid == 0 && (PROBE_MAX) == 3) atomicMax((int*)(p.ws + WS_CTR) + 32 + l, (int)(wall_clock64() - tb_));
#endif
    } else {
      const int a = (it < 64) ? it : it - 64 - NA2;
#ifdef PROBE_MAX
      unsigned long long tb_ = wall_clock64();
#endif
      dn_scan_item(p, l, (it < 64 ? 32 : 0) + (a >> 3), (a >> 1) & 3, a & 1, smem, tid);
#ifdef PROBE_MAX
      if (tid == 0 && (PROBE_MAX) == 2) atomicMax((int*)(p.ws + WS_CTR) + 32 + l, (int)(wall_clock64() - tb_));
#endif
    }
  }
}

DI void phase_dn_post(const Params& p, int l, int tid, int bid, int nblk) {
  const int lane = tid & 63;
  const int gw = bid * 8 + (tid >> 6), nw = nblk * 8;
  const u16* OF = ws_slab(p, 6); const u16* OB = ws_slab(p, 8); const u16* DG = ws_slab(p, 5); u16* DO = ws_slab(p, 2);
  const float* nwp = p.k.in[21] + l * 128 + (lane & 15) * 8;
  float nwv[8];
#pragma unroll
  for (int e = 0; e < 8; ++e) nwv[e] = nwp[e];
  for (int t0 = gw; t0 < TT; t0 += 4 * nw) {
    uint4 a[4], b[4], g[4];
#pragma unroll
    for (int u = 0; u < 4; ++u) {
      const int t = (t0 + u * nw < TT) ? t0 + u * nw : t0;
      const size_t off = (size_t)t * 512 + lane * 8;
      a[u] = *(const uint4*)(OF + off); b[u] = *(const uint4*)(OB + off); g[u] = *(const uint4*)(DG + off);
    }
#pragma unroll
    for (int u = 0; u < 4; ++u) {
      const int t = t0 + u * nw;
      if (t >= TT) break;
      const unsigned au[4] = {a[u].x, a[u].y, a[u].z, a[u].w}, bu[4] = {b[u].x, b[u].y, b[u].z, b[u].w}, gu[4] = {g[u].x, g[u].y, g[u].z, g[u].w};
      float y[8];
      float ss = 0.f;
#pragma unroll
      for (int e = 0; e < 4; ++e) {
        y[2 * e] = bflo(au[e]) + bflo(bu[e]); y[2 * e + 1] = bfhi(au[e]) + bfhi(bu[e]);
        ss += y[2 * e] * y[2 * e] + y[2 * e + 1] * y[2 * e + 1];
      }
      const float rn = rsqrtf(sum16(ss) * (1.f / 128.f) + EPSF);
      unsigned o[4];
#pragma unroll
      for (int e = 0; e < 4; ++e) {
        float y0 = y[2 * e] * rn * nwv[2 * e] * silu_f(bflo(gu[e]));
        float y1 = y[2 * e + 1] * rn * nwv[2 * e + 1] * silu_f(bfhi(gu[e]));
        o[e] = cvtpk(y0, y1);
      }
      *(uint4*)(DO + (size_t)t * 512 + lane * 8) = uint4{o[0], o[1], o[2], o[3]};
    }
  }
}

DI void fast_grid_sync(unsigned* bar, unsigned target) {
  __syncthreads();
  if (threadIdx.x == 0) {
    __builtin_amdgcn_fence(__ATOMIC_RELEASE, "agent");
    asm volatile("s_waitcnt vmcnt(0)" ::: "memory");
    __hip_atomic_fetch_add(bar, 1u, __ATOMIC_RELAXED, __HIP_MEMORY_SCOPE_AGENT);
    while (__hip_atomic_load(bar, __ATOMIC_RELAXED, __HIP_MEMORY_SCOPE_AGENT) < target) __builtin_amdgcn_s_sleep(1);
    __builtin_amdgcn_fence(__ATOMIC_ACQUIRE, "agent");
    asm volatile("s_waitcnt vmcnt(0)" ::: "memory");
  }
  __syncthreads();
}

#define PHASE_BEGIN int t_ = tid, b_ = bid, l_ = l; size_t z_ = 0; \
  asm volatile("" : "+v"(t_)); asm volatile("" : "+s"(b_)); asm volatile("" : "+s"(l_)); asm volatile("" : "+s"(z_)); \
  unsigned char* w_ = kp.ws + z_; float* o_ = kp.out + z_; \
  Params q{kp, o_, w_};

__global__ void __launch_bounds__(NTHREADS) trunk_megakernel(KParams kp) {
  extern __shared__ __attribute__((aligned(16))) unsigned char dyn_lds[];
  u16* smem = (u16*)dyn_lds;
  int* s_item_p = (int*)(dyn_lds + LDS_WORK);
#ifdef PROBE_SEG
  if (threadIdx.x == 0) *(unsigned long long*)(dyn_lds + 147456 + 8) = 0ull;
  __syncthreads();
#endif
#ifdef PROBE_ITEM
  if (threadIdx.x == 0) *(unsigned long long*)(s_item_p + 2) = 0ull;
  __syncthreads();
#endif
  cg::grid_group grid = cg::this_grid();
  const int tid = threadIdx.x, bid = blockIdx.x, nblk = gridDim.x;
#ifdef TMASK
  unsigned long long tacc = 0, tprev = wall_clock64();
#endif
  { const int l = 0; PHASE_BEGIN phase_mods(q, smem, t_, b_, nblk); }
  grid.sync();
#pragma unroll 1
  for (int l = 0; l < 2; ++l) {
    if (PH(0)) { PHASE_BEGIN phase_convert(q, l_, smem, t_, b_, nblk); }
#ifdef TMASK
    { unsigned long long tn = wall_clock64(); if ((TMASK >> 0) & 1u) tacc += tn - tprev; tprev = tn; }
#endif
    if (PH(1)) { PHASE_BEGIN phase_norm(q, l_, 0, l_ == 0, t_, b_, nblk); }
    fast_grid_sync((unsigned*)(kp.ws + WS_BAR), (unsigned)(l * 18 + 1) * (unsigned)nblk);
#ifdef TMASK
    { unsigned long long tn = wall_clock64(); if ((TMASK >> 1) & 1u) tacc += tn - tprev; tprev = tn; }
#endif
    if (PH(2)) { PHASE_BEGIN phase_g1(q, 0, smem, t_, b_); }
    fast_grid_sync((unsigned*)(kp.ws + WS_BAR), (unsigned)(l * 18 + 2) * (unsigned)nblk);
    if (PH(3)) { PHASE_BEGIN phase_g2(q, l_, 0, l_ == 0, smem, t_, b_); }
    fast_grid_sync((unsigned*)(kp.ws + WS_BAR), (unsigned)(l * 18 + 3) * (unsigned)nblk);
#ifdef TMASK
    { unsigned long long tn = wall_clock64(); if ((TMASK >> 3) & 1u) tacc += tn - tprev; tprev = tn; }
#endif
    if (PH(4)) { PHASE_BEGIN phase_norm(q, l_, 1, false, t_, b_, nblk); }
    fast_grid_sync((unsigned*)(kp.ws + WS_BAR), (unsigned)(l * 18 + 4) * (unsigned)nblk);
#ifdef TMASK
    { unsigned long long tn = wall_clock64(); if ((TMASK >> 4) & 1u) tacc += tn - tprev; tprev = tn; }
#endif
    if (PH(5)) { PHASE_BEGIN phase_g3a(q, smem, t_, b_); }
    fast_grid_sync((unsigned*)(kp.ws + WS_BAR), (unsigned)(l * 18 + 5) * (unsigned)nblk);
#ifdef TMASK
    { unsigned long long tn = wall_clock64(); if ((TMASK >> 5) & 1u) tacc += tn - tprev; tprev = tn; }
#endif
    if (PH(6)) { PHASE_BEGIN phase_prep(q, l_, t_, b_, nblk); }
    fast_grid_sync((unsigned*)(kp.ws + WS_BAR), (unsigned)(l * 18 + 6) * (unsigned)nblk);
#ifdef TMASK
    { unsigned long long tn = wall_clock64(); if ((TMASK >> 6) & 1u) tacc += tn - tprev; tprev = tn; }
#endif
    if (PH(7)) { PHASE_BEGIN phase_mix1(q, l_, smem, s_item_p, t_); }
    fast_grid_sync((unsigned*)(kp.ws + WS_BAR), (unsigned)(l * 18 + 7) * (unsigned)nblk);
#ifdef TMASK
    { unsigned long long tn = wall_clock64(); if ((TMASK >> 7) & 1u) tacc += tn - tprev; tprev = tn; }
#endif
    if (PH(8)) { PHASE_BEGIN phase_g3b(q, smem, t_, b_); }
    fast_grid_sync((unsigned*)(kp.ws + WS_BAR), (unsigned)(l * 18 + 8) * (unsigned)nblk);
#ifdef TMASK
    { unsigned long long tn = wall_clock64(); if ((TMASK >> 8) & 1u) tacc += tn - tprev; tprev = tn; }
#endif
    if (PH(9)) { PHASE_BEGIN phase_dn_pre(q, l_, smem, t_, b_, nblk); }
    fast_grid_sync((unsigned*)(kp.ws + WS_BAR), (unsigned)(l * 18 + 9) * (unsigned)nblk);
#ifdef TMASK
    { unsigned long long tn = wall_clock64(); if ((TMASK >> 9) & 1u) tacc += tn - tprev; tprev = tn; }
#endif
    if (PH(10)) { PHASE_BEGIN phase_mix2(q, l_, smem, s_item_p, t_); }
    fast_grid_sync((unsigned*)(kp.ws + WS_BAR), (unsigned)(l * 18 + 10) * (unsigned)nblk);
#ifdef TMASK
    { unsigned long long tn = wall_clock64(); if ((TMASK >> 10) & 1u) tacc += tn - tprev; tprev = tn; }
#endif
    if (PH(18)) { PHASE_BEGIN phase_g3c(q, smem, t_, b_); }
    fast_grid_sync((unsigned*)(kp.ws + WS_BAR), (unsigned)(l * 18 + 11) * (unsigned)nblk);
#ifdef TMASK
    { unsigned long long tn = wall_clock64(); if ((TMASK >> 18) & 1u) tacc += tn - tprev; tprev = tn; }
#endif
    if (PH(11)) { PHASE_BEGIN phase_dn_post(q, l_, t_, b_, nblk); }
    fast_grid_sync((unsigned*)(kp.ws + WS_BAR), (unsigned)(l * 18 + 12) * (unsigned)nblk);
#ifdef TMASK
    { unsigned long long tn = wall_clock64(); if ((TMASK >> 11) & 1u) tacc += tn - tprev; tprev = tn; }
#endif
    if (PH(12)) { PHASE_BEGIN phase_mg(q, smem, t_, b_); }
    fast_grid_sync((unsigned*)(kp.ws + WS_BAR), (unsigned)(l * 18 + 13) * (unsigned)nblk);
    if (PH(12)) { PHASE_BEGIN
#pragma unroll 1
      for (int b = 0; b < 3; ++b) { int bb = b; asm volatile("" : "+s"(bb)); phase_br(q, bb, smem, t_, b_); } }
    fast_grid_sync((unsigned*)(kp.ws + WS_BAR), (unsigned)(l * 18 + 14) * (unsigned)nblk);
#ifdef TMASK
    { unsigned long long tn = wall_clock64(); if ((TMASK >> 12) & 1u) tacc += tn - tprev; tprev = tn; }
#endif
    if (PH(13)) { PHASE_BEGIN phase_g5(q, l_, smem, t_, b_); }
    fast_grid_sync((unsigned*)(kp.ws + WS_BAR), (unsigned)(l * 18 + 15) * (unsigned)nblk);
#ifdef TMASK
    { unsigned long long tn = wall_clock64(); if ((TMASK >> 13) & 1u) tacc += tn - tprev; tprev = tn; }
#endif
    if (PH(14)) { PHASE_BEGIN phase_norm(q, l_, 2, false, t_, b_, nblk); }
    fast_grid_sync((unsigned*)(kp.ws + WS_BAR), (unsigned)(l * 18 + 16) * (unsigned)nblk);
#ifdef TMASK
    { unsigned long long tn = wall_clock64(); if ((TMASK >> 14) & 1u) tacc += tn - tprev; tprev = tn; }
#endif
    if (PH(15)) { PHASE_BEGIN phase_g1(q, 1, smem, t_, b_); }
    fast_grid_sync((unsigned*)(kp.ws + WS_BAR), (unsigned)(l * 18 + 17) * (unsigned)nblk);
#ifdef TMASK
    { unsigned long long tn = wall_clock64(); if ((TMASK >> 15) & 1u) tacc += tn - tprev; tprev = tn; }
#endif
    if (PH(16)) { PHASE_BEGIN phase_g2(q, l_, 1, false, smem, t_, b_); }
    fast_grid_sync((unsigned*)(kp.ws + WS_BAR), (unsigned)(l * 18 + 18) * (unsigned)nblk);
#ifdef TMASK
    { unsigned long long tn = wall_clock64(); if ((TMASK >> 16) & 1u) tacc += tn - tprev; tprev = tn; }
#endif
  }
  if (PH(17)) { Params q{kp, kp.out, kp.ws}; phase_final_norm(q, tid, bid, nblk); }
#ifdef PROBE_MAX
  if (bid == 0 && tid == 0) { int* c_ = (int*)(kp.ws + WS_CTR) + 32; unsigned long long ta = (unsigned long long)(__hip_atomic_load(c_, __ATOMIC_RELAXED, __HIP_MEMORY_SCOPE_AGENT) + __hip_atomic_load(c_ + 1, __ATOMIC_RELAXED, __HIP_MEMORY_SCOPE_AGENT)); unsigned long long te = wall_clock64(); while (wall_clock64() - te < ta) { __builtin_amdgcn_s_sleep(8); } }
#endif
#ifdef PROBE_SEG
  if (tid == 0) { unsigned long long ta = *(unsigned long long*)(dyn_lds + 147456 + 8); unsigned long long te = wall_clock64(); while (wall_clock64() - te < ta) { __builtin_amdgcn_s_sleep(8); } }
#endif
#ifdef PROBE_ITEM
  if (bid == nblk - 1 && tid == 0) { unsigned long long ta = *(unsigned long long*)(s_item_p + 2); unsigned long long te = wall_clock64(); while (wall_clock64() - te < ta) { __builtin_amdgcn_s_sleep(8); } }
#endif
#ifdef TMASK
  if (bid == 0) { unsigned long long te = wall_clock64(); while (wall_clock64() - te < tacc) { __builtin_amdgcn_s_sleep(8); } }
#endif
}

extern "C" void kernel_launch(void* const* d_in, const int* in_sizes, int n_in, void* d_out, int out_size, void* d_ws, size_t ws_size,
                              hipStream_t stream) {
  static int grid_blocks = 0;
  if (!grid_blocks) {
    int dev = 0, cus = 0, per_cu = 0;
    hipGetDevice(&dev);
    hipDeviceGetAttribute(&cus, hipDeviceAttributeMultiprocessorCount, dev);
    hipFuncSetAttribute((const void*)trunk_megakernel, hipFuncAttributeMaxDynamicSharedMemorySize, LDS_DYN);
    hipOccupancyMaxActiveBlocksPerMultiprocessor(&per_cu, trunk_megakernel, NTHREADS, LDS_DYN);
    if (per_cu < 1) per_cu = 1;
    grid_blocks = cus * per_cu;
  }
  if (ws_size < WS_END) { fprintf(stderr, "workspace too small: %zu < %zu\n", ws_size, (size_t)WS_END); return; }
  KParams p{};
  for (int i = 0; i < 30; ++i) p.in[i] = (const float*)d_in[i];
  p.out = (float*)d_out;
  p.ws = (unsigned char*)d_ws;
  hipMemsetAsync((unsigned char*)d_ws + WS_BAR, 0, 256, stream);
  void* args[] = {&p};
  hipError_t e = hipLaunchCooperativeKernel((void*)trunk_megakernel, dim3(grid_blocks), dim3(NTHREADS), args, LDS_DYN, stream);
  if (e != hipSuccess) fprintf(stderr, "cooperative launch failed: %s (grid %d)\n", hipGetErrorString(e), grid_blocks);
}
```
